# Optimizing an MI355X kernel written in HIP

```python
import math
import jax, jax.numpy as jnp
from jax import lax
import numpy as np

D_MODEL = 1024
BATCH = 8
SEQ = 4096
DEPTH = 2

MEM_LEN = 256
Q_BLOCK = 128
RMS_EPS = 1e-6
SSM_WIDTH = D_MODEL // 2
SSM_GROUP = 16
SSM_GROUPS = SSM_WIDTH // SSM_GROUP
SSM_STATE = 64
SB_HEADS = 8
SB_HEAD_DIM = 64
SB_WIDTH = SB_HEADS * SB_HEAD_DIM
DA_HEADS = 4
DA_QK_DIM = 64
DA_V_DIM = 2 * DA_QK_DIM
DA_QK_WIDTH = DA_HEADS * 2 * DA_QK_DIM
DA_WIDTH = DA_HEADS * DA_V_DIM
ROT_DIM = DA_QK_DIM // 4
ROPE_THETA = 500000.0
N_BRANCH = 3
BRANCH_WIDTH = 512
XA_HEADS = 4
XA_HEAD_DIM = 128
XA_WIDTH = XA_HEADS * XA_HEAD_DIM
MLP_HIDDEN = 4 * D_MODEL
IN_SPLITS = (SSM_WIDTH, SB_WIDTH, SB_WIDTH, SB_WIDTH, DA_QK_WIDTH, DA_QK_WIDTH, DA_WIDTH, N_BRANCH * D_MODEL)
N_IN = sum(IN_SPLITS)

kernel_name = 'hybrid_s5_stickbreak_diffattn_gated'


def rmsnorm(x, gain):
    x32 = x.astype(jnp.float32)
    y = x32 * lax.rsqrt(jnp.mean(x32 * x32, axis=-1, keepdims=True) + RMS_EPS)
    return (y * gain.astype(jnp.float32)).astype(x.dtype)


def rope_partial(t, cos, sin):
    half = ROT_DIM // 2
    t1 = t[..., :half]
    t2 = t[..., half:ROT_DIM]
    return jnp.concatenate([t1 * cos - t2 * sin, t2 * cos + t1 * sin, t[..., ROT_DIM:]], axis=-1)


def query_blocks(fn, q):
    b, h, s, d = q.shape
    nb = s // Q_BLOCK
    qb = q.reshape(b, h, nb, Q_BLOCK, d).transpose(2, 0, 1, 3, 4)
    starts = jnp.arange(nb, dtype=jnp.int32) * Q_BLOCK
    out = lax.map(lambda a: fn(a[0], a[1]), (qb, starts))
    return out.transpose(1, 2, 0, 3, 4).reshape(b, h, s, out.shape[-1])


def stick_breaking_attention(q, k, v):
    scale = q.shape[-1] ** -0.5
    key_idx = jnp.arange(k.shape[2])

    def blk(qb, t0):
        q_idx = t0 + jnp.arange(Q_BLOCK)
        mask = key_idx[None, :] < q_idx[:, None]
        z = jnp.einsum('bhqd,bhkd->bhqk', qb, k).astype(jnp.float32) * scale
        log_1mb = jnp.where(mask, jax.nn.log_sigmoid(-z), 0.0)
        later = lax.cumsum(log_1mb, axis=3, reverse=True) - log_1mb
        w = jnp.where(mask, jnp.exp(jax.nn.log_sigmoid(z) + later), 0.0)
        return jnp.einsum('bhqk,bhkd->bhqd', w.astype(v.dtype), v)

    return query_blocks(blk, q)


def differential_attention(q, k, v, lam):
    dk = q.shape[-1] // 2
    scale = dk ** -0.5
    k1 = k[..., :dk]
    k2 = k[..., dk:]
    key_idx = jnp.arange(k.shape[2])

    def blk(qb, t0):
        q_idx = t0 + jnp.arange(Q_BLOCK)
        mask = key_idx[None, :] <= q_idx[:, None]
        s1 = jnp.einsum('bhqd,bhkd->bhqk', qb[..., :dk], k1).astype(jnp.float32) * scale
        s2 = jnp.einsum('bhqd,bhkd->bhqk', qb[..., dk:], k2).astype(jnp.float32) * scale
        p1 = jax.nn.softmax(jnp.where(mask, s1, -jnp.inf), axis=-1)
        p2 = jax.nn.softmax(jnp.where(mask, s2, -jnp.inf), axis=-1)
        w = p1 - lam * p2
        return jnp.einsum('bhqk,bhkd->bhqd', w.astype(v.dtype), v)

    return query_blocks(blk, q)


def _ssm_combine(e1, e2):
    a1, b1 = e1
    a2, b2 = e2
    return a2 * a1, a2 * b1 + b2


def s5_ssm(u, lam_re, lam_im, log_dt, b_re, b_im, c_re, c_im, d_skip):
    bsz, seq, _ = u.shape
    ug = u.astype(jnp.float32).reshape(bsz, seq, SSM_GROUPS, SSM_GROUP)
    lam = lax.complex(lam_re.astype(jnp.float32), lam_im.astype(jnp.float32))
    dt = jnp.exp(log_dt.astype(jnp.float32))[:, None]
    lam_bar = jnp.exp(lam * dt)
    bmat = lax.complex(b_re.astype(jnp.float32), b_im.astype(jnp.float32))
    b_bar = ((lam_bar - 1.0) / lam)[..., None] * bmat
    bu = jnp.einsum('gpc,blgc->blgp', b_bar, ug.astype(jnp.complex64))
    a = jnp.broadcast_to(lam_bar, bu.shape)
    _, states = lax.associative_scan(_ssm_combine, (a, bu), axis=1)
    y = (jnp.einsum('gcp,blgp->blgc', c_re.astype(jnp.float32), states.real)
         - jnp.einsum('gcp,blgp->blgc', c_im.astype(jnp.float32), states.imag))
    y = y + d_skip.astype(jnp.float32).reshape(SSM_GROUPS, SSM_GROUP) * ug
    return y.reshape(bsz, seq, SSM_WIDTH).astype(u.dtype)


def _normal(k, shape, scale):
    return jax.random.normal(k, shape, jnp.float32) * scale


def setup_inputs(seed: int = 0) -> dict:
    key = jax.random.key(seed)
    ks = jax.random.split(key, 32)
    gain = lambda k, shape: 1.0 + _normal(k, shape, 0.02)
    offsets = jax.random.randint(ks[2], (BATCH, 1), 0, 1024, dtype=jnp.int32)
    positions = offsets + jnp.arange(SEQ, dtype=jnp.int32)[None, :]
    lam_im = jnp.pi * jnp.arange(SSM_STATE, dtype=jnp.float32)[None, None, :] + _normal(ks[7], (DEPTH, SSM_GROUPS, SSM_STATE), 0.01)
    return {
        'x': _normal(ks[0], (BATCH, SEQ, D_MODEL), 1.0),
        'mem': _normal(ks[1], (BATCH, MEM_LEN, D_MODEL), 1.0),
        'positions': positions,
        'norm_mix': gain(ks[3], (DEPTH, D_MODEL)),
        'w_in': _normal(ks[4], (DEPTH, D_MODEL, N_IN), D_MODEL ** -0.5),
        'ssm_lam_re': -0.5 + _normal(ks[6], (DEPTH, SSM_GROUPS, SSM_STATE), 0.01),
        'ssm_lam_im': lam_im,
        'ssm_log_dt': jax.random.uniform(ks[8], (DEPTH, SSM_GROUPS), jnp.float32, math.log(1e-3), math.log(1e-1)),
        'ssm_b_re': _normal(ks[9], (DEPTH, SSM_GROUPS, SSM_STATE, SSM_GROUP), (2 * SSM_GROUP) ** -0.5),
        'ssm_b_im': _normal(ks[10], (DEPTH, SSM_GROUPS, SSM_STATE, SSM_GROUP), (2 * SSM_GROUP) ** -0.5),
        'ssm_c_re': _normal(ks[11], (DEPTH, SSM_GROUPS, SSM_GROUP, SSM_STATE), (2 * SSM_STATE) ** -0.5),
        'ssm_c_im': _normal(ks[12], (DEPTH, SSM_GROUPS, SSM_GROUP, SSM_STATE), (2 * SSM_STATE) ** -0.5),
        'ssm_d': _normal(ks[13], (DEPTH, SSM_WIDTH), 1.0),
        'ssm_w_glu': _normal(ks[14], (DEPTH, SSM_WIDTH, 2 * SSM_WIDTH), SSM_WIDTH ** -0.5),
        'diff_lambda': _normal(ks[15], (DEPTH, 4, DA_QK_DIM), 0.1),
        'diff_subln': gain(ks[16], (DEPTH, DA_V_DIM)),
        'w_branch': _normal(ks[17], (DEPTH, N_BRANCH, BRANCH_WIDTH, D_MODEL), BRANCH_WIDTH ** -0.5),
        'w_out': _normal(ks[18], (DEPTH, D_MODEL, D_MODEL), D_MODEL ** -0.5),
        'norm_cross': gain(ks[19], (DEPTH, D_MODEL)),
        'norm_mem': gain(ks[20], (DEPTH, D_MODEL)),
        'w_xq': _normal(ks[21], (DEPTH, D_MODEL, XA_WIDTH), D_MODEL ** -0.5),
        'w_xkv': _normal(ks[22], (DEPTH, D_MODEL, 2 * XA_WIDTH), D_MODEL ** -0.5),
        'w_xo': _normal(ks[23], (DEPTH, XA_WIDTH, D_MODEL), XA_WIDTH ** -0.5),
        'norm_mlp': gain(ks[24], (DEPTH, D_MODEL)),
        'w_up': _normal(ks[25], (DEPTH, D_MODEL, MLP_HIDDEN), D_MODEL ** -0.5),
        'w_down': _normal(ks[26], (DEPTH, MLP_HIDDEN, D_MODEL), MLP_HIDDEN ** -0.5),
        'norm_final': gain(ks[27], (D_MODEL,)),
    }


def reference(x, mem, positions, norm_mix, w_in, ssm_lam_re, ssm_lam_im, ssm_log_dt, ssm_b_re, ssm_b_im,
              ssm_c_re, ssm_c_im, ssm_d, ssm_w_glu, diff_lambda, diff_subln, w_branch, w_out,
              norm_cross, norm_mem, w_xq, w_xkv, w_xo, norm_mlp, w_up, w_down, norm_final):
    bsz, seq, _ = x.shape
    split_idx = np.cumsum(IN_SPLITS)[:-1].tolist()

    inv_freq = ROPE_THETA ** (-jnp.arange(0, ROT_DIM, 2, dtype=jnp.float32) / ROT_DIM)
    ang = positions.astype(jnp.float32)[..., None] * inv_freq
    cos = jnp.cos(ang)[:, :, None, None, :].astype(x.dtype)
    sin = jnp.sin(ang)[:, :, None, None, :].astype(x.dtype)

    def heads(t, n):
        return t.reshape(bsz, seq, n, -1).transpose(0, 2, 1, 3)

    def merge_heads(t):
        return t.transpose(0, 2, 1, 3).reshape(bsz, seq, -1)

    for l in range(DEPTH):
        h = rmsnorm(x, norm_mix[l])
        u, sq, sk, sv, dq, dk, dv, gate_logits = jnp.split(h @ w_in[l], split_idx, axis=-1)

        y_ssm = jax.nn.gelu(s5_ssm(u, ssm_lam_re[l], ssm_lam_im[l], ssm_log_dt[l], ssm_b_re[l], ssm_b_im[l],
                                   ssm_c_re[l], ssm_c_im[l], ssm_d[l]))
        glu_a, glu_b = jnp.split(y_ssm @ ssm_w_glu[l], 2, axis=-1)
        y_ssm = glu_a * jax.nn.sigmoid(glu_b)

        y_sb = merge_heads(stick_breaking_attention(heads(sq, SB_HEADS), heads(sk, SB_HEADS), heads(sv, SB_HEADS)))

        dq_r = rope_partial(dq.reshape(bsz, seq, DA_HEADS, 2, DA_QK_DIM), cos, sin)
        dk_r = rope_partial(dk.reshape(bsz, seq, DA_HEADS, 2, DA_QK_DIM), cos, sin)
        dq_r = dq_r.reshape(bsz, seq, DA_HEADS, 2 * DA_QK_DIM).transpose(0, 2, 1, 3)
        dk_r = dk_r.reshape(bsz, seq, DA_HEADS, 2 * DA_QK_DIM).transpose(0, 2, 1, 3)
        lam_vec = diff_lambda[l].astype(jnp.float32)
        lam_init = 0.8 - 0.6 * math.exp(-0.3 * l)
        lam = (jnp.exp(jnp.sum(lam_vec[0] * lam_vec[1])) - jnp.exp(jnp.sum(lam_vec[2] * lam_vec[3]))
               + lam_init)
        o = differential_attention(dq_r, dk_r, heads(dv, DA_HEADS), lam)
        o = rmsnorm(o, diff_subln[l]) * (1.0 - lam_init)
        y_da = merge_heads(o)

        branches = jnp.stack([y_ssm, y_sb, y_da], axis=2)
        proj = jnp.einsum('bsnc,ncd->bsnd', branches, w_branch[l])
        gates = jax.nn.sigmoid(gate_logits.reshape(bsz, seq, N_BRANCH, D_MODEL))
        x = x + jnp.sum(gates * proj, axis=2) @ w_out[l]

        hx = rmsnorm(x, norm_cross[l])
        m = rmsnorm(mem, norm_mem[l])
        xq = hx.reshape(bsz, seq, D_MODEL) @ w_xq[l]
        xq = xq.reshape(bsz, seq, XA_HEADS, XA_HEAD_DIM)
        xk, xv = jnp.split(m @ w_xkv[l], 2, axis=-1)
        xk = xk.reshape(bsz, -1, XA_HEADS, XA_HEAD_DIM)
        xv = xv.reshape(bsz, -1, XA_HEADS, XA_HEAD_DIM)
        sc = jnp.einsum('bshd,bmhd->bhsm', xq, xk).astype(jnp.float32) * (XA_HEAD_DIM ** -0.5)
        p = jax.nn.softmax(sc, axis=-1).astype(xv.dtype)
        xo = jnp.einsum('bhsm,bmhd->bshd', p, xv).reshape(bsz, seq, XA_WIDTH)
        x = x + xo @ w_xo[l]

        hm = rmsnorm(x, norm_mlp[l])
        x = x + jnp.square(jax.nn.relu(hm @ w_up[l])) @ w_down[l]

    return rmsnorm(x, norm_final)
```

```cpp
#include <hip/hip_runtime.h>
#include <hip/hip_cooperative_groups.h>
#include <cstdint>
#include <cstdio>
namespace cg = cooperative_groups;

#define LAS __attribute__((address_space(3)))
#define DI __device__ __forceinline__
typedef unsigned short bf16_t;
typedef short bf16x8 __attribute__((ext_vector_type(8)));
typedef short s16x4 __attribute__((ext_vector_type(4)));
typedef short v4i16_t __attribute__((ext_vector_type(4)));
typedef float f32x4 __attribute__((ext_vector_type(4)));
typedef float f32x16 __attribute__((ext_vector_type(16)));
typedef unsigned u32x4 __attribute__((ext_vector_type(4)));
typedef float f32x2_t __attribute__((ext_vector_type(2)));
typedef __bf16 bf16x2_t __attribute__((ext_vector_type(2)));

constexpr int DM = 1024, NB = 8, SEQ = 4096, MTOK = NB * SEQ, DEPTH = 2, MEML = 256;
constexpr int NIN = 6656, NINA = 3584;
constexpr float RMS_EPS = 1e-6f;
constexpr int SSM_T = 32, SSM_NC = SEQ / SSM_T  , SSM_M2 = NB * SSM_NC  , SSM_K2 = 640;

constexpr size_t MiB = 1u << 20;
constexpr size_t WS_ROPE = 1 * MiB;
constexpr size_t WS_LAMT = 3 * MiB;
constexpr size_t WS_MEMN = 4 * MiB;
constexpr size_t WS_WXKV = 12 * MiB;
constexpr size_t WS_MEMKV = 16 * MiB;
constexpr size_t WS_WIN = 24 * MiB;
constexpr size_t WS_WGLU = 37 * MiB;
constexpr size_t WS_WB = 38 * MiB;
constexpr size_t WS_WOUT = 41 * MiB;
constexpr size_t WS_WXQ = 43 * MiB;
constexpr size_t WS_WXO = 44 * MiB;
constexpr size_t WS_WUP = 45 * MiB;
constexpr size_t WS_WDN = 53 * MiB;
constexpr size_t WS_WST = 61 * MiB;
constexpr size_t WS_TOEP = 69 * MiB;
constexpr size_t WS_H = 90 * MiB;
constexpr size_t WS_YSSM = 154 * MiB;
constexpr size_t WS_SQ = 186 * MiB;
constexpr size_t WS_DQ = 218 * MiB;
constexpr size_t WS_SK = 250 * MiB;
constexpr size_t WS_SV = 282 * MiB;
constexpr size_t WS_DK = 314 * MiB;
constexpr size_t WS_DV = 346 * MiB;
constexpr size_t WS_A2 = 378 * MiB;
constexpr size_t WS_SLOC = 418 * MiB;
constexpr size_t WS_YACT = 434 * MiB;
constexpr size_t WS_GATES = 250 * MiB;
constexpr size_t WS_HID = 154 * MiB;
constexpr size_t WS_XQ = 154 * MiB;
constexpr size_t WS_H2 = 250 * MiB;
constexpr size_t WS_GS = 314 * MiB;
constexpr size_t WS_PART = 466 * MiB;
constexpr size_t WS_END = 468 * MiB;

constexpr int LDS_CTL = 143360;
constexpr int LDS_BYTES = LDS_CTL + 1024;

DI unsigned pk2(float lo, float hi) { f32x2_t v = {lo, hi}; bf16x2_t b = __builtin_convertvector(v, bf16x2_t); return __builtin_bit_cast(unsigned, b); }
DI bf16_t f2bf(float f) { return (bf16_t)(pk2(f, 0.f) & 0xffffu); }
DI float bf2f(unsigned u) { return __uint_as_float(u << 16); }
DI void st8(bf16_t* p, f32x4 a, f32x4 b) { u32x4 w; w.x = pk2(a[0], a[1]); w.y = pk2(a[2], a[3]); w.z = pk2(b[0], b[1]); w.w = pk2(b[2], b[3]); *(u32x4*)p = w; }
DI int opaque(int v) { asm volatile("" : "+v"(v)); return v; }
DI int opaque_s(int v) { asm volatile("" : "+s"(v)); return v; }
DI float sigmoidf_(float x) { return __builtin_amdgcn_rcpf(1.f + __builtin_amdgcn_exp2f(x * -1.4426950408889634f)); }
DI float wave_sum(float v) {
#pragma unroll
    for (int o = 1; o < 64; o <<= 1) v += __shfl_xor(v, o);
    return v;
}
DI void sincos_red(double a, float& s, float& c) {
    const double k = rint(a * 0.15915494309189535);
    const float r = (float)(a - k * 6.283185307179586);
    s = __sinf(r); c = __cosf(r);
}

namespace pg8 {
constexpr int BM = 256, BK = 64, HALF = 128, HTB = HALF * BK * 2, STAGE_BYTES = 8 * HTB, NXCD = 8, WGM = 8;
DI int lds_byte(int r, int c) { const int st = (r >> 4) * 2 + (c >> 5), rr = r & 15, cc = c & 31, ob = rr * 64 + cc * 2; return st * 1024 + (ob ^ (((ob >> 9) & 1) << 5)); }
DI void stage_rc(int b, int& R, int& C) { const int st = b / 1024, sb = b % 1024, swz = sb ^ (((sb >> 9) & 1) << 5); R = (st >> 1) * 16 + swz / 64; C = (st & 1) * 32 + (swz % 64) / 2; }
DI int perm32(int rho) { const int n = rho >> 4, i = rho & 15; return 8 * (i >> 2) + 4 * n + (i & 3); }

struct Unit { int pm, pn, z; };
struct Gemm { const bf16_t* A; const bf16_t* Bt; int lda, ldb, K; long zA, zB; };

DI void tile_decode(int wgid, int nM, int nN, int& pm, int& pn) {
    const int nwg = nM * nN;
    { const int q = nwg / NXCD, r = nwg % NXCD, xcd = wgid % NXCD, off = wgid / NXCD; wgid = (xcd < r ? xcd * (q + 1) : r * (q + 1) + (xcd - r) * q) + off; }
    const int nig = WGM * nN, gid = wgid / nig, fm = gid * WGM, gsz = (nM - fm) < WGM ? (nM - fm) : WGM;
    pm = fm + ((wgid % nig) % gsz); pn = (wgid % nig) / gsz;
}
struct SchedMN {
    int nM, nN, G, c;
    DI bool next(int i, Unit& u) const { const long L = (long)i * G + c; if (L >= (long)nM * nN) return false; tile_decode((int)L, nM, nN, u.pm, u.pn); u.z = 0; return true; }
};
struct SchedZ {
    int nZ, nM, nN, G, c;
    DI bool next(int i, Unit& u) const { const long L = (long)i * G + c; if (L >= (long)nZ * nM * nN) return false; const int l = (int)L; u.z = l / (nM * nN); const int r = l % (nM * nN); u.pm = r / nN; u.pn = r % nN; return true; }
};
struct SchedMerge {
    int nM, nN, G, c;
    DI bool next(int i, Unit& u) const { const long L = (long)(i / 3) * G + c; if (L >= (long)nM * nN) return false; tile_decode((int)L, nM, nN, u.pm, u.pn); u.z = i % 3; return true; }
};

template <class Epi, class Sched>
DI void gemm_phase(LAS unsigned char* lds, const Gemm g, const Sched& S, const Epi& E) {
    const int tid = opaque(threadIdx.x), wid = __builtin_amdgcn_readfirstlane(tid >> 6), lane = tid & 63, wr = wid >> 2, wc = wid & 3, fr = lane & 15, fq = lane >> 4;
    const int nt = g.K / BK;
    unsigned voffA[2], voffB[2];
#pragma unroll
    for (int i = 0; i < 2; ++i) { int R, C; stage_rc(tid * 16 + i * 8192, R, C); const int Rb = (R & ~31) + perm32(R & 31);
        voffA[i] = (unsigned)(R * g.lda + C) * 2u; voffB[i] = (unsigned)(Rb * g.ldb + C) * 2u; }
    const size_t kstep = (size_t)(BK * 2);
    const size_t hstepA = (size_t)HALF * g.lda * 2, hstepB = (size_t)HALF * g.ldb * 2;
    const unsigned ldsw = (unsigned)wid * 1024u;
    const int aoff = lds_byte(wr * 64 + fr, fq * 8), boff = lds_byte(wc * 32 + fr, fq * 8);
#define PG8_SA(b, h) (((b) * 2 + (h)) * HTB)
#define PG8_SB(b, h) ((4 + (b) * 2 + (h)) * HTB)
#define PG8_STAGE(bufoff, gbase, voff) do { _Pragma("unroll") for (int _i = 0; _i < 2; ++_i) \
        __builtin_amdgcn_global_load_lds((const unsigned*)((const char*)(gbase) + (voff)[_i]), (LAS unsigned*)(lds + (bufoff) + ldsw + _i * 8192), 16, 0, 0); } while (0)
#define PG8_LDA(dst, b, h) do { _Pragma("unroll") for (int m = 0; m < 4; ++m) _Pragma("unroll") for (int k = 0; k < 2; ++k) dst[m][k] = *(const LAS bf16x8*)(lds + PG8_SA(b, h) + aoff + m * 2048 + k * 1024); } while (0)
#define PG8_LDB(dst, b, h) do { _Pragma("unroll") for (int n = 0; n < 2; ++n) _Pragma("unroll") for (int k = 0; k < 2; ++k) dst[n][k] = *(const LAS bf16x8*)(lds + PG8_SB(b, h) + boff + n * 2048 + k * 1024); } while (0)
#define PG8_MMA(ai, bj, At, Bt) do { __builtin_amdgcn_s_setprio(1); _Pragma("unroll") for (int m = 0; m < 4; ++m) _Pragma("unroll") for (int n = 0; n < 2; ++n) _Pragma("unroll") for (int k = 0; k < 2; ++k) \
        acc[ai][bj][m][n] = __builtin_amdgcn_mfma_f32_16x16x32_bf16(Bt[n][k], At[m][k], acc[ai][bj][m][n], 0, 0, 0); __builtin_amdgcn_s_setprio(0); } while (0)
#define PG8_WAIT_V(n) asm volatile("s_waitcnt vmcnt(" #n ")" ::: "memory")
#define PG8_WAIT_L(n) asm volatile("s_waitcnt lgkmcnt(" #n ")" ::: "memory")
#define PG8_BAR __builtin_amdgcn_s_barrier()
#define PG8_SCHED __builtin_amdgcn_sched_barrier(0)
    Unit cur, nxt; int ui = 0;
    if (!S.next(0, cur)) return;
#define PG8_RFILL(u_, ui_) do { if (tid < 256) { const f32x4* pp_ = (const f32x4*)(E.part + (size_t)((u_).pm * BM + tid) * 16); \
        const f32x4 a_ = pp_[0], b_ = pp_[1], c_ = pp_[2], d_ = pp_[3]; const f32x4 s_ = (a_ + b_) + (c_ + d_); \
        ((LAS float*)(lds + STAGE_BYTES))[(ui_) * 256 + tid] = rsqrtf(((s_[0] + s_[1]) + (s_[2] + s_[3])) * (1.f / DM) + RMS_EPS); } } while (0)
    if constexpr (Epi::NEEDS_R) {
        Unit uu; for (int i = 0; i < 8 && S.next(i, uu); ++i) PG8_RFILL(uu, i);
    }
    f32x4 acc[2][2][4][2];
#pragma unroll
    for (int a = 0; a < 2; ++a)
#pragma unroll
        for (int b = 0; b < 2; ++b)
#pragma unroll
            for (int m = 0; m < 4; ++m)
#pragma unroll
                for (int n = 0; n < 2; ++n) acc[a][b][m][n] = (f32x4){0.f, 0.f, 0.f, 0.f};
    bf16x8 At[4][2], B0[2][2], B1[2][2];
    const char* cA = (const char*)g.A + (size_t)cur.z * g.zA * 2 + (size_t)cur.pm * 2 * hstepA;
    const char* cB = (const char*)g.Bt + (size_t)cur.z * g.zB * 2 + (size_t)cur.pn * 2 * hstepB;
    PG8_STAGE(PG8_SB(0, 0), cB, voffB); PG8_STAGE(PG8_SB(0, 1), cB + hstepB, voffB); PG8_STAGE(PG8_SA(0, 0), cA, voffA); PG8_STAGE(PG8_SA(0, 1), cA + hstepA, voffA);
    if (wr == 1) PG8_BAR;
    PG8_WAIT_V(2); PG8_BAR;
    PG8_STAGE(PG8_SB(1, 0), cB + kstep, voffB); PG8_STAGE(PG8_SA(1, 0), cA + kstep, voffA); PG8_STAGE(PG8_SB(1, 1), cB + hstepB + kstep, voffB);
    PG8_WAIT_V(6); PG8_BAR;
    for (;;) {
        const bool has_next = S.next(ui + 1, nxt);
        const char* nA = has_next ? (const char*)g.A + (size_t)nxt.z * g.zA * 2 + (size_t)nxt.pm * 2 * hstepA : cA;
        const char* nB = has_next ? (const char*)g.Bt + (size_t)nxt.z * g.zB * 2 + (size_t)nxt.pn * 2 * hstepB : cB;
        for (int t = 0; t < nt; t += 2) {
            const bool last = (t == nt - 2);
            const char* a1 = cA + (size_t)(t + 1) * kstep;
            const char* a2 = last ? nA : cA + (size_t)(t + 2) * kstep; const char* b2 = last ? nB : cB + (size_t)(t + 2) * kstep;
            const char* a3 = a2 + kstep; const char* b3 = b2 + kstep;
            PG8_LDB(B0, 0, 0); PG8_LDB(B1, 0, 1); PG8_SCHED; PG8_LDA(At, 0, 0); PG8_STAGE(PG8_SA(1, 1), a1 + hstepA, voffA);
            PG8_WAIT_V(8); PG8_WAIT_L(0); PG8_BAR; PG8_MMA(0, 0, At, B0); PG8_MMA(0, 1, At, B1); PG8_BAR; PG8_SCHED;
            PG8_LDA(At, 0, 1); PG8_STAGE(PG8_SB(0, 0), b2, voffB); PG8_STAGE(PG8_SB(0, 1), b2 + hstepB, voffB); PG8_STAGE(PG8_SA(0, 0), a2, voffA);
            PG8_WAIT_V(8); PG8_WAIT_L(0); PG8_BAR; PG8_MMA(1, 0, At, B0); PG8_MMA(1, 1, At, B1); PG8_BAR; PG8_SCHED;
            PG8_LDB(B0, 1, 0); PG8_LDB(B1, 1, 1); PG8_SCHED; PG8_LDA(At, 1, 0); PG8_STAGE(PG8_SA(0, 1), a2 + hstepA, voffA);
            PG8_WAIT_V(8); PG8_WAIT_L(0); PG8_BAR; PG8_MMA(0, 0, At, B0); PG8_MMA(0, 1, At, B1); PG8_BAR; PG8_SCHED;
            PG8_LDA(At, 1, 1); PG8_STAGE(PG8_SB(1, 0), b3, voffB); PG8_STAGE(PG8_SB(1, 1), b3 + hstepB, voffB); PG8_STAGE(PG8_SA(1, 0), a3, voffA);
            PG8_WAIT_V(8); PG8_WAIT_L(0); PG8_BAR; PG8_MMA(1, 0, At, B0); PG8_MMA(1, 1, At, B1); PG8_BAR; PG8_SCHED;
        }
        if (wr == 0) PG8_BAR;
        E(acc, cur, wr, wc, fr, fq, (const LAS float*)(lds + STAGE_BYTES) + (ui & 7) * 256);
        if (!has_next) break;
#pragma unroll
        for (int a = 0; a < 2; ++a)
#pragma unroll
            for (int b = 0; b < 2; ++b)
#pragma unroll
                for (int m = 0; m < 4; ++m)
#pragma unroll
                    for (int n = 0; n < 2; ++n) acc[a][b][m][n] = (f32x4){0.f, 0.f, 0.f, 0.f};
        cur = nxt; cA = nA; cB = nB; ++ui;
        if (wr == 1) PG8_BAR;
    }
    PG8_WAIT_V(0);
    PG8_BAR;
#undef PG8_RFILL
#undef PG8_SA
#undef PG8_SB
#undef PG8_STAGE
#undef PG8_LDA
#undef PG8_LDB
#undef PG8_MMA
#undef PG8_WAIT_V
#undef PG8_WAIT_L
#undef PG8_BAR
#undef PG8_SCHED
}

typedef f32x4 AccT[2][2][4][2];

struct EpiInProj {
    static constexpr bool PERM = true, NEEDS_R = true;
    unsigned char* ws; const f32x2_t* rope; const float* part;
    DI void operator()(const AccT& acc, const Unit& u, int wr, int wc, int fr, int fq, const LAS float* rt) const {
        const int colt = u.pn * BM; const int seg = colt >> 9; const int cbase = (colt & 511) + wc * 32 + 8 * fq;
        const size_t off = seg == 1 ? WS_SQ : seg == 2 ? WS_SK : seg == 3 ? WS_SV : seg == 4 ? WS_DQ : seg == 5 ? WS_DK : WS_DV;
        bf16_t* base = (bf16_t*)(ws + off); bf16_t* a2 = (bf16_t*)(ws + WS_A2);
        const bool rot = (seg == 4 || seg == 5) && ((wc & 1) == 0) && (fq < 2);
        const float sc = (seg == 1 || seg == 4) ? 0.18033688011112042f : 1.f;
#pragma unroll
        for (int ai = 0; ai < 2; ++ai) {
            f32x2_t rc[4][4];
            if (rot) {
#pragma unroll
                for (int m = 0; m < 4; ++m) { const f32x2_t* cs = rope + (size_t)(u.pm * BM + ai * HALF + wr * 64 + m * 16 + fr) * 8 + 4 * fq;
#pragma unroll
                    for (int k = 0; k < 4; ++k) rc[m][k] = cs[k]; }
            }
            __builtin_amdgcn_sched_barrier(0);
#pragma unroll
            for (int m = 0; m < 4; ++m) {
                const int row = u.pm * BM + ai * HALF + wr * 64 + m * 16 + fr; const float rr = rt[ai * HALF + wr * 64 + m * 16 + fr] * sc;
#pragma unroll
                for (int bj = 0; bj < 2; ++bj) {
                    const int cs = cbase + bj * HALF; f32x4 v0 = acc[ai][bj][m][0] * rr, v1 = acc[ai][bj][m][1] * rr;
                    if (seg == 0) {
                        const int g = cs >> 4, ci = cs & 15, b = row >> 12, t = row & 4095, c = t >> 5, s = t & 31;
                        st8(a2 + ((size_t)(g * SSM_M2 + b * SSM_NC + c) * SSM_K2 + s * 16 + ci), v0, v1);
                    } else if (rot) {
#pragma unroll
                        for (int k = 0; k < 4; ++k) { const float t1 = v0[k], t2 = v1[k]; v0[k] = t1 * rc[m][k].x - t2 * rc[m][k].y; v1[k] = t2 * rc[m][k].x + t1 * rc[m][k].y; }
                        bf16_t* dp = base + (size_t)row * 512 + (cs - 8 * fq) + 4 * fq;
                        *(unsigned long long*)dp = (unsigned long long)pk2(v0[0], v0[1]) | ((unsigned long long)pk2(v0[2], v0[3]) << 32);
                        *(unsigned long long*)(dp + 8) = (unsigned long long)pk2(v1[0], v1[1]) | ((unsigned long long)pk2(v1[2], v1[3]) << 32);
                    } else {
                        st8(base + (size_t)row * 512 + cs, v0, v1);
                    }
                }
            }
        }
    }
};
struct EpiMemKV {
    static constexpr bool PERM = true, NEEDS_R = false;
    bf16_t* kv;
    DI void operator()(const AccT& acc, const Unit& u, int wr, int wc, int fr, int fq, const LAS float* rt) const {
        const int colt = u.pn * BM; bf16_t* base = kv + (size_t)(u.z * 2 + (colt >> 9)) * 2048 * 512; const int cbase = (colt & 511) + wc * 32 + 8 * fq;
#pragma unroll
        for (int ai = 0; ai < 2; ++ai)
#pragma unroll
            for (int m = 0; m < 4; ++m) { const int row = u.pm * BM + ai * HALF + wr * 64 + m * 16 + fr;
#pragma unroll
                for (int bj = 0; bj < 2; ++bj) st8(base + (size_t)row * 512 + cbase + bj * HALF, acc[ai][bj][m][0], acc[ai][bj][m][1]); }
    }
};
template <int ACT, bool RS> struct EpiBf16 {
    static constexpr bool PERM = true, NEEDS_R = RS;
    bf16_t* O; int ldc; float scale; const float* part;
    DI void operator()(const AccT& acc, const Unit& u, int wr, int wc, int fr, int fq, const LAS float* rt) const {
        const int col0 = u.pn * BM + wc * 32 + 8 * fq;
#pragma unroll
        for (int ai = 0; ai < 2; ++ai)
#pragma unroll
            for (int m = 0; m < 4; ++m) { const int row = u.pm * BM + ai * HALF + wr * 64 + m * 16 + fr; const float rr = RS ? rt[ai * HALF + wr * 64 + m * 16 + fr] * scale : scale;
#pragma unroll
                for (int bj = 0; bj < 2; ++bj) { f32x4 v0 = acc[ai][bj][m][0] * rr, v1 = acc[ai][bj][m][1] * rr;
                    if (ACT == 1) {
#pragma unroll
                        for (int k = 0; k < 4; ++k) { v0[k] = sigmoidf_(v0[k]); v1[k] = sigmoidf_(v1[k]); } }
                    if (ACT == 2) {
#pragma unroll
                        for (int k = 0; k < 4; ++k) { const float a = fmaxf(v0[k], 0.f), b = fmaxf(v1[k], 0.f); v0[k] = a * a; v1[k] = b * b; } }
                    st8(O + (size_t)row * ldc + col0 + bj * HALF, v0, v1); } }
    }
};
struct EpiGlu {
    static constexpr bool PERM = true, NEEDS_R = false;
    bf16_t* O;
    DI void operator()(const AccT& acc, const Unit& u, int wr, int wc, int fr, int fq, const LAS float* rt) const {
        const int col0 = u.pn * HALF + wc * 32 + 8 * fq;
#pragma unroll
        for (int ai = 0; ai < 2; ++ai)
#pragma unroll
            for (int m = 0; m < 4; ++m) { const int row = u.pm * BM + ai * HALF + wr * 64 + m * 16 + fr;
                f32x4 v0, v1;
#pragma unroll
                for (int k = 0; k < 4; ++k) { v0[k] = acc[ai][0][m][0][k] * sigmoidf_(acc[ai][1][m][0][k]); v1[k] = acc[ai][0][m][1][k] * sigmoidf_(acc[ai][1][m][1][k]); }
                st8(O + (size_t)row * 512 + col0, v0, v1); }
    }
};
struct EpiSloc {
    static constexpr bool PERM = true, NEEDS_R = false;
    float* S;
    DI void operator()(const AccT& acc, const Unit& u, int wr, int wc, int fr, int fq, const LAS float* rt) const {
        const int col0 = wc * 32 + 8 * fq;
#pragma unroll
        for (int ai = 0; ai < 2; ++ai)
#pragma unroll
            for (int m = 0; m < 4; ++m) { const int row = u.pm * BM + ai * HALF + wr * 64 + m * 16 + fr;
                float* p = S + ((size_t)(u.z * SSM_M2 + row) * 128 + col0);
                *(f32x4*)p = acc[ai][0][m][0]; *(f32x4*)(p + 4) = acc[ai][0][m][1]; }
    }
};
struct EpiGelu {
    static constexpr bool PERM = true, NEEDS_R = false;
    bf16_t* Y;
    DI void operator()(const AccT& acc, const Unit& u, int wr, int wc, int fr, int fq, const LAS float* rt) const {
        const int col0 = u.pn * BM + wc * 32 + 8 * fq;
#pragma unroll
        for (int ai = 0; ai < 2; ++ai)
#pragma unroll
            for (int m = 0; m < 4; ++m) { const int row = u.pm * BM + ai * HALF + wr * 64 + m * 16 + fr; const int b = row >> 7, c = row & 127;
#pragma unroll
                for (int bj = 0; bj < 2; ++bj) { const int n = col0 + bj * HALF, t = n >> 4, co = n & 15;
                    f32x4 v0 = acc[ai][bj][m][0], v1 = acc[ai][bj][m][1];
#pragma unroll
                    for (int k = 0; k < 4; ++k) { float x = v0[k]; v0[k] = x * __builtin_amdgcn_rcpf(1.f + __builtin_amdgcn_exp2f(x * (-2.3022082f - 0.10294324f * (x * x))));
                        x = v1[k]; v1[k] = x * __builtin_amdgcn_rcpf(1.f + __builtin_amdgcn_exp2f(x * (-2.3022082f - 0.10294324f * (x * x)))); }
                    st8(Y + ((size_t)(b * SEQ + c * SSM_T + t) * 512 + u.z * 16 + co), v0, v1); } }
    }
};
struct EpiMerge {
    static constexpr bool PERM = true, NEEDS_R = false;
    const bf16_t* gates; bf16_t* O;
    DI void operator()(const AccT& acc, const Unit& u, int wr, int wc, int fr, int fq, const LAS float* rt) const {
        const int col0 = u.pn * BM + wc * 32 + 8 * fq;
#pragma unroll
        for (int ai = 0; ai < 2; ++ai) {
            u32x4 gw[4][2], pw[4][2];
#pragma unroll
            for (int m = 0; m < 4; ++m) { const int row = u.pm * BM + ai * HALF + wr * 64 + m * 16 + fr;
#pragma unroll
                for (int bj = 0; bj < 2; ++bj) { const int col = col0 + bj * HALF;
                    gw[m][bj] = *(const u32x4*)(gates + (size_t)row * 3072 + u.z * 1024 + col);
                    if (u.z > 0) pw[m][bj] = *(const u32x4*)(O + (size_t)row * 1024 + col); else pw[m][bj] = (u32x4){0u, 0u, 0u, 0u}; } }
            __builtin_amdgcn_sched_barrier(0);
#pragma unroll
            for (int m = 0; m < 4; ++m) { const int row = u.pm * BM + ai * HALF + wr * 64 + m * 16 + fr;
#pragma unroll
                for (int bj = 0; bj < 2; ++bj) { const int col = col0 + bj * HALF; const u32x4 g4 = gw[m][bj], p4 = pw[m][bj];
                    f32x4 v0 = acc[ai][bj][m][0], v1 = acc[ai][bj][m][1];
                    v0[0] = v0[0] * bf2f(g4.x & 0xffffu) + bf2f(p4.x & 0xffffu); v0[1] = v0[1] * bf2f(g4.x >> 16) + bf2f(p4.x >> 16);
                    v0[2] = v0[2] * bf2f(g4.y & 0xffffu) + bf2f(p4.y & 0xffffu); v0[3] = v0[3] * bf2f(g4.y >> 16) + bf2f(p4.y >> 16);
                    v1[0] = v1[0] * bf2f(g4.z & 0xffffu) + bf2f(p4.z & 0xffffu); v1[1] = v1[1] * bf2f(g4.z >> 16) + bf2f(p4.z >> 16);
                    v1[2] = v1[2] * bf2f(g4.w & 0xffffu) + bf2f(p4.w & 0xffffu); v1[3] = v1[3] * bf2f(g4.w >> 16) + bf2f(p4.w >> 16);
                    st8(O + (size_t)row * 1024 + col, v0, v1); } }
        }
    }
};
struct EpiResid {
    static constexpr bool PERM = true, NEEDS_R = false;
    const float* base; float* out; bf16_t* hb; const float* gain; float* part;
    DI void operator()(const AccT& acc, const Unit& u, int wr, int wc, int fr, int fq, const LAS float* rt) const {
        const int col0 = u.pn * BM + wc * 32 + 8 * fq;
        f32x4 gv[2][2];
#pragma unroll
        for (int bj = 0; bj < 2; ++bj) { gv[bj][0] = *(const f32x4*)(gain + col0 + bj * HALF); gv[bj][1] = *(const f32x4*)(gain + col0 + bj * HALF + 4); }
#pragma unroll
        for (int ai = 0; ai < 2; ++ai)
#pragma unroll
            for (int mh = 0; mh < 2; ++mh) {
                f32x4 bx[2][2][2];
#pragma unroll
                for (int mm = 0; mm < 2; ++mm) { const int row = u.pm * BM + ai * HALF + wr * 64 + (mh * 2 + mm) * 16 + fr;
#pragma unroll
                    for (int bj = 0; bj < 2; ++bj) { const size_t o = (size_t)row * DM + col0 + bj * HALF; bx[mm][bj][0] = *(const f32x4*)(base + o); bx[mm][bj][1] = *(const f32x4*)(base + o + 4); } }
                __builtin_amdgcn_sched_barrier(0);
#pragma unroll
                for (int mm = 0; mm < 2; ++mm) { const int m = mh * 2 + mm; const int row = u.pm * BM + ai * HALF + wr * 64 + m * 16 + fr; float ss = 0.f;
#pragma unroll
                    for (int bj = 0; bj < 2; ++bj) { const size_t o = (size_t)row * DM + col0 + bj * HALF;
                        const f32x4 x0 = bx[mm][bj][0] + acc[ai][bj][m][0], x1 = bx[mm][bj][1] + acc[ai][bj][m][1];
                        *(f32x4*)(out + o) = x0; *(f32x4*)(out + o + 4) = x1;
                        ss += (x0[0] * x0[0] + x0[1] * x0[1]) + (x0[2] * x0[2] + x0[3] * x0[3]) + (x1[0] * x1[0] + x1[1] * x1[1]) + (x1[2] * x1[2] + x1[3] * x1[3]);
                        st8(hb + o, x0 * gv[bj][0], x1 * gv[bj][1]); }
                    ss += __shfl_xor(ss, 16); ss += __shfl_xor(ss, 32);
                    if (fq == 0) part[(size_t)row * 16 + u.pn * 4 + wc] = ss; }
            }
    }
};

struct GmArgs { const bf16_t* Ah; const bf16_t* Wg; const bf16_t* Y; long zY; const bf16_t* Wb; bf16_t* gs; bf16_t* O; const float* part; };
DI void gm_unit_info(const GmArgs& a, const Unit& u, const char*& cA, const char*& cB, int& ld, int& nt) {
    const int z = u.z >> 1;
    if (u.z & 1) { ld = 512; nt = 8; cA = (const char*)(a.Y + (size_t)z * a.zY) + (size_t)u.pm * 256 * 512 * 2; cB = (const char*)a.Wb + ((size_t)z * 1024 + u.pn * 256) * 512 * 2; }
    else { ld = 1024; nt = 16; cA = (const char*)a.Ah + (size_t)u.pm * 256 * 1024 * 2; cB = (const char*)a.Wg + ((size_t)z * 1024 + u.pn * 256) * 1024 * 2; }
}
DI void gm_epilogue(const GmArgs& a, const AccT& acc, const Unit& u, int wr, int wc, int fr, int fq, const LAS float* rt) {
    const int z = u.z >> 1; const int colL = wc * 32 + 8 * fq;
    bf16_t* gsb = a.gs + (size_t)blockIdx.x * 65536;
    if (!(u.z & 1)) {
#pragma unroll
        for (int ai = 0; ai < 2; ++ai)
#pragma unroll
            for (int m = 0; m < 4; ++m) { const int rl = ai * HALF + wr * 64 + m * 16 + fr; const float rrn = rt[rl] * -1.4426950408889634f;
#pragma unroll
                for (int bj = 0; bj < 2; ++bj) { f32x4 v0 = acc[ai][bj][m][0] * rrn, v1 = acc[ai][bj][m][1] * rrn;
#pragma unroll
                    for (int k = 0; k < 4; ++k) { v0[k] = __builtin_amdgcn_rcpf(1.f + __builtin_amdgcn_exp2f(v0[k])); v1[k] = __builtin_amdgcn_rcpf(1.f + __builtin_amdgcn_exp2f(v1[k])); }
                    st8(gsb + rl * 256 + colL + bj * HALF, v0, v1); } }
    } else {
#pragma unroll
        for (int ai = 0; ai < 2; ++ai) {
            u32x4 gw[4][2], pw[4][2];
#pragma unroll
            for (int m = 0; m < 4; ++m) { const int rl = ai * HALF + wr * 64 + m * 16 + fr; const int row = u.pm * BM + rl;
#pragma unroll
                for (int bj = 0; bj < 2; ++bj) { const int col = u.pn * BM + colL + bj * HALF;
                    gw[m][bj] = *(const u32x4*)(gsb + rl * 256 + colL + bj * HALF);
                    if (z > 0) pw[m][bj] = *(const u32x4*)(a.O + (size_t)row * 1024 + col); else pw[m][bj] = (u32x4){0u, 0u, 0u, 0u}; } }
            __builtin_amdgcn_sched_barrier(0);
#pragma unroll
            for (int m = 0; m < 4; ++m) { const int rl = ai * HALF + wr * 64 + m * 16 + fr; const int row = u.pm * BM + rl;
#pragma unroll
                for (int bj = 0; bj < 2; ++bj) { const int col = u.pn * BM + colL + bj * HALF; const u32x4 g4 = gw[m][bj], p4 = pw[m][bj];
                    f32x4 v0 = acc[ai][bj][m][0], v1 = acc[ai][bj][m][1];
                    v0[0] = v0[0] * bf2f(g4.x & 0xffffu) + bf2f(p4.x & 0xffffu); v0[1] = v0[1] * bf2f(g4.x >> 16) + bf2f(p4.x >> 16);
                    v0[2] = v0[2] * bf2f(g4.y & 0xffffu) + bf2f(p4.y & 0xffffu); v0[3] = v0[3] * bf2f(g4.y >> 16) + bf2f(p4.y >> 16);
                    v1[0] = v1[0] * bf2f(g4.z & 0xffffu) + bf2f(p4.z & 0xffffu); v1[1] = v1[1] * bf2f(g4.z >> 16) + bf2f(p4.z >> 16);
                    v1[2] = v1[2] * bf2f(g4.w & 0xffffu) + bf2f(p4.w & 0xffffu); v1[3] = v1[3] * bf2f(g4.w >> 16) + bf2f(p4.w >> 16);
                    st8(a.O + (size_t)row * 1024 + col, v0, v1); } }
        }
    }
}
struct SchedGM {
    int nM, nN, G, c;
    DI bool next(int i, Unit& u) const { const long L = (long)(i / 6) * G + c; if (L >= (long)nM * nN) return false; tile_decode((int)L, nM, nN, u.pm, u.pn); u.z = i % 6; return true; }
};
DI void gemm_phase_gm(LAS unsigned char* lds, const GmArgs ga, const SchedGM& S) {
    const int tid = opaque(threadIdx.x), wid = __builtin_amdgcn_readfirstlane(tid >> 6), lane = tid & 63, wr = wid >> 2, wc = wid & 3, fr = lane & 15, fq = lane >> 4;
    unsigned RA2, RB2, C2;
    { int R, C; stage_rc(tid * 16, R, C); const int Rb = (R & ~31) + perm32(R & 31); RA2 = (unsigned)R * 2u; RB2 = (unsigned)Rb * 2u; C2 = (unsigned)C * 2u; }
    const size_t kstep = (size_t)(BK * 2);
    const unsigned ldsw = (unsigned)wid * 1024u;
    const int aoff = lds_byte(wr * 64 + fr, fq * 8), boff = lds_byte(wc * 32 + fr, fq * 8);
#define PG8_SA(b, h) (((b) * 2 + (h)) * HTB)
#define PG8_SB(b, h) ((4 + (b) * 2 + (h)) * HTB)
#define GM_STAGE(bufoff, gbase, R2, ld_) do { _Pragma("unroll") for (int _i = 0; _i < 2; ++_i) \
        __builtin_amdgcn_global_load_lds((const unsigned*)((const char*)(gbase) + (size_t)_i * 128 * (size_t)(ld_) + ((R2) * (unsigned)(ld_) + C2)), (LAS unsigned*)(lds + (bufoff) + ldsw + _i * 8192), 16, 0, 0); } while (0)
#define PG8_LDA(dst, b, h) do { _Pragma("unroll") for (int m = 0; m < 4; ++m) _Pragma("unroll") for (int k = 0; k < 2; ++k) dst[m][k] = *(const LAS bf16x8*)(lds + PG8_SA(b, h) + aoff + m * 2048 + k * 1024); } while (0)
#define PG8_LDB(dst, b, h) do { _Pragma("unroll") for (int n = 0; n < 2; ++n) _Pragma("unroll") for (int k = 0; k < 2; ++k) dst[n][k] = *(const LAS bf16x8*)(lds + PG8_SB(b, h) + boff + n * 2048 + k * 1024); } while (0)
#define PG8_MMA(ai, bj, At, Bt) do { __builtin_amdgcn_s_setprio(1); _Pragma("unroll") for (int m = 0; m < 4; ++m) _Pragma("unroll") for (int n = 0; n < 2; ++n) _Pragma("unroll") for (int k = 0; k < 2; ++k) \
        acc[ai][bj][m][n] = __builtin_amdgcn_mfma_f32_16x16x32_bf16(Bt[n][k], At[m][k], acc[ai][bj][m][n], 0, 0, 0); __builtin_amdgcn_s_setprio(0); } while (0)
#define PG8_WAIT_V(n) asm volatile("s_waitcnt vmcnt(" #n ")" ::: "memory")
#define PG8_WAIT_L(n) asm volatile("s_waitcnt lgkmcnt(" #n ")" ::: "memory")
#define PG8_BAR __builtin_amdgcn_s_barrier()
#define PG8_SCHED __builtin_amdgcn_sched_barrier(0)
#define GM_RFILL(u_, ui_) do { if (tid < 256) { const f32x4* pp_ = (const f32x4*)(ga.part + (size_t)((u_).pm * BM + tid) * 16); \
        const f32x4 a_ = pp_[0], b_ = pp_[1], c_ = pp_[2], d_ = pp_[3]; const f32x4 s_ = (a_ + b_) + (c_ + d_); \
        ((LAS float*)(lds + STAGE_BYTES))[(ui_) * 256 + tid] = rsqrtf(((s_[0] + s_[1]) + (s_[2] + s_[3])) * (1.f / DM) + RMS_EPS); } } while (0)
    Unit cur, nxt; int ui = 0;
    if (!S.next(0, cur)) return;
    { Unit uu; for (int i = 0; i < 8 && S.next(6 * i, uu); ++i) GM_RFILL(uu, i); }
    f32x4 acc[2][2][4][2];
#pragma unroll
    for (int a = 0; a < 2; ++a)
#pragma unroll
        for (int b = 0; b < 2; ++b)
#pragma unroll
            for (int m = 0; m < 4; ++m)
#pragma unroll
                for (int n = 0; n < 2; ++n) acc[a][b][m][n] = (f32x4){0.f, 0.f, 0.f, 0.f};
    bf16x8 At[4][2], B0[2][2], B1[2][2];
    const char* cA; const char* cB; int ldc_, nt;
    gm_unit_info(ga, cur, cA, cB, ldc_, nt);
    size_t hsc = (size_t)HALF * ldc_ * 2;
    GM_STAGE(PG8_SB(0, 0), cB, RB2, ldc_); GM_STAGE(PG8_SB(0, 1), cB + hsc, RB2, ldc_); GM_STAGE(PG8_SA(0, 0), cA, RA2, ldc_); GM_STAGE(PG8_SA(0, 1), cA + hsc, RA2, ldc_);
    if (wr == 1) PG8_BAR;
    PG8_WAIT_V(2); PG8_BAR;
    GM_STAGE(PG8_SB(1, 0), cB + kstep, RB2, ldc_); GM_STAGE(PG8_SA(1, 0), cA + kstep, RA2, ldc_); GM_STAGE(PG8_SB(1, 1), cB + hsc + kstep, RB2, ldc_);
    PG8_WAIT_V(6); PG8_BAR;
    for (;;) {
        const bool has_next = S.next(ui + 1, nxt);
        const char* nA = cA; const char* nB = cB; int ldn = ldc_, ntn = nt;
        if (has_next) gm_unit_info(ga, nxt, nA, nB, ldn, ntn);
        const size_t hsn = (size_t)HALF * ldn * 2;
        for (int t = 0; t < nt; t += 2) {
            const bool last = (t == nt - 2);
            const char* a1 = cA + (size_t)(t + 1) * kstep;
            const char* a2 = last ? nA : cA + (size_t)(t + 2) * kstep; const char* b2 = last ? nB : cB + (size_t)(t + 2) * kstep;
            const char* a3 = a2 + kstep; const char* b3 = b2 + kstep;
            const int ld2 = last ? ldn : ldc_; const size_t hs2 = last ? hsn : hsc;
            PG8_LDB(B0, 0, 0); PG8_LDB(B1, 0, 1); PG8_SCHED; PG8_LDA(At, 0, 0); GM_STAGE(PG8_SA(1, 1), a1 + hsc, RA2, ldc_);
            PG8_WAIT_V(8); PG8_WAIT_L(0); PG8_BAR; PG8_MMA(0, 0, At, B0); PG8_MMA(0, 1, At, B1); PG8_BAR; PG8_SCHED;
            PG8_LDA(At, 0, 1); GM_STAGE(PG8_SB(0, 0), b2, RB2, ld2); GM_STAGE(PG8_SB(0, 1), b2 + hs2, RB2, ld2); GM_STAGE(PG8_SA(0, 0), a2, RA2, ld2);
            PG8_WAIT_V(8); PG8_WAIT_L(0); PG8_BAR; PG8_MMA(1, 0, At, B0); PG8_MMA(1, 1, At, B1); PG8_BAR; PG8_SCHED;
            PG8_LDB(B0, 1, 0); PG8_LDB(B1, 1, 1); PG8_SCHED; PG8_LDA(At, 1, 0); GM_STAGE(PG8_SA(0, 1), a2 + hs2, RA2, ld2);
            PG8_WAIT_V(8); PG8_WAIT_L(0); PG8_BAR; PG8_MMA(0, 0, At, B0); PG8_MMA(0, 1, At, B1); PG8_BAR; PG8_SCHED;
            PG8_LDA(At, 1, 1); GM_STAGE(PG8_SB(1, 0), b3, RB2, ld2); GM_STAGE(PG8_SB(1, 1), b3 + hs2, RB2, ld2); GM_STAGE(PG8_SA(1, 0), a3, RA2, ld2);
            PG8_WAIT_V(8); PG8_WAIT_L(0); PG8_BAR; PG8_MMA(1, 0, At, B0); PG8_MMA(1, 1, At, B1); PG8_BAR; PG8_SCHED;
        }
        if (wr == 0) PG8_BAR;
        gm_epilogue(ga, acc, cur, wr, wc, fr, fq, (const LAS float*)(lds + STAGE_BYTES) + ((ui / 6) & 7) * 256);
        if (!has_next) break;
#pragma unroll
        for (int a = 0; a < 2; ++a)
#pragma unroll
            for (int b = 0; b < 2; ++b)
#pragma unroll
                for (int m = 0; m < 4; ++m)
#pragma unroll
                    for (int n = 0; n < 2; ++n) acc[a][b][m][n] = (f32x4){0.f, 0.f, 0.f, 0.f};
        cur = nxt; cA = nA; cB = nB; ldc_ = ldn; nt = ntn; hsc = hsn; ++ui;
        if (wr == 1) PG8_BAR;
    }
    PG8_WAIT_V(0);
    PG8_BAR;
#undef GM_RFILL
#undef GM_STAGE
#undef PG8_SA
#undef PG8_SB
#undef PG8_LDA
#undef PG8_LDB
#undef PG8_MMA
#undef PG8_WAIT_V
#undef PG8_WAIT_L
#undef PG8_BAR
#undef PG8_SCHED
}
}

DI f32x16 mfma32(bf16x8 a, bf16x8 b, f32x16 c) { return __builtin_amdgcn_mfma_f32_32x32x16_bf16(a, b, c, 0, 0, 0); }
DI s16x4 vtr(const LAS unsigned char* p) { return __builtin_bit_cast(s16x4, __builtin_amdgcn_ds_read_tr16_b64_v4i16((LAS v4i16_t*)p)); }
DI int crow(int r, int hi) { return (r & 3) + 8 * (r >> 2) + 4 * hi; }
DI bf16x8 pack8(const float* w) { u32x4 p; p.x = pk2(w[0], w[1]); p.y = pk2(w[2], w[3]); p.z = pk2(w[4], w[5]); p.w = pk2(w[6], w[7]); return __builtin_bit_cast(bf16x8, p); }

template <bool MASK>
DI void sb_block(const f32x16& p, int kvbase, int qrow, int hi, float& carry, bf16x8& f0, bf16x8& f1) {
    float bt[16], om[16];
#pragma unroll
    for (int i = 0; i < 16; ++i) { const float e = __builtin_amdgcn_exp2f(-p[i]); float b = __builtin_amdgcn_rcpf(1.f + e); float o = 1.f - b;
        if (MASK) { const bool valid = (kvbase + crow(i, hi) < qrow); b = valid ? b : 0.f; o = valid ? o : 1.f; }
        bt[i] = b; om[i] = o; }
    float plo[4], phi[4];
#pragma unroll
    for (int g = 0; g < 4; ++g) { const float gp = (om[4 * g] * om[4 * g + 1]) * (om[4 * g + 2] * om[4 * g + 3]);
        auto rr = __builtin_amdgcn_permlane32_swap(__float_as_uint(gp), __float_as_uint(gp), false, false);
        plo[g] = __uint_as_float(rr[0]); phi[g] = __uint_as_float(rr[1]); }
    float T[4]; T[3] = 1.f; T[2] = plo[3] * phi[3]; T[1] = T[2] * (plo[2] * phi[2]); T[0] = T[1] * (plo[1] * phi[1]);
    const float tot = T[0] * (plo[0] * phi[0]);
    float w[16];
#pragma unroll
    for (int g = 0; g < 4; ++g) { const float w3 = carry * T[g] * (hi ? 1.f : phi[g]);
        const float w2 = w3 * om[4 * g + 3], w1 = w2 * om[4 * g + 2], w0 = w1 * om[4 * g + 1];
        w[4 * g + 3] = bt[4 * g + 3] * w3; w[4 * g + 2] = bt[4 * g + 2] * w2; w[4 * g + 1] = bt[4 * g + 1] * w1; w[4 * g] = bt[4 * g] * w0; }
    carry *= tot;
    f0 = pack8(w); f1 = pack8(w + 8);
}

constexpr int SB_KP = 144, SB_VP = 192, SB_FLAGS = 2 * 64 * SB_KP + 2 * 64 * SB_VP;
DI void sb_unit(int b, int h, int qb, const bf16_t* QO, bf16_t* Ob, const bf16_t* K, const bf16_t* V, LAS unsigned char* lds) {
    const int tid = opaque(threadIdx.x), lane = tid & 63, wid = __builtin_amdgcn_readfirstlane(tid >> 6), r32 = lane & 31, hi = lane >> 5;
    const size_t rowbase = (size_t)b * SEQ;
    const int q0w = qb * 256 + wid * 32, qrow = q0w + r32;
    const bf16_t* qp = QO + (rowbase + qrow) * 512 + h * 64;
    bf16x8 qf[4];
#pragma unroll
    for (int ks = 0; ks < 4; ++ks) qf[ks] = *(const bf16x8*)(qp + ks * 16 + hi * 8);
    const int nt = 4 * qb + 4;
    const int lrow = tid >> 3, lch = tid & 7;
    const bf16_t* kg = K + (rowbase + lrow) * 512 + h * 64 + lch * 8;
    const bf16_t* vg = V + (rowbase + lrow) * 512 + h * 64 + lch * 8;
    LAS unsigned char* Kb = lds; LAS unsigned char* Vb = lds + 2 * 64 * SB_KP;
    LAS unsigned char* flags = lds + SB_FLAGS;
    const int kst = lrow * SB_KP + lch * 16, vst = lrow * SB_VP + lch * 16;
    u32x4 kr = *(const u32x4*)(kg + (size_t)(nt - 1) * 64 * 512), vr = *(const u32x4*)(vg + (size_t)(nt - 1) * 64 * 512);
    *(LAS u32x4*)(Kb + kst) = kr; *(LAS u32x4*)(Vb + vst) = vr;
    __syncthreads();
    f32x16 o0, o1;
#pragma unroll
    for (int i = 0; i < 16; ++i) { o0[i] = 0.f; o1[i] = 0.f; }
    float carry = 1.f; int cur = 0;
    const int vlane = (4 * hi + ((lane & 15) >> 2)) * SB_VP + (16 * ((lane >> 4) & 1) + 4 * (lane & 3)) * 2;
    for (int t = nt - 1; t >= 0; --t) {
        if (t > 0) { kr = *(const u32x4*)(kg + (size_t)(t - 1) * 64 * 512); vr = *(const u32x4*)(vg + (size_t)(t - 1) * 64 * 512); }
        const LAS unsigned char* Kc = Kb + cur * 64 * SB_KP; const LAS unsigned char* Vc = Vb + cur * 64 * SB_VP;
        const bool wdone = !__any(carry >= 1e-30f);
        if (64 * t < q0w + 31 && !wdone) {
            f32x16 p0, p1;
#pragma unroll
            for (int i = 0; i < 16; ++i) { p0[i] = 0.f; p1[i] = 0.f; }
            { bf16x8 a0[4], a1[4];
#pragma unroll
              for (int ks = 0; ks < 4; ++ks) { a0[ks] = *(const LAS bf16x8*)(Kc + r32 * SB_KP + (ks * 16 + hi * 8) * 2); a1[ks] = *(const LAS bf16x8*)(Kc + (32 + r32) * SB_KP + (ks * 16 + hi * 8) * 2); }
              __builtin_amdgcn_sched_barrier(0);
#pragma unroll
              for (int ks = 0; ks < 4; ++ks) { p0 = mfma32(a0[ks], qf[ks], p0); p1 = mfma32(a1[ks], qf[ks], p1); } }
            s16x4 vlo[8], vhh[8];
#pragma unroll
            for (int kk = 0; kk < 4; ++kk) { const LAS unsigned char* vp = Vc + vlane + 16 * kk * SB_VP;
                vlo[2 * kk] = vtr(vp); vhh[2 * kk] = vtr(vp + 8 * SB_VP); vlo[2 * kk + 1] = vtr(vp + 64); vhh[2 * kk + 1] = vtr(vp + 64 + 8 * SB_VP); }
            __builtin_amdgcn_sched_barrier(0);
            bf16x8 fr[4];
            if (64 * t + 63 >= q0w) { sb_block<true>(p1, 64 * t + 32, qrow, hi, carry, fr[2], fr[3]); sb_block<true>(p0, 64 * t, qrow, hi, carry, fr[0], fr[1]); }
            else { sb_block<false>(p1, 64 * t + 32, qrow, hi, carry, fr[2], fr[3]); sb_block<false>(p0, 64 * t, qrow, hi, carry, fr[0], fr[1]); }
            __builtin_amdgcn_sched_barrier(0);
#pragma unroll
            for (int kk = 0; kk < 4; ++kk) {
                { const bf16x8 vb = __builtin_shufflevector(vlo[2 * kk], vhh[2 * kk], 0, 1, 2, 3, 4, 5, 6, 7); o0 = mfma32(fr[kk], vb, o0); }
                { const bf16x8 vb = __builtin_shufflevector(vlo[2 * kk + 1], vhh[2 * kk + 1], 0, 1, 2, 3, 4, 5, 6, 7); o1 = mfma32(fr[kk], vb, o1); }
            }
        }
        if (lane == 0) flags[(t & 1) * 8 + wid] = __any(carry >= 1e-30f) ? 0 : 1;
        if (t > 0) { *(LAS u32x4*)(Kb + (cur ^ 1) * 64 * SB_KP + kst) = kr; *(LAS u32x4*)(Vb + (cur ^ 1) * 64 * SB_VP + vst) = vr; }
        __syncthreads(); cur ^= 1;
        const unsigned long long fl = *(const LAS unsigned long long*)(flags + (t & 1) * 8);
        if (fl == 0x0101010101010101ull) break;
    }
    bf16_t* ob = Ob + (rowbase + q0w) * 512 + h * 64 + r32;
#pragma unroll
    for (int i = 0; i < 16; ++i) { const int r = crow(i, hi); ob[(size_t)r * 512] = f2bf(o0[i]); ob[(size_t)r * 512 + 32] = f2bf(o1[i]); }
}

constexpr int A2_KP = 272, A2_VP = 320, A2_WS = 2 * 64 * A2_KP + 2 * 64 * A2_VP;
DI void bcast_rows(LAS float* wsf, float v, int r32, int hi, float (&out)[16]) {
    if (hi == 0) wsf[r32] = v;
    asm volatile("s_waitcnt lgkmcnt(0)" ::: "memory");
#pragma unroll
    for (int i = 0; i < 16; ++i) out[i] = wsf[crow(i, hi)];
    asm volatile("s_waitcnt lgkmcnt(0)" ::: "memory");
}
DI float half_swap_max(float m) { auto rr = __builtin_amdgcn_permlane32_swap(__float_as_uint(m), __float_as_uint(m), false, false); return fmaxf(__uint_as_float(rr[0]), __uint_as_float(rr[1])); }
DI float half_swap_sum(float m) { auto rr = __builtin_amdgcn_permlane32_swap(__float_as_uint(m), __float_as_uint(m), false, false); return __uint_as_float(rr[0]) + __uint_as_float(rr[1]); }

template <bool DIFF>
DI void attn2_unit(int qb, const bf16_t* QO  , bf16_t* Ob, const bf16_t* K, const bf16_t* V  ,
                   int ntile, float lam, const float* gain, float post, LAS unsigned char* lds) {
    const int tid = opaque(threadIdx.x), lane = tid & 63, wid = __builtin_amdgcn_readfirstlane(tid >> 6), r32 = lane & 31, hi = lane >> 5;
    const int q0w = qb * 256 + wid * 32, qrow = q0w + r32;
    const bf16_t* qp = QO + (size_t)qrow * 512;
    LAS unsigned char* qst = lds + A2_WS + 2048 + wid * 8192 + lane * 16;
#pragma unroll
    for (int ks = 0; ks < 8; ++ks) *(LAS bf16x8*)(qst + ks * 1024) = *(const bf16x8*)(qp + ks * 16 + hi * 8);
    const int lrow = tid >> 3, lch = tid & 7;
    const bf16_t* kg = K + (size_t)lrow * 512 + lch * 16;
    const bf16_t* vg = V + (size_t)lrow * 512 + lch * 16;
    LAS unsigned char* Kb = lds; LAS unsigned char* Vb = lds + 2 * 64 * A2_KP;
    LAS float* wsf = (LAS float*)(lds + A2_WS) + wid * 64;
    const int kst = lrow * A2_KP + lch * 32, vst = lrow * A2_VP + lch * 32;
    const int vlane = (4 * hi + ((lane & 15) >> 2)) * A2_VP + (16 * ((lane >> 4) & 1) + 4 * (lane & 3)) * 2;
    constexpr int NC = DIFF ? 2 : 1;
    float mref[2] = {-1e30f, -1e30f}, ls[2] = {0.f, 0.f};
    bool ref0[2] = {false, false}, inited[2] = {false, false};
    f32x16 o1[4], o2[4];
#pragma unroll
    for (int d = 0; d < 4; ++d)
#pragma unroll
        for (int i = 0; i < 16; ++i) { o1[d][i] = 0.f; o2[d][i] = 0.f; }
    u32x4 kr0 = *(const u32x4*)(kg), kr1 = *(const u32x4*)(kg + 8), vr0 = *(const u32x4*)(vg), vr1 = *(const u32x4*)(vg + 8);
    *(LAS u32x4*)(Kb + kst) = kr0; *(LAS u32x4*)(Kb + kst + 16) = kr1; *(LAS u32x4*)(Vb + vst) = vr0; *(LAS u32x4*)(Vb + vst + 16) = vr1;
    __syncthreads();
    int cur = 0;
    for (int t = 0; t < ntile; ++t) {
        const bool more = (t + 1 < ntile);
        if (more) { const size_t go = (size_t)(t + 1) * 64 * 512; kr0 = *(const u32x4*)(kg + go); kr1 = *(const u32x4*)(kg + go + 8); vr0 = *(const u32x4*)(vg + go); vr1 = *(const u32x4*)(vg + go + 8); }
        const LAS unsigned char* Kc = Kb + cur * 64 * A2_KP; const LAS unsigned char* Vc = Vb + cur * 64 * A2_VP;
#pragma unroll
        for (int blk = 0; blk < 2; ++blk) {
            const int kv0 = 64 * t + 32 * blk;
            if (DIFF && kv0 > q0w + 31) continue;
            const bool diag = DIFF && (kv0 + 31 > q0w);
#pragma unroll
            for (int c = 0; c < NC; ++c) {
                f32x16 p;
#pragma unroll
                for (int i = 0; i < 16; ++i) p[i] = 0.f;
                constexpr int KS = DIFF ? 4 : 8;
                {
                    bf16x8 ka[KS], qa[KS];
#pragma unroll
                    for (int ks = 0; ks < KS; ++ks) { const int kk = c * 4 + ks;
                        ka[ks] = *(const LAS bf16x8*)(Kc + (32 * blk + r32) * A2_KP + (kk * 16 + hi * 8) * 2);
                        qa[ks] = *(const LAS bf16x8*)(qst + kk * 1024); }
                    __builtin_amdgcn_sched_barrier(0);
#pragma unroll
                    for (int ks = 0; ks < KS; ++ks) p = mfma32(ka[ks], qa[ks], p);
                }
                s16x4 vlo[8], vhh[8];
                { const LAS unsigned char* vp = Vc + vlane + 16 * (2 * blk) * A2_VP;
#pragma unroll
                    for (int d0 = 0; d0 < 4; ++d0) { vlo[d0] = vtr(vp + d0 * 64); vhh[d0] = vtr(vp + d0 * 64 + 8 * A2_VP); } }
                __builtin_amdgcn_sched_barrier(0);
                if (diag) {
#pragma unroll
                    for (int i = 0; i < 16; ++i) { if (kv0 + crow(i, hi) > qrow) p[i] = -1e30f; }
                }
                float mm = mref[c]; float w[16]; float sm = 0.f;
                if (ref0[c]) {
#pragma unroll
                    for (int i = 0; i < 16; ++i) { w[i] = __builtin_amdgcn_exp2f(p[i]); sm += w[i]; }
                } else {
#pragma unroll
                    for (int i = 0; i < 16; ++i) { w[i] = __builtin_amdgcn_exp2f(p[i] - mm); sm += w[i]; }
                }
                if (__any(!(sm <= (ref0[c] ? 1.0e30f : 256.f)))) {
                    float tm = fmaxf(p[0], p[1]);
#pragma unroll
                    for (int i = 2; i < 16; i += 2) tm = fmaxf(fmaxf(tm, p[i]), p[i + 1]);
                    tm = half_swap_max(tm);
                    if (!inited[c] && !__any(!(fabsf(tm) <= 40.f))) {
                        mref[c] = 0.f; mm = 0.f; ref0[c] = true;
                    } else {
                        const float mn = fmaxf(mref[c], tm); const float f = __builtin_amdgcn_exp2f(mref[c] - mn); ls[c] *= f; mref[c] = mn; mm = mn; ref0[c] = false;
                        float f16[16]; bcast_rows(wsf, f, r32, hi, f16);
                        if (c == 0) {
#pragma unroll
                            for (int d = 0; d < 4; ++d)
#pragma unroll
                                for (int i = 0; i < 16; ++i) o1[d][i] *= f16[i];
                        } else {
#pragma unroll
                            for (int d = 0; d < 4; ++d)
#pragma unroll
                                for (int i = 0; i < 16; ++i) o2[d][i] *= f16[i];
                        }
                    }
                    inited[c] = true;
                    sm = 0.f;
#pragma unroll
                    for (int i = 0; i < 16; ++i) { w[i] = __builtin_amdgcn_exp2f(p[i] - mm); sm += w[i]; }
                }
                ls[c] += sm;
                const bf16x8 fr0 = pack8(w), fr1 = pack8(w + 8);
                __builtin_amdgcn_sched_barrier(0);
                { const LAS unsigned char* vp = Vc + vlane + 16 * (2 * blk + 1) * A2_VP;
#pragma unroll
                    for (int d0 = 0; d0 < 4; ++d0) { vlo[4 + d0] = vtr(vp + d0 * 64); vhh[4 + d0] = vtr(vp + d0 * 64 + 8 * A2_VP); } }
                __builtin_amdgcn_sched_barrier(0);
#pragma unroll
                for (int s2 = 0; s2 < 2; ++s2) {
#pragma unroll
                    for (int d0 = 0; d0 < 4; ++d0) { const bf16x8 vb = __builtin_shufflevector(vlo[s2 * 4 + d0], vhh[s2 * 4 + d0], 0, 1, 2, 3, 4, 5, 6, 7);
                        if (c == 0) o1[d0] = mfma32(s2 ? fr1 : fr0, vb, o1[d0]); else o2[d0] = mfma32(s2 ? fr1 : fr0, vb, o2[d0]); }
                }
            }
        }
        if (more) { LAS unsigned char* kd = Kb + (cur ^ 1) * 64 * A2_KP + kst; *(LAS u32x4*)kd = kr0; *(LAS u32x4*)(kd + 16) = kr1;
            LAS unsigned char* vd = Vb + (cur ^ 1) * 64 * A2_VP + vst; *(LAS u32x4*)vd = vr0; *(LAS u32x4*)(vd + 16) = vr1; }
        __syncthreads(); cur ^= 1;
    }
    float a1[16], a2[16];
    { const float l1 = half_swap_sum(ls[0]); bcast_rows(wsf, 1.f / l1, r32, hi, a1); }
    if (DIFF) { const float l2 = half_swap_sum(ls[1]); bcast_rows(wsf, -lam / l2, r32, hi, a2); }
#pragma unroll
    for (int d = 0; d < 4; ++d)
#pragma unroll
        for (int i = 0; i < 16; ++i) { o1[d][i] *= a1[i]; if (DIFF) o1[d][i] += o2[d][i] * a2[i]; }
    bf16_t* ob = Ob + (size_t)q0w * 512 + r32;
    if (DIFF) {
        const float g0 = gain[r32] * post, g1 = gain[32 + r32] * post, g2 = gain[64 + r32] * post, g3 = gain[96 + r32] * post;
#pragma unroll
        for (int i = 0; i < 16; ++i) {
            float ss = o1[0][i] * o1[0][i] + o1[1][i] * o1[1][i] + o1[2][i] * o1[2][i] + o1[3][i] * o1[3][i];
            ss += __shfl_xor(ss, 1); ss += __shfl_xor(ss, 2); ss += __shfl_xor(ss, 4); ss += __shfl_xor(ss, 8); ss += __shfl_xor(ss, 16);
            const float rs = rsqrtf(ss * (1.f / 128.f) + RMS_EPS);
            bf16_t* rp = ob + (size_t)crow(i, hi) * 512;
            rp[0] = f2bf(o1[0][i] * rs * g0); rp[32] = f2bf(o1[1][i] * rs * g1); rp[64] = f2bf(o1[2][i] * rs * g2); rp[96] = f2bf(o1[3][i] * rs * g3);
        }
    } else {
#pragma unroll
        for (int i = 0; i < 16; ++i) { bf16_t* rp = ob + (size_t)crow(i, hi) * 512;
            rp[0] = f2bf(o1[0][i]); rp[32] = f2bf(o1[1][i]); rp[64] = f2bf(o1[2][i]); rp[96] = f2bf(o1[3][i]); }
    }
}

DI void transpose_item(const float* W, int K, int N, bf16_t* WT, int drow0, LAS float* scr, int k0, int n0, int lane, bool ropeperm) {
#pragma unroll
    for (int i = 0; i < 32; ++i) { const int kk = 2 * i + (lane >> 5); scr[kk * 33 + (lane & 31)] = W[(size_t)(k0 + kk) * N + n0 + (lane & 31)]; }
    asm volatile("s_waitcnt lgkmcnt(0)" ::: "memory");
    const int c = lane & 7;
#pragma unroll
    for (int j = 0; j < 4; ++j) { const int n = (lane >> 3) + 8 * j;
        int ns = n; if (ropeperm && n < 16) { const int gq = (n >> 2) & 3; ns = (n & 3) | ((gq == 1 ? 2 : gq == 2 ? 1 : gq) << 2); }
        const LAS float* s = scr + (8 * c) * 33 + ns;
        u32x4 o; o.x = pk2(s[0 * 33], s[1 * 33]); o.y = pk2(s[2 * 33], s[3 * 33]); o.z = pk2(s[4 * 33], s[5 * 33]); o.w = pk2(s[6 * 33], s[7 * 33]);
        *(u32x4*)(WT + (size_t)(drow0 + n) * K + k0 + 8 * c) = o; }
    asm volatile("s_waitcnt lgkmcnt(0)" ::: "memory");
}
DI void transpose_mat(const float* W, int K, int N, bf16_t* WT, bool glu, LAS float* scr, int gw, int ngw, int lane, int& goff, int rope_lo = -1, int rope_hi = -1) {
    lane = opaque(lane); gw = opaque_s(gw);
    const int nblk = N / 32, items = (K / 64) * nblk;
    int first = gw - (goff % ngw); if (first < 0) first += ngw;
    goff += items;
    for (int it = first; it < items; it += ngw) { const int kb = it / nblk, nb = it % nblk, n0 = nb * 32;
        int d0 = n0; if (glu) d0 = (n0 < 512) ? (n0 / 128) * 256 + (n0 % 128) : ((n0 - 512) / 128) * 256 + 128 + ((n0 - 512) % 128);
        transpose_item(W, K, N, WT, d0, scr, kb * 64, n0, lane, (n0 >= rope_lo) && (n0 < rope_hi) && ((n0 & 63) == 0)); }
}
DI void rms_row_bf16(const float* xrow, const float* gain, bf16_t* orow, int lane) {
    lane = opaque(lane);
    const f32x4* xr = (const f32x4*)xrow + lane; const f32x4* gr = (const f32x4*)gain + lane;
    f32x4 v[4]; float s = 0.f;
#pragma unroll
    for (int j = 0; j < 4; ++j) { v[j] = xr[64 * j]; s += (v[j].x * v[j].x + v[j].y * v[j].y) + (v[j].z * v[j].z + v[j].w * v[j].w); }
    const float r = rsqrtf(wave_sum(s) * (1.f / DM) + RMS_EPS);
    unsigned long long* o8 = (unsigned long long*)orow + lane;
#pragma unroll
    for (int j = 0; j < 4; ++j) { const f32x4 gq = gr[64 * j];
        o8[64 * j] = (unsigned long long)pk2(v[j].x * r * gq.x, v[j].y * r * gq.y) | ((unsigned long long)pk2(v[j].z * r * gq.z, v[j].w * r * gq.w) << 32); }
}
DI void prep_row_bf16(const float* xrow, const float* gain, bf16_t* orow, float* prow, int lane) {
    lane = opaque(lane);
    const f32x4* xr = (const f32x4*)xrow + lane; const f32x4* gr = (const f32x4*)gain + lane;
    f32x4 v[4]; float s = 0.f;
#pragma unroll
    for (int j = 0; j < 4; ++j) { v[j] = xr[64 * j]; s += (v[j].x * v[j].x + v[j].y * v[j].y) + (v[j].z * v[j].z + v[j].w * v[j].w); }
    s = wave_sum(s);
    if (lane < 16) prow[lane] = (lane == 0) ? s : 0.f;
    unsigned long long* o8 = (unsigned long long*)orow + lane;
#pragma unroll
    for (int j = 0; j < 4; ++j) { const f32x4 gq = gr[64 * j];
        o8[64 * j] = (unsigned long long)pk2(v[j].x * gq.x, v[j].y * gq.y) | ((unsigned long long)pk2(v[j].z * gq.z, v[j].w * gq.w) << 32); }
}
DI void rms_row_f32(float* xrow, const float* gain, int lane) {
    lane = opaque(lane);
    f32x4* xr = (f32x4*)xrow + lane; const f32x4* gr = (const f32x4*)gain + lane;
    f32x4 v[4]; float s = 0.f;
#pragma unroll
    for (int j = 0; j < 4; ++j) { v[j] = xr[64 * j]; s += (v[j].x * v[j].x + v[j].y * v[j].y) + (v[j].z * v[j].z + v[j].w * v[j].w); }
    const float r = rsqrtf(wave_sum(s) * (1.f / DM) + RMS_EPS);
#pragma unroll
    for (int j = 0; j < 4; ++j) xr[64 * j] = v[j] * r * gr[64 * j];
}

struct Params {
    const float* x; const float* mem; const int* pos;
    const float *norm_mix, *w_in, *lam_re, *lam_im, *log_dt, *b_re, *b_im, *c_re, *c_im, *ssm_d, *w_glu, *diff_lambda, *diff_subln, *w_branch, *w_out,
                *norm_cross, *norm_mem, *w_xq, *w_xkv, *w_xo, *norm_mlp, *w_up, *w_down, *norm_final;
    float* out; unsigned char* ws;
};

typedef const __attribute__((address_space(4))) Params* KPtr;
DI KPtr kp_get() { unsigned long long v = (unsigned long long)__builtin_amdgcn_kernarg_segment_ptr(); asm volatile("" : "+s"(v)); return (KPtr)v; }
#define PP (kp_get())

DI void ssm_prep(int l, LAS unsigned char* lds) {
    const int tid = opaque(threadIdx.x);
    LAS f32x2_t* E = (LAS f32x2_t*)lds;
    LAS f32x2_t* Bb = (LAS f32x2_t*)(lds + 33 * 64 * 8);
    LAS f32x2_t* Cc = (LAS f32x2_t*)(lds + 33 * 64 * 8 + 1024 * 8);
    LAS float* Kk = (LAS float*)(lds + 33 * 64 * 8 + 1024 * 8 + 64 * 8);
    bf16_t* toep = (bf16_t*)(PP->ws + WS_TOEP); bf16_t* wst = (bf16_t*)(PP->ws + WS_WST); f32x2_t* lamT = (f32x2_t*)(PP->ws + WS_LAMT);
    const float* lre = PP->lam_re + l * 2048; const float* lim = PP->lam_im + l * 2048; const float* ldt = PP->log_dt + l * 32;
    const float* bre = PP->b_re + (size_t)l * 32768; const float* bim = PP->b_im + (size_t)l * 32768;
    const float* cre = PP->c_re + (size_t)l * 32768; const float* cim = PP->c_im + (size_t)l * 32768; const float* dsk = PP->ssm_d + l * 512;
    for (int un = blockIdx.x; un < 512; un += gridDim.x) {
        const int g = un >> 4, co = un & 15; const float dt = __expf(ldt[g]);
        for (int idx = tid; idx < 33 * 64; idx += 512) { const int tau = idx >> 6, p = idx & 63; const float lr = lre[g * 64 + p] * dt; const double li = (double)(lim[g * 64 + p] * dt);
            const float mag = __expf(tau * lr); float s, c; sincos_red(tau * li, s, c); E[idx] = (f32x2_t){mag * c, mag * s}; }
        for (int idx = tid; idx < 1024; idx += 512) { const int p = idx >> 4, ci = idx & 15; const float ar = lre[g * 64 + p], ai = lim[g * 64 + p];
            const float mag = __expf(ar * dt); float s, c; sincos_red((double)(ai * dt), s, c);
            const float nr = mag * c - 1.f, ni = mag * s; const float den = 1.f / (ar * ar + ai * ai);
            const float qr = (nr * ar + ni * ai) * den, qi = (ni * ar - nr * ai) * den;
            const float br = bre[(size_t)(g * 64 + p) * 16 + ci], bi = bim[(size_t)(g * 64 + p) * 16 + ci];
            Bb[idx] = (f32x2_t){qr * br - qi * bi, qr * bi + qi * br}; }
        if (tid < 64) Cc[tid] = (f32x2_t){cre[(size_t)(g * 16 + co) * 64 + tid], cim[(size_t)(g * 16 + co) * 64 + tid]};
        __syncthreads();
        { const int tau = tid >> 4, ci = tid & 15; float a = 0.f;
            for (int p = 0; p < 64; ++p) { const f32x2_t e = E[tau * 64 + p], cc = Cc[p], bb = Bb[p * 16 + ci];
                const float cr = cc.x * e.x - cc.y * e.y, cim2 = cc.x * e.y + cc.y * e.x; a += cr * bb.x - cim2 * bb.y; }
            Kk[tid] = a; }
        __syncthreads();
        const float dval = dsk[g * 16 + co];
        for (int idx = tid; idx < 32 * SSM_K2; idx += 512) { const int t = idx / SSM_K2, k = idx % SSM_K2; float val;
            if (k < 512) { const int s = k >> 4, ci = k & 15; val = (t >= s) ? Kk[(t - s) * 16 + ci] : 0.f; if (s == t && ci == co) val += dval; }
            else { const int p = (k - 512) & 63; const f32x2_t e = E[(t + 1) * 64 + p], cc = Cc[p];
                val = (k < 576) ? (cc.x * e.x - cc.y * e.y) : -(cc.x * e.y + cc.y * e.x); }
            toep[(size_t)(g * 512 + t * 16 + co) * SSM_K2 + k] = f2bf(val); }
        __syncthreads();
    }
    for (int un = blockIdx.x; un < 2048; un += gridDim.x) {
        const int g = un >> 6, p = un & 63; const float dt = __expf(ldt[g]); const int s = tid >> 4, ci = tid & 15;
        const float ar = lre[g * 64 + p], ai = lim[g * 64 + p];
        float sn, cs; const float mag = __expf(ar * dt); sincos_red((double)(ai * dt), sn, cs);
        const float nr = mag * cs - 1.f, ni = mag * sn; const float den = 1.f / (ar * ar + ai * ai);
        const float qr = (nr * ar + ni * ai) * den, qi = (ni * ar - nr * ai) * den;
        const float br = bre[(size_t)(g * 64 + p) * 16 + ci], bi = bim[(size_t)(g * 64 + p) * 16 + ci];
        const float bbr = qr * br - qi * bi, bbi = qr * bi + qi * br;
        const int tau = 31 - s; const float em = __expf(tau * ar * dt); float es, ec; sincos_red((double)tau * (double)(ai * dt), es, ec);
        const float er = em * ec, ei = em * es;
        const size_t o = (size_t)(g * 256 + p) * 512 + s * 16 + ci;
        wst[o] = f2bf(er * bbr - ei * bbi); wst[o + 64 * 512] = f2bf(er * bbi + ei * bbr); wst[o + 128 * 512] = 0; wst[o + 192 * 512] = 0;
        if (tid == 0) { const float m32 = __expf(32.f * ar * dt); float s3, c3; sincos_red(32.0 * (double)(ai * dt), s3, c3); lamT[g * 64 + p] = (f32x2_t){m32 * c3, m32 * s3}; }
    }
}

DI void ssm_scan(LAS unsigned char* lds) {
    const int tid = opaque(threadIdx.x);
    const float* sloc = (const float*)(PP->ws + WS_SLOC); bf16_t* a2 = (bf16_t*)(PP->ws + WS_A2); const f32x2_t* lamT = (const f32x2_t*)(PP->ws + WS_LAMT);
    for (int un = blockIdx.x; un < NB * 32; un += gridDim.x) {
        const int g = un & 31, b = un >> 5; const size_t r0 = (size_t)g * SSM_M2 + b * SSM_NC;
        const f32x4* src = (const f32x4*)(sloc + r0 * 128) + tid;
#pragma unroll
        for (int j = 0; j < 8; ++j) ((LAS f32x4*)lds)[tid + j * 512] = src[j * 512];
        __syncthreads();
        if (tid < 64) { const int p = tid; const f32x2_t lt = lamT[g * 64 + p]; float sr = 0.f, si = 0.f; const LAS float* L = (const LAS float*)lds;
            bf16_t* dst = a2 + r0 * SSM_K2 + 512 + p;
#pragma unroll 8
            for (int c = 0; c < SSM_NC; ++c) { dst[(size_t)c * SSM_K2] = f2bf(sr); dst[(size_t)c * SSM_K2 + 64] = f2bf(si);
                const float lr = L[c * 128 + p], li = L[c * 128 + 64 + p];
                const float nr = lt.x * sr - lt.y * si + lr, ni = lt.x * si + lt.y * sr + li; sr = nr; si = ni; } }
        __syncthreads();
    }
}

#define XB_TMO      128
#define XB_XCNT(j)  (256  + 64 * (j))
#define XB_XSUB(j)  (1280 + 64 * (j))
#define XB_XGEN(j)  (2304 + 64 * (j))
#define XB_TOP      3328
#define XB_TOPGEN   3392
#define XCD_BAR_WORDS 3456
#define XB_SPIN_CAP (1u << 18)
DI unsigned xb_ld(unsigned* p)              { return __hip_atomic_load(p, __ATOMIC_RELAXED, __HIP_MEMORY_SCOPE_AGENT); }
DI unsigned xb_add(unsigned* p, unsigned v) { return __hip_atomic_fetch_add(p, v, __ATOMIC_RELAXED, __HIP_MEMORY_SCOPE_AGENT); }
DI unsigned xb_xcc_id() { return (unsigned)__builtin_amdgcn_s_getreg((3 << 11) | 20) & 0xFu; }
#define XB_SPIN(cond, bar) do { unsigned _sp = 0; while (cond) { __builtin_amdgcn_s_sleep(1); \
    if ((++_sp & 255u) == 0u) { if (xb_ld(&(bar)[XB_TMO])) break; if (_sp > XB_SPIN_CAP) { atomicAdd(&(bar)[XB_TMO], 1u); break; } } } } while (0)
struct XcdBarrier { unsigned* bar; unsigned x; volatile LAS unsigned* st; };
DI XcdBarrier xcd_barrier_post(unsigned* bar, volatile LAS unsigned* st) {
    XcdBarrier b; b.bar = bar; b.x = xb_xcc_id(); b.st = st;
    if (threadIdx.x == 0) (void)xb_add(&bar[XB_XCNT(b.x)], 1u);
    return b;
}
DI void xcd_barrier_complete(unsigned* bar, unsigned x, unsigned& nloc, unsigned& nx) {
    const unsigned G = gridDim.x * gridDim.y * gridDim.z;
    unsigned sum, cnt, mine, sp = 0u;
    for (;;) {
        sum = 0u; cnt = 0u; mine = 0u;
#pragma unroll
        for (unsigned j = 0; j < 16; ++j) { const unsigned c = xb_ld(&bar[XB_XCNT(j)]); sum += c; cnt += (c > 0u) ? 1u : 0u; mine = (j == x) ? c : mine; }
        if (sum == G) break;
        __builtin_amdgcn_s_sleep(1);
        if ((++sp & 255u) == 0u) { if (xb_ld(&bar[XB_TMO])) break; if (sp > XB_SPIN_CAP) { atomicAdd(&bar[XB_TMO], 1u); break; } }
    }
    nloc = mine > 0u ? mine : 1u; nx = cnt > 0u ? cnt : 1u;
}
DI void xcd_barrier(const XcdBarrier& b) {
    asm volatile("s_waitcnt vmcnt(0)" ::: "memory");
    __syncthreads();
    if (opaque((int)threadIdx.x) == 0) {
        unsigned* bar = b.bar;
        __builtin_amdgcn_s_waitcnt(0);
        unsigned nloc = b.st[0], nx = b.st[1];
        if (nloc == 0u) { xcd_barrier_complete(bar, b.x, nloc, nx); b.st[0] = nloc; b.st[1] = nx; }
        const unsigned old = xb_add(&bar[XB_XSUB(b.x)], 1u);
        const unsigned gen = old / nloc;
        if (old + 1u == (gen + 1u) * nloc) {
            __builtin_amdgcn_fence(__ATOMIC_RELEASE, "agent");
            asm volatile("s_waitcnt vmcnt(0)" ::: "memory");
            const unsigned og = xb_add(&bar[XB_TOP], 1u);
            const unsigned tg = og / nx;
            if (og + 1u == (tg + 1u) * nx) xb_add(&bar[XB_TOPGEN], 1u);
            else XB_SPIN(xb_ld(&bar[XB_TOPGEN]) == tg, bar);
            __builtin_amdgcn_fence(__ATOMIC_ACQUIRE, "agent");
            xb_add(&bar[XB_XGEN(b.x)], 1u);
            asm volatile("s_waitcnt vmcnt(0)" ::: "memory");
        } else {
            XB_SPIN(xb_ld(&bar[XB_XGEN(b.x)]) == gen, bar);
            __builtin_amdgcn_fence(__ATOMIC_ACQUIRE, "agent");
            asm volatile("s_waitcnt vmcnt(0)" ::: "memory");
        }
    }
    __syncthreads();
}

#define HBUF ((bf16_t*)(PP->ws + WS_H))
#define LAMS ((float*)(PP->ws + WS_LAMT + 65536))
__global__ void __launch_bounds__(512, 2) fwd_megakernel(Params P) {
    extern __shared__ __attribute__((aligned(16))) unsigned char lds_raw[];
    LAS unsigned char* lds = (LAS unsigned char*)lds_raw;
    cg::grid_group grid = cg::this_grid();
    const int tid = threadIdx.x, lane = tid & 63, wave = __builtin_amdgcn_readfirstlane(tid >> 6);
    const int G = gridDim.x, c = blockIdx.x;
    const int gw = c * 8 + wave, ngw = G * 8;
    LAS float* scr = (LAS float*)(lds + wave * 16384);
    if (tid < 4) ((LAS unsigned*)(lds + LDS_CTL + 64))[tid] = 0u;
    __syncthreads();
    const XcdBarrier xbar = xcd_barrier_post((unsigned*)PP->ws + 4096, (volatile LAS unsigned*)(lds + LDS_CTL + 64));

    int goff = 0;
    for (int i = c * 512 + tid; i < MTOK * 8; i += G * 512) { const int row = i >> 3, j = i & 7;
        const float invf = __builtin_amdgcn_exp2f(-(float)j * 2.3664460712f);   const float ang = (float)PP->pos[row] * invf; float s, cs; sincos_red((double)ang, s, cs);
        ((f32x2_t*)(PP->ws + WS_ROPE))[i] = (f32x2_t){cs, s}; }
    if (c == 0 && tid < DEPTH) { const float* lv = PP->diff_lambda + tid * 256; float a = 0.f, b = 0.f;
        for (int k = 0; k < 64; ++k) { a += lv[k] * lv[64 + k]; b += lv[128 + k] * lv[192 + k]; }
        LAMS[tid] = expf(a) - expf(b) + (0.8f - 0.6f * expf(-0.3f * (float)tid)); }
    for (int r = gw; r < DEPTH * NB * MEML; r += ngw) { const int l = r / (NB * MEML), m = r % (NB * MEML);
        rms_row_bf16(PP->mem + (size_t)m * DM, PP->norm_mem + l * DM, (bf16_t*)(PP->ws + WS_MEMN) + (size_t)r * DM, lane); }
    for (int l = 0; l < DEPTH; ++l) transpose_mat(PP->w_xkv + (size_t)l * DM * 1024, DM, 1024, (bf16_t*)(PP->ws + WS_WXKV) + (size_t)l * 1024 * DM, false, scr, gw, ngw, lane, goff);

    for (int l = 0; l < DEPTH; ++l) {
        const float* xin = (l == 0) ? PP->x : PP->out;
        transpose_mat(PP->w_in + (size_t)l * DM * NIN, DM, NIN, (bf16_t*)(PP->ws + WS_WIN), false, scr, gw, ngw, lane, goff, 2048, 3072);
        transpose_mat(PP->w_glu + (size_t)l * 512 * 1024, 512, 1024, (bf16_t*)(PP->ws + WS_WGLU), true, scr, gw, ngw, lane, goff);
        for (int z = 0; z < 3; ++z) transpose_mat(PP->w_branch + ((size_t)l * 3 + z) * 512 * DM, 512, DM, (bf16_t*)(PP->ws + WS_WB) + (size_t)z * DM * 512, false, scr, gw, ngw, lane, goff);
        transpose_mat(PP->w_out + (size_t)l * DM * DM, DM, DM, (bf16_t*)(PP->ws + WS_WOUT), false, scr, gw, ngw, lane, goff);
        transpose_mat(PP->w_xq + (size_t)l * DM * 512, DM, 512, (bf16_t*)(PP->ws + WS_WXQ), false, scr, gw, ngw, lane, goff);
        transpose_mat(PP->w_xo + (size_t)l * 512 * DM, 512, DM, (bf16_t*)(PP->ws + WS_WXO), false, scr, gw, ngw, lane, goff);
        transpose_mat(PP->w_up + (size_t)l * DM * 4096, DM, 4096, (bf16_t*)(PP->ws + WS_WUP), false, scr, gw, ngw, lane, goff);
        transpose_mat(PP->w_down + (size_t)l * 4096 * DM, 4096, DM, (bf16_t*)(PP->ws + WS_WDN), false, scr, gw, ngw, lane, goff);
        __syncthreads();
        ssm_prep(l, lds);
        if (l == 0) for (int r = gw; r < MTOK; r += ngw) prep_row_bf16(xin + (size_t)r * DM, PP->norm_mix, HBUF + (size_t)r * DM, (float*)(PP->ws + WS_PART) + (size_t)r * 16, lane);
        grid.sync();

        { pg8::Gemm g{HBUF, (const bf16_t*)(PP->ws + WS_WIN), DM, DM, DM, 0, 0}; pg8::SchedMN S{MTOK / 256, NINA / 256, G, c};
          pg8::EpiInProj E{PP->ws, (const f32x2_t*)(PP->ws + WS_ROPE), (const float*)(PP->ws + WS_PART)}; pg8::gemm_phase(lds, g, S, E); }
        if (l == 0) { pg8::Gemm g{(const bf16_t*)(PP->ws + WS_MEMN), (const bf16_t*)(PP->ws + WS_WXKV), DM, DM, DM, (long)NB * MEML * DM, (long)1024 * DM};
          pg8::SchedZ S{DEPTH, NB * MEML / 256, 1024 / 256, G, c}; pg8::EpiMemKV E{(bf16_t*)(PP->ws + WS_MEMKV)}; pg8::gemm_phase(lds, g, S, E); }
        xcd_barrier(xbar);

        { pg8::Gemm g{(const bf16_t*)(PP->ws + WS_A2), (const bf16_t*)(PP->ws + WS_WST), SSM_K2, 512, 512, (long)SSM_M2 * SSM_K2, (long)256 * 512};
          pg8::SchedZ S{32, SSM_M2 / 256, 1, G, c}; pg8::EpiSloc E{(float*)(PP->ws + WS_SLOC)}; pg8::gemm_phase(lds, g, S, E); }
        xcd_barrier(xbar);
        ssm_scan(lds);
        xcd_barrier(xbar);
        { pg8::Gemm g{(const bf16_t*)(PP->ws + WS_A2), (const bf16_t*)(PP->ws + WS_TOEP), SSM_K2, SSM_K2, SSM_K2, (long)SSM_M2 * SSM_K2, (long)512 * SSM_K2};
          pg8::SchedZ S{32, SSM_M2 / 256, 2, G, c}; pg8::EpiGelu E{(bf16_t*)(PP->ws + WS_YACT)}; pg8::gemm_phase(lds, g, S, E); }
        xcd_barrier(xbar);
        { pg8::Gemm g{(const bf16_t*)(PP->ws + WS_YACT), (const bf16_t*)(PP->ws + WS_WGLU), 512, 512, 512, 0, 0}; pg8::SchedMN S{MTOK / 256, 4, G, c};
          pg8::EpiGlu E{(bf16_t*)(PP->ws + WS_YSSM)}; pg8::gemm_phase(lds, g, S, E); }
        for (int r = 0;; ++r) { const int pos = (r & 1) ? G - 1 - c : c; const int idx = r * G + pos; if (idx >= 1024) break;
            const int qb = 15 - idx / 64, bh = idx % 64;
            sb_unit(bh >> 3, bh & 7, qb, (const bf16_t*)(PP->ws + WS_SQ), (bf16_t*)(PP->ws + WS_SQ), (const bf16_t*)(PP->ws + WS_SK), (const bf16_t*)(PP->ws + WS_SV), lds); }
        { const float lam = LAMS[l]; const float post = 1.f - (0.8f - 0.6f * expf(-0.3f * (float)l));
          for (int r = 0;; ++r) { const int pos = (r & 1) ? G - 1 - c : c; const int idx = r * G + pos; if (idx >= 512) break;
            const int qb = 15 - idx / 32, bh = idx % 32, b = bh >> 2, hh = bh & 3; const size_t off = (size_t)b * SEQ * 512 + hh * 128;
            attn2_unit<true>(qb, (const bf16_t*)(PP->ws + WS_DQ) + off, (bf16_t*)(PP->ws + WS_DQ) + off, (const bf16_t*)(PP->ws + WS_DK) + off, (const bf16_t*)(PP->ws + WS_DV) + off, 4 * qb + 4, lam, PP->diff_subln + l * 128, post, lds); } }
        xcd_barrier(xbar);
        { pg8::GmArgs ga{HBUF, (const bf16_t*)(PP->ws + WS_WIN) + (size_t)NINA * DM, (const bf16_t*)(PP->ws + WS_YSSM), (long)(WS_SQ - WS_YSSM) / 2, (const bf16_t*)(PP->ws + WS_WB),
                         (bf16_t*)(PP->ws + WS_GS), (bf16_t*)(PP->ws + WS_H2), (const float*)(PP->ws + WS_PART)};
          pg8::SchedGM S{MTOK / 256, 4, G, c}; pg8::gemm_phase_gm(lds, ga, S); }
        xcd_barrier(xbar);
        { pg8::Gemm g{(const bf16_t*)(PP->ws + WS_H2), (const bf16_t*)(PP->ws + WS_WOUT), DM, DM, DM, 0, 0}; pg8::SchedMN S{MTOK / 256, 4, G, c}; pg8::EpiResid E{xin, PP->out, HBUF, PP->norm_cross + l * DM, (float*)(PP->ws + WS_PART)}; pg8::gemm_phase(lds, g, S, E); }
        xcd_barrier(xbar);
        { pg8::Gemm g{HBUF, (const bf16_t*)(PP->ws + WS_WXQ), DM, DM, DM, 0, 0}; const pg8::SchedMN S{MTOK / 256, 2, G, c};
          pg8::EpiBf16<0, true> E{(bf16_t*)(PP->ws + WS_XQ), 512, 0.12751743074602334f, (const float*)(PP->ws + WS_PART)}; pg8::gemm_phase(lds, g, S, E);
          if (G == (MTOK / 256) * 2) {
              __builtin_amdgcn_fence(__ATOMIC_ACQUIRE, "agent"); asm volatile("s_waitcnt vmcnt(0)" ::: "memory");
              pg8::Unit u; (void)S.next(0, u); const int b = u.pm >> 4, qb = u.pm & 15;
#pragma nounroll
              for (int hh = 2 * u.pn; hh < 2 * u.pn + 2; ++hh) {
                  const bf16_t* kb = (const bf16_t*)(PP->ws + WS_MEMKV) + (size_t)(l * 2) * 2048 * 512 + (size_t)b * MEML * 512 + hh * 128;
                  attn2_unit<false>(qb, (const bf16_t*)(PP->ws + WS_XQ) + (size_t)b * SEQ * 512 + hh * 128, (bf16_t*)(PP->ws + WS_XQ) + (size_t)b * SEQ * 512 + hh * 128, kb, kb + (size_t)2048 * 512, 4, 0.f, nullptr, 1.f, lds); }
          } else {
              xcd_barrier(xbar);
              for (int idx = c; idx < 512; idx += G) { const int qb = idx & 15, bh = idx >> 4, b = bh >> 2, hh = bh & 3;
                  const bf16_t* kb = (const bf16_t*)(PP->ws + WS_MEMKV) + (size_t)(l * 2) * 2048 * 512 + (size_t)b * MEML * 512 + hh * 128;
                  attn2_unit<false>(qb, (const bf16_t*)(PP->ws + WS_XQ) + (size_t)b * SEQ * 512 + hh * 128, (bf16_t*)(PP->ws + WS_XQ) + (size_t)b * SEQ * 512 + hh * 128, kb, kb + (size_t)2048 * 512, 4, 0.f, nullptr, 1.f, lds); }
          } }
        xcd_barrier(xbar);
        { pg8::Gemm g{(const bf16_t*)(PP->ws + WS_XQ), (const bf16_t*)(PP->ws + WS_WXO), 512, 512, 512, 0, 0}; pg8::SchedMN S{MTOK / 256, 4, G, c}; pg8::EpiResid E{PP->out, PP->out, HBUF, PP->norm_mlp + l * DM, (float*)(PP->ws + WS_PART)}; pg8::gemm_phase(lds, g, S, E); }
        xcd_barrier(xbar);
        { pg8::Gemm g{HBUF, (const bf16_t*)(PP->ws + WS_WUP), DM, DM, DM, 0, 0}; pg8::SchedMN S{MTOK / 256, 16, G, c};
          pg8::EpiBf16<2, true> E{(bf16_t*)(PP->ws + WS_HID), 4096, 1.f, (const float*)(PP->ws + WS_PART)}; pg8::gemm_phase(lds, g, S, E); }
        xcd_barrier(xbar);
        { pg8::Gemm g{(const bf16_t*)(PP->ws + WS_HID), (const bf16_t*)(PP->ws + WS_WDN), 4096, 4096, 4096, 0, 0}; pg8::SchedMN S{MTOK / 256, 4, G, c}; pg8::EpiResid E{PP->out, PP->out, HBUF, PP->norm_mix + (l + 1 < DEPTH ? l + 1 : l) * DM, (float*)(PP->ws + WS_PART)}; pg8::gemm_phase(lds, g, S, E); }
        xcd_barrier(xbar);
    }
    for (int r = gw; r < MTOK; r += ngw) rms_row_f32(PP->out + (size_t)r * DM, PP->norm_final, lane);
}

extern "C" void kernel_launch(void* const* d_in, const int* in_sizes, int n_in, void* d_out, int out_size, void* d_ws, size_t ws_size, hipStream_t stream) {
    static int grid = 0;
    if (grid == 0) {
        if (n_in != 27 || ws_size < WS_END) { fprintf(stderr, "kernel_launch: unexpected n_in %d / ws %zu\n", n_in, ws_size); grid = -1; return; }
        int dev = 0, cus = 0, per_cu = 0;
        hipGetDevice(&dev); hipDeviceGetAttribute(&cus, hipDeviceAttributeMultiprocessorCount, dev);
        hipFuncSetAttribute((const void*)fwd_megakernel, hipFuncAttributeMaxDynamicSharedMemorySize, LDS_BYTES);
        hipOccupancyMaxActiveBlocksPerMultiprocessor(&per_cu, (const void*)fwd_megakernel, 512, LDS_BYTES);
        if (per_cu < 1) per_cu = 1;
        grid = cus * 1; (void)per_cu;
        (void)hipGetLastError();
    }
    if (grid < 0) return;
    Params p{};
    p.x = (const float*)d_in[0]; p.mem = (const float*)d_in[1]; p.pos = (const int*)d_in[2];
    p.norm_mix = (const float*)d_in[3]; p.w_in = (const float*)d_in[4]; p.lam_re = (const float*)d_in[5]; p.lam_im = (const float*)d_in[6]; p.log_dt = (const float*)d_in[7];
    p.b_re = (const float*)d_in[8]; p.b_im = (const float*)d_in[9]; p.c_re = (const float*)d_in[10]; p.c_im = (const float*)d_in[11]; p.ssm_d = (const float*)d_in[12];
    p.w_glu = (const float*)d_in[13]; p.diff_lambda = (const float*)d_in[14]; p.diff_subln = (const float*)d_in[15]; p.w_branch = (const float*)d_in[16]; p.w_out = (const float*)d_in[17];
    p.norm_cross = (const float*)d_in[18]; p.norm_mem = (const float*)d_in[19]; p.w_xq = (const float*)d_in[20]; p.w_xkv = (const float*)d_in[21]; p.w_xo = (const float*)d_in[22];
    p.norm_mlp = (const float*)d_in[23]; p.w_up = (const float*)d_in[24]; p.w_down = (const float*)d_in[25]; p.norm_final = (const float*)d_in[26];
    p.out = (float*)d_out; p.ws = (unsigned char*)d_ws;
    (void)hipMemsetAsync(d_ws, 0, 65536, stream);
    void* args[] = {&p};
    hipError_t e = hipLaunchCooperativeKernel((const void*)fwd_megakernel, dim3(grid), dim3(512), args, LDS_BYTES, stream);
    if (e != hipSuccess) fprintf(stderr, "cooperative launch failed: %s (grid %d)\n", hipGetErrorString(e), grid);
}
```

```cpp
#include <hip/hip_runtime.h>
#include <hip/hip_cooperative_groups.h>
#include <cstdint>
#include <cstdio>
namespace cg = cooperative_groups;

#define LAS __attribute__((address_space(3)))
#define DI __device__ __forceinline__
typedef unsigned short bf16_t;
typedef short bf16x8 __attribute__((ext_vector_type(8)));
typedef short s16x4 __attribute__((ext_vector_type(4)));
typedef short v4i16_t __attribute__((ext_vector_type(4)));
typedef float f32x4 __attribute__((ext_vector_type(4)));
typedef float f32x16 __attribute__((ext_vector_type(16)));
typedef unsigned u32x4 __attribute__((ext_vector_type(4)));
typedef float f32x2_t __attribute__((ext_vector_type(2)));
typedef __bf16 bf16x2_t __attribute__((ext_vector_type(2)));

constexpr int DM = 1024, NB = 8, SEQ = 4096, MTOK = NB * SEQ, DEPTH = 2, MEML = 256;
constexpr int NIN = 6656, NINA = 3584;
constexpr float RMS_EPS = 1e-6f;
constexpr int SSM_T = 32, SSM_NC = SEQ / SSM_T  , SSM_M2 = NB * SSM_NC  , SSM_K2 = 640;

constexpr size_t MiB = 1u << 20;
constexpr size_t WS_ROPE = 1 * MiB;
constexpr size_t WS_LAMT = 3 * MiB;
constexpr size_t WS_MEMN = 4 * MiB;
constexpr size_t WS_WXKV = 12 * MiB;
constexpr size_t WS_MEMKV = 16 * MiB;
constexpr size_t WS_WIN = 24 * MiB;
constexpr size_t WS_WGLU = 37 * MiB;
constexpr size_t WS_WB = 38 * MiB;
constexpr size_t WS_WOUT = 41 * MiB;
constexpr size_t WS_WXQ = 43 * MiB;
constexpr size_t WS_WXO = 44 * MiB;
constexpr size_t WS_WUP = 45 * MiB;
constexpr size_t WS_WDN = 53 * MiB;
constexpr size_t WS_WST = 61 * MiB;
constexpr size_t WS_TOEP = 69 * MiB;
constexpr size_t WS_H = 90 * MiB;
constexpr size_t WS_YSSM = 154 * MiB;
constexpr size_t WS_SQ = 186 * MiB;
constexpr size_t WS_DQ = 218 * MiB;
constexpr size_t WS_SK = 250 * MiB;
constexpr size_t WS_SV = 282 * MiB;
constexpr size_t WS_DK = 314 * MiB;
constexpr size_t WS_DV = 346 * MiB;
constexpr size_t WS_A2 = 378 * MiB;
constexpr size_t WS_SLOC = 418 * MiB;
constexpr size_t WS_YACT = 434 * MiB;
constexpr size_t WS_GATES = 250 * MiB;
constexpr size_t WS_HID = 154 * MiB;
constexpr size_t WS_XQ = 154 * MiB;
constexpr size_t WS_H2 = 250 * MiB;
constexpr size_t WS_GS = 314 * MiB;
constexpr size_t WS_PART = 466 * MiB;
constexpr size_t WS_END = 468 * MiB;

constexpr int LDS_CTL = 143360;
constexpr int LDS_BYTES = LDS_CTL + 1024;

DI unsigned pk2(float lo, float hi) { f32x2_t v = {lo, hi}; bf16x2_t b = __builtin_convertvector(v, bf16x2_t); return __builtin_bit_cast(unsigned, b); }
DI bf16_t f2bf(float f) { return (bf16_t)(pk2(f, 0.f) & 0xffffu); }
DI float bf2f(unsigned u) { return __uint_as_float(u << 16); }
DI void st8(bf16_t* p, f32x4 a, f32x4 b) { u32x4 w; w.x = pk2(a[0], a[1]); w.y = pk2(a[2], a[3]); w.z = pk2(b[0], b[1]); w.w = pk2(b[2], b[3]); *(u32x4*)p = w; }
DI int opaque(int v) { asm volatile("" : "+v"(v)); return v; }
DI int opaque_s(int v) { asm volatile("" : "+s"(v)); return v; }
DI float sigmoidf_(float x) { return __builtin_amdgcn_rcpf(1.f + __builtin_amdgcn_exp2f(x * -1.4426950408889634f)); }
DI float wave_sum(float v) {
#pragma unroll
    for (int o = 1; o < 64; o <<= 1) v += __shfl_xor(v, o);
    return v;
}
DI void sincos_red(double a, float& s, float& c) {
    const double k = rint(a * 0.15915494309189535);
    const float r = (float)(a - k * 6.283185307179586);
    s = __sinf(r); c = __cosf(r);
}

namespace pg8 {
constexpr int BM = 256, BK = 64, HALF = 128, HTB = HALF * BK * 2, STAGE_BYTES = 8 * HTB, NXCD = 8, WGM = 8;
DI int lds_byte(int r, int c) { const int st = (r >> 4) * 2 + (c >> 5), rr = r & 15, cc = c & 31, ob = rr * 64 + cc * 2; return st * 1024 + (ob ^ (((ob >> 9) & 1) << 5)); }
DI void stage_rc(int b, int& R, int& C) { const int st = b / 1024, sb = b % 1024, swz = sb ^ (((sb >> 9) & 1) << 5); R = (st >> 1) * 16 + swz / 64; C = (st & 1) * 32 + (swz % 64) / 2; }
DI int perm32(int rho) { const int n = rho >> 4, i = rho & 15; return 8 * (i >> 2) + 4 * n + (i & 3); }

struct Unit { int pm, pn, z; };
struct Gemm { const bf16_t* A; const bf16_t* Bt; int lda, ldb, K; long zA, zB; };

DI void tile_decode(int wgid, int nM, int nN, int& pm, int& pn) {
    const int nwg = nM * nN;
    { const int q = nwg / NXCD, r = nwg % NXCD, xcd = wgid % NXCD, off = wgid / NXCD; wgid = (xcd < r ? xcd * (q + 1) : r * (q + 1) + (xcd - r) * q) + off; }
    const int nig = WGM * nN, gid = wgid / nig, fm = gid * WGM, gsz = (nM - fm) < WGM ? (nM - fm) : WGM;
    pm = fm + ((wgid % nig) % gsz); pn = (wgid % nig) / gsz;
}
struct SchedMN {
    int nM, nN, G, c;
    DI bool next(int i, Unit& u) const { const long L = (long)i * G + c; if (L >= (long)nM * nN) return false; tile_decode((int)L, nM, nN, u.pm, u.pn); u.z = 0; return true; }
};
struct SchedZ {
    int nZ, nM, nN, G, c;
    DI bool next(int i, Unit& u) const { const long L = (long)i * G + c; if (L >= (long)nZ * nM * nN) return false; const int l = (int)L; u.z = l / (nM * nN); const int r = l % (nM * nN); u.pm = r / nN; u.pn = r % nN; return true; }
};
struct SchedMerge {
    int nM, nN, G, c;
    DI bool next(int i, Unit& u) const { const long L = (long)(i / 3) * G + c; if (L >= (long)nM * nN) return false; tile_decode((int)L, nM, nN, u.pm, u.pn); u.z = i % 3; return true; }
};

template <class Epi, class Sched>
DI void gemm_phase(LAS unsigned char* lds, const Gemm g, const Sched& S, const Epi& E) {
    const int tid = opaque(threadIdx.x), wid = __builtin_amdgcn_readfirstlane(tid >> 6), lane = tid & 63, wr = wid >> 2, wc = wid & 3, fr = lane & 15, fq = lane >> 4;
    const int nt = g.K / BK;
    unsigned voffA[2], voffB[2];
#pragma unroll
    for (int i = 0; i < 2; ++i) { int R, C; stage_rc(tid * 16 + i * 8192, R, C); const int Rb = (R & ~31) + perm32(R & 31);
        voffA[i] = (unsigned)(R * g.lda + C) * 2u; voffB[i] = (unsigned)(Rb * g.ldb + C) * 2u; }
    const size_t kstep = (size_t)(BK * 2);
    const size_t hstepA = (size_t)HALF * g.lda * 2, hstepB = (size_t)HALF * g.ldb * 2;
    const unsigned ldsw = (unsigned)wid * 1024u;
    const int aoff = lds_byte(wr * 64 + fr, fq * 8), boff = lds_byte(wc * 32 + fr, fq * 8);
#define PG8_SA(b, h) (((b) * 2 + (h)) * HTB)
#define PG8_SB(b, h) ((4 + (b) * 2 + (h)) * HTB)
#define PG8_STAGE(bufoff, gbase, voff) do { _Pragma("unroll") for (int _i = 0; _i < 2; ++_i) \
        __builtin_amdgcn_global_load_lds((const unsigned*)((const char*)(gbase) + (voff)[_i]), (LAS unsigned*)(lds + (bufoff) + ldsw + _i * 8192), 16, 0, 0); } while (0)
#define PG8_LDA(dst, b, h) do { _Pragma("unroll") for (int m = 0; m < 4; ++m) _Pragma("unroll") for (int k = 0; k < 2; ++k) dst[m][k] = *(const LAS bf16x8*)(lds + PG8_SA(b, h) + aoff + m * 2048 + k * 1024); } while (0)
#define PG8_LDB(dst, b, h) do { _Pragma("unroll") for (int n = 0; n < 2; ++n) _Pragma("unroll") for (int k = 0; k < 2; ++k) dst[n][k] = *(const LAS bf16x8*)(lds + PG8_SB(b, h) + boff + n * 2048 + k * 1024); } while (0)
#define PG8_MMA(ai, bj, At, Bt) do { __builtin_amdgcn_s_setprio(1); _Pragma("unroll") for (int m = 0; m < 4; ++m) _Pragma("unroll") for (int n = 0; n < 2; ++n) _Pragma("unroll") for (int k = 0; k < 2; ++k) \
        acc[ai][bj][m][n] = __builtin_amdgcn_mfma_f32_16x16x32_bf16(Bt[n][k], At[m][k], acc[ai][bj][m][n], 0, 0, 0); __builtin_amdgcn_s_setprio(0); } while (0)
#define PG8_WAIT_V(n) asm volatile("s_waitcnt vmcnt(" #n ")" ::: "memory")
#define PG8_WAIT_L(n) asm volatile("s_waitcnt lgkmcnt(" #n ")" ::: "memory")
#define PG8_BAR __builtin_amdgcn_s_barrier()
#define PG8_SCHED __builtin_amdgcn_sched_barrier(0)
    Unit cur, nxt; int ui = 0;
    if (!S.next(0, cur)) return;
#define PG8_RFILL(u_, ui_) do { if (tid < 256) { const f32x4* pp_ = (const f32x4*)(E.part + (size_t)((u_).pm * BM + tid) * 16); \
        const f32x4 a_ = pp_[0], b_ = pp_[1], c_ = pp_[2], d_ = pp_[3]; const f32x4 s_ = (a_ + b_) + (c_ + d_); \
        ((LAS float*)(lds + STAGE_BYTES))[(ui_) * 256 + tid] = rsqrtf(((s_[0] + s_[1]) + (s_[2] + s_[3])) * (1.f / DM) + RMS_EPS); } } while (0)
    if constexpr (Epi::NEEDS_R) {
        Unit uu; for (int i = 0; i < 8 && S.next(i, uu); ++i) PG8_RFILL(uu, i);
    }
    f32x4 acc[2][2][4][2];
#pragma unroll
    for (int a = 0; a < 2; ++a)
#pragma unroll
        for (int b = 0; b < 2; ++b)
#pragma unroll
            for (int m = 0; m < 4; ++m)
#pragma unroll
                for (int n = 0; n < 2; ++n) acc[a][b][m][n] = (f32x4){0.f, 0.f, 0.f, 0.f};
    bf16x8 At[4][2], B0[2][2], B1[2][2];
    const char* cA = (const char*)g.A + (size_t)cur.z * g.zA * 2 + (size_t)cur.pm * 2 * hstepA;
    const char* cB = (const char*)g.Bt + (size_t)cur.z * g.zB * 2 + (size_t)cur.pn * 2 * hstepB;
    PG8_STAGE(PG8_SB(0, 0), cB, voffB); PG8_STAGE(PG8_SB(0, 1), cB + hstepB, voffB); PG8_STAGE(PG8_SA(0, 0), cA, voffA); PG8_STAGE(PG8_SA(0, 1), cA + hstepA, voffA);
    if (wr == 1) PG8_BAR;
    PG8_WAIT_V(2); PG8_BAR;
    PG8_STAGE(PG8_SB(1, 0), cB + kstep, voffB); PG8_STAGE(PG8_SA(1, 0), cA + kstep, voffA); PG8_STAGE(PG8_SB(1, 1), cB + hstepB + kstep, voffB);
    PG8_WAIT_V(6); PG8_BAR;
    for (;;) {
        const bool has_next = S.next(ui + 1, nxt);
        const char* nA = has_next ? (const char*)g.A + (size_t)nxt.z * g.zA * 2 + (size_t)nxt.pm * 2 * hstepA : cA;
        const char* nB = has_next ? (const char*)g.Bt + (size_t)nxt.z * g.zB * 2 + (size_t)nxt.pn * 2 * hstepB : cB;
        for (int t = 0; t < nt; t += 2) {
            const bool last = (t == nt - 2);
            const char* a1 = cA + (size_t)(t + 1) * kstep;
            const char* a2 = last ? nA : cA + (size_t)(t + 2) * kstep; const char* b2 = last ? nB : cB + (size_t)(t + 2) * kstep;
            const char* a3 = a2 + kstep; const char* b3 = b2 + kstep;
            PG8_LDB(B0, 0, 0); PG8_LDB(B1, 0, 1); PG8_SCHED; PG8_LDA(At, 0, 0); PG8_STAGE(PG8_SA(1, 1), a1 + hstepA, voffA);
            PG8_WAIT_V(8); PG8_WAIT_L(0); PG8_BAR; PG8_MMA(0, 0, At, B0); PG8_MMA(0, 1, At, B1); PG8_BAR; PG8_SCHED;
            PG8_LDA(At, 0, 1); PG8_STAGE(PG8_SB(0, 0), b2, voffB); PG8_STAGE(PG8_SB(0, 1), b2 + hstepB, voffB); PG8_STAGE(PG8_SA(0, 0), a2, voffA);
            PG8_WAIT_V(8); PG8_WAIT_L(0); PG8_BAR; PG8_MMA(1, 0, At, B0); PG8_MMA(1, 1, At, B1); PG8_BAR; PG8_SCHED;
            PG8_LDB(B0, 1, 0); PG8_LDB(B1, 1, 1); PG8_SCHED; PG8_LDA(At, 1, 0); PG8_STAGE(PG8_SA(0, 1), a2 + hstepA, voffA);
            PG8_WAIT_V(8); PG8_WAIT_L(0); PG8_BAR; PG8_MMA(0, 0, At, B0); PG8_MMA(0, 1, At, B1); PG8_BAR; PG8_SCHED;
            PG8_LDA(At, 1, 1); PG8_STAGE(PG8_SB(1, 0), b3, voffB); PG8_STAGE(PG8_SB(1, 1), b3 + hstepB, voffB); PG8_STAGE(PG8_SA(1, 0), a3, voffA);
            PG8_WAIT_V(8); PG8_WAIT_L(0); PG8_BAR; PG8_MMA(1, 0, At, B0); PG8_MMA(1, 1, At, B1); PG8_BAR; PG8_SCHED;
        }
        if (wr == 0) PG8_BAR;
        E(acc, cur, wr, wc, fr, fq, (const LAS float*)(lds + STAGE_BYTES) + (ui & 7) * 256);
        if (!has_next) break;
#pragma unroll
        for (int a = 0; a < 2; ++a)
#pragma unroll
            for (int b = 0; b < 2; ++b)
#pragma unroll
                for (int m = 0; m < 4; ++m)
#pragma unroll
                    for (int n = 0; n < 2; ++n) acc[a][b][m][n] = (f32x4){0.f, 0.f, 0.f, 0.f};
        cur = nxt; cA = nA; cB = nB; ++ui;
        if (wr == 1) PG8_BAR;
    }
    PG8_WAIT_V(0);
    PG8_BAR;
#undef PG8_RFILL
#undef PG8_SA
#undef PG8_SB
#undef PG8_STAGE
#undef PG8_LDA
#undef PG8_LDB
#undef PG8_MMA
#undef PG8_WAIT_V
#undef PG8_WAIT_L
#undef PG8_BAR
#undef PG8_SCHED
}

typedef f32x4 AccT[2][2][4][2];

struct EpiInProj {
    static constexpr bool PERM = true, NEEDS_R = true;
    unsigned char* ws; const f32x2_t* rope; const float* part;
    DI void operator()(const AccT& acc, const Unit& u, int wr, int wc, int fr, int fq, const LAS float* rt) const {
        const int colt = u.pn * BM; const int seg = colt >> 9; const int cbase = (colt & 511) + wc * 32 + 8 * fq;
        const size_t off = seg == 1 ? WS_SQ : seg == 2 ? WS_SK : seg == 3 ? WS_SV : seg == 4 ? WS_DQ : seg == 5 ? WS_DK : WS_DV;
        bf16_t* base = (bf16_t*)(ws + off); bf16_t* a2 = (bf16_t*)(ws + WS_A2);
        const bool rot = (seg == 4 || seg == 5) && ((wc & 1) == 0) && (fq < 2);
        const float sc = (seg == 1 || seg == 4) ? 0.18033688011112042f : 1.f;
#pragma unroll
        for (int ai = 0; ai < 2; ++ai) {
            f32x2_t rc[4][4];
            if (rot) {
#pragma unroll
                for (int m = 0; m < 4; ++m) { const f32x2_t* cs = rope + (size_t)(u.pm * BM + ai * HALF + wr * 64 + m * 16 + fr) * 8 + 4 * fq;
#pragma unroll
                    for (int k = 0; k < 4; ++k) rc[m][k] = cs[k]; }
            }
            __builtin_amdgcn_sched_barrier(0);
#pragma unroll
            for (int m = 0; m < 4; ++m) {
                const int row = u.pm * BM + ai * HALF + wr * 64 + m * 16 + fr; const float rr = rt[ai * HALF + wr * 64 + m * 16 + fr] * sc;
#pragma unroll
                for (int bj = 0; bj < 2; ++bj) {
                    const int cs = cbase + bj * HALF; f32x4 v0 = acc[ai][bj][m][0] * rr, v1 = acc[ai][bj][m][1] * rr;
                    if (seg == 0) {
                        const int g = cs >> 4, ci = cs & 15, b = row >> 12, t = row & 4095, c = t >> 5, s = t & 31;
                        st8(a2 + ((size_t)(g * SSM_M2 + b * SSM_NC + c) * SSM_K2 + s * 16 + ci), v0, v1);
                    } else if (rot) {
#pragma unroll
                        for (int k = 0; k < 4; ++k) { const float t1 = v0[k], t2 = v1[k]; v0[k] = t1 * rc[m][k].x - t2 * rc[m][k].y; v1[k] = t2 * rc[m][k].x + t1 * rc[m][k].y; }
                        bf16_t* dp = base + (size_t)row * 512 + (cs - 8 * fq) + 4 * fq;
                        *(unsigned long long*)dp = (unsigned long long)pk2(v0[0], v0[1]) | ((unsigned long long)pk2(v0[2], v0[3]) << 32);
                        *(unsigned long long*)(dp + 8) = (unsigned long long)pk2(v1[0], v1[1]) | ((unsigned long long)pk2(v1[2], v1[3]) << 32);
                    } else {
                        st8(base + (size_t)row * 512 + cs, v0, v1);
                    }
                }
            }
        }
    }
};
struct EpiMemKV {
    static constexpr bool PERM = true, NEEDS_R = false;
    bf16_t* kv;
    DI void operator()(const AccT& acc, const Unit& u, int wr, int wc, int fr, int fq, const LAS float* rt) const {
        const int colt = u.pn * BM; bf16_t* base = kv + (size_t)(u.z * 2 + (colt >> 9)) * 2048 * 512; const int cbase = (colt & 511) + wc * 32 + 8 * fq;
#pragma unroll
        for (int ai = 0; ai < 2; ++ai)
#pragma unroll
            for (int m = 0; m < 4; ++m) { const int row = u.pm * BM + ai * HALF + wr * 64 + m * 16 + fr;
#pragma unroll
                for (int bj = 0; bj < 2; ++bj) st8(base + (size_t)row * 512 + cbase + bj * HALF, acc[ai][bj][m][0], acc[ai][bj][m][1]); }
    }
};
template <int ACT, bool RS> struct EpiBf16 {
    static constexpr bool PERM = true, NEEDS_R = RS;
    bf16_t* O; int ldc; float scale; const float* part;
    DI void operator()(const AccT& acc, const Unit& u, int wr, int wc, int fr, int fq, const LAS float* rt) const {
        const int col0 = u.pn * BM + wc * 32 + 8 * fq;
#pragma unroll
        for (int ai = 0; ai < 2; ++ai)
#pragma unroll
            for (int m = 0; m < 4; ++m) { const int row = u.pm * BM + ai * HALF + wr * 64 + m * 16 + fr; const float rr = RS ? rt[ai * HALF + wr * 64 + m * 16 + fr] * scale : scale;
#pragma unroll
                for (int bj = 0; bj < 2; ++bj) { f32x4 v0 = acc[ai][bj][m][0] * rr, v1 = acc[ai][bj][m][1] * rr;
                    if (ACT == 1) {
#pragma unroll
                        for (int k = 0; k < 4; ++k) { v0[k] = sigmoidf_(v0[k]); v1[k] = sigmoidf_(v1[k]); } }
                    if (ACT == 2) {
#pragma unroll
                        for (int k = 0; k < 4; ++k) { const float a = fmaxf(v0[k], 0.f), b = fmaxf(v1[k], 0.f); v0[k] = a * a; v1[k] = b * b; } }
                    st8(O + (size_t)row * ldc + col0 + bj * HALF, v0, v1); } }
    }
};
struct EpiGlu {
    static constexpr bool PERM = true, NEEDS_R = false;
    bf16_t* O;
    DI void operator()(const AccT& acc, const Unit& u, int wr, int wc, int fr, int fq, const LAS float* rt) const {
        const int col0 = u.pn * HALF + wc * 32 + 8 * fq;
#pragma unroll
        for (int ai = 0; ai < 2; ++ai)
#pragma unroll
            for (int m = 0; m < 4; ++m) { const int row = u.pm * BM + ai * HALF + wr * 64 + m * 16 + fr;
                f32x4 v0, v1;
#pragma unroll
                for (int k = 0; k < 4; ++k) { v0[k] = acc[ai][0][m][0][k] * sigmoidf_(acc[ai][1][m][0][k]); v1[k] = acc[ai][0][m][1][k] * sigmoidf_(acc[ai][1][m][1][k]); }
                st8(O + (size_t)row * 512 + col0, v0, v1); }
    }
};
struct EpiSloc {
    static constexpr bool PERM = true, NEEDS_R = false;
    float* S;
    DI void operator()(const AccT& acc, const Unit& u, int wr, int wc, int fr, int fq, const LAS float* rt) const {
        const int col0 = wc * 32 + 8 * fq;
#pragma unroll
        for (int ai = 0; ai < 2; ++ai)
#pragma unroll
            for (int m = 0; m < 4; ++m) { const int row = u.pm * BM + ai * HALF + wr * 64 + m * 16 + fr;
                float* p = S + ((size_t)(u.z * SSM_M2 + row) * 128 + col0);
                *(f32x4*)p = acc[ai][0][m][0]; *(f32x4*)(p + 4) = acc[ai][0][m][1]; }
    }
};
struct EpiGelu {
    static constexpr bool PERM = true, NEEDS_R = false;
    bf16_t* Y;
    DI void operator()(const AccT& acc, const Unit& u, int wr, int wc, int fr, int fq, const LAS float* rt) const {
        const int col0 = u.pn * BM + wc * 32 + 8 * fq;
#pragma unroll
        for (int ai = 0; ai < 2; ++ai)
#pragma unroll
            for (int m = 0; m < 4; ++m) { const int row = u.pm * BM + ai * HALF + wr * 64 + m * 16 + fr; const int b = row >> 7, c = row & 127;
#pragma unroll
                for (int bj = 0; bj < 2; ++bj) { const int n = col0 + bj * HALF, t = n >> 4, co = n & 15;
                    f32x4 v0 = acc[ai][bj][m][0], v1 = acc[ai][bj][m][1];
#pragma unroll
                    for (int k = 0; k < 4; ++k) { float x = v0[k]; v0[k] = x * __builtin_amdgcn_rcpf(1.f + __builtin_amdgcn_exp2f(x * (-2.3022082f - 0.10294324f * (x * x))));
                        x = v1[k]; v1[k] = x * __builtin_amdgcn_rcpf(1.f + __builtin_amdgcn_exp2f(x * (-2.3022082f - 0.10294324f * (x * x)))); }
                    st8(Y + ((size_t)(b * SEQ + c * SSM_T + t) * 512 + u.z * 16 + co), v0, v1); } }
    }
};
struct EpiMerge {
    static constexpr bool PERM = true, NEEDS_R = false;
    const bf16_t* gates; bf16_t* O;
    DI void operator()(const AccT& acc, const Unit& u, int wr, int wc, int fr, int fq, const LAS float* rt) const {
        const int col0 = u.pn * BM + wc * 32 + 8 * fq;
#pragma unroll
        for (int ai = 0; ai < 2; ++ai) {
            u32x4 gw[4][2], pw[4][2];
#pragma unroll
            for (int m = 0; m < 4; ++m) { const int row = u.pm * BM + ai * HALF + wr * 64 + m * 16 + fr;
#pragma unroll
                for (int bj = 0; bj < 2; ++bj) { const int col = col0 + bj * HALF;
                    gw[m][bj] = *(const u32x4*)(gates + (size_t)row * 3072 + u.z * 1024 + col);
                    if (u.z > 0) pw[m][bj] = *(const u32x4*)(O + (size_t)row * 1024 + col); else pw[m][bj] = (u32x4){0u, 0u, 0u, 0u}; } }
            __builtin_amdgcn_sched_barrier(0);
#pragma unroll
            for (int m = 0; m < 4; ++m) { const int row = u.pm * BM + ai * HALF + wr * 64 + m * 16 + fr;
#pragma unroll
                for (int bj = 0; bj < 2; ++bj) { const int col = col0 + bj * HALF; const u32x4 g4 = gw[m][bj], p4 = pw[m][bj];
                    f32x4 v0 = acc[ai][bj][m][0], v1 = acc[ai][bj][m][1];
                    v0[0] = v0[0] * bf2f(g4.x & 0xffffu) + bf2f(p4.x & 0xffffu); v0[1] = v0[1] * bf2f(g4.x >> 16) + bf2f(p4.x >> 16);
                    v0[2] = v0[2] * bf2f(g4.y & 0xffffu) + bf2f(p4.y & 0xffffu); v0[3] = v0[3] * bf2f(g4.y >> 16) + bf2f(p4.y >> 16);
                    v1[0] = v1[0] * bf2f(g4.z & 0xffffu) + bf2f(p4.z & 0xffffu); v1[1] = v1[1] * bf2f(g4.z >> 16) + bf2f(p4.z >> 16);
                    v1[2] = v1[2] * bf2f(g4.w & 0xffffu) + bf2f(p4.w & 0xffffu); v1[3] = v1[3] * bf2f(g4.w >> 16) + bf2f(p4.w >> 16);
                    st8(O + (size_t)row * 1024 + col, v0, v1); } }
        }
    }
};
struct EpiResid {
    static constexpr bool PERM = true, NEEDS_R = false;
    const float* base; float* out; bf16_t* hb; const float* gain; float* part;
    DI void operator()(const AccT& acc, const Unit& u, int wr, int wc, int fr, int fq, const LAS float* rt) const {
        const int col0 = u.pn * BM + wc * 32 + 8 * fq;
        f32x4 gv[2][2];
#pragma unroll
        for (int bj = 0; bj < 2; ++bj) { gv[bj][0] = *(const f32x4*)(gain + col0 + bj * HALF); gv[bj][1] = *(const f32x4*)(gain + col0 + bj * HALF + 4); }
#pragma unroll
        for (int ai = 0; ai < 2; ++ai)
#pragma unroll
            for (int mh = 0; mh < 2; ++mh) {
                f32x4 bx[2][2][2];
#pragma unroll
                for (int mm = 0; mm < 2; ++mm) { const int row = u.pm * BM + ai * HALF + wr * 64 + (mh * 2 + mm) * 16 + fr;
#pragma unroll
                    for (int bj = 0; bj < 2; ++bj) { const size_t o = (size_t)row * DM + col0 + bj * HALF; bx[mm][bj][0] = *(const f32x4*)(base + o); bx[mm][bj][1] = *(const f32x4*)(base + o + 4); } }
                __builtin_amdgcn_sched_barrier(0);
#pragma unroll
                for (int mm = 0; mm < 2; ++mm) { const int m = mh * 2 + mm; const int row = u.pm * BM + ai * HALF + wr * 64 + m * 16 + fr; float ss = 0.f;
#pragma unroll
                    for (int bj = 0; bj < 2; ++bj) { const size_t o = (size_t)row * DM + col0 + bj * HALF;
                        const f32x4 x0 = bx[mm][bj][0] + acc[ai][bj][m][0], x1 = bx[mm][bj][1] + acc[ai][bj][m][1];
                        *(f32x4*)(out + o) = x0; *(f32x4*)(out + o + 4) = x1;
                        ss += (x0[0] * x0[0] + x0[1] * x0[1]) + (x0[2] * x0[2] + x0[3] * x0[3]) + (x1[0] * x1[0] + x1[1] * x1[1]) + (x1[2] * x1[2] + x1[3] * x1[3]);
                        st8(hb + o, x0 * gv[bj][0], x1 * gv[bj][1]); }
                    ss += __shfl_xor(ss, 16); ss += __shfl_xor(ss, 32);
                    if (fq == 0) part[(size_t)row * 16 + u.pn * 4 + wc] = ss; }
            }
    }
};

struct GmArgs { const bf16_t* Ah; const bf16_t* Wg; const bf16_t* Y; long zY; const bf16_t* Wb; bf16_t* gs; bf16_t* O; const float* part; };
DI void gm_unit_info(const GmArgs& a, const Unit& u, const char*& cA, const char*& cB, int& ld, int& nt) {
    const int z = u.z >> 1;
    if (u.z & 1) { ld = 512; nt = 8; cA = (const char*)(a.Y + (size_t)z * a.zY) + (size_t)u.pm * 256 * 512 * 2; cB = (const char*)a.Wb + ((size_t)z * 1024 + u.pn * 256) * 512 * 2; }
    else { ld = 1024; nt = 16; cA = (const char*)a.Ah + (size_t)u.pm * 256 * 1024 * 2; cB = (const char*)a.Wg + ((size_t)z * 1024 + u.pn * 256) * 1024 * 2; }
}
DI void gm_epilogue(const GmArgs& a, const AccT& acc, const Unit& u, int wr, int wc, int fr, int fq, const LAS float* rt) {
    const int z = u.z >> 1; const int colL = wc * 32 + 8 * fq;
    bf16_t* gsb = a.gs + (size_t)blockIdx.x * 65536;
    if (!(u.z & 1)) {
#pragma unroll
        for (int ai = 0; ai < 2; ++ai)
#pragma unroll
            for (int m = 0; m < 4; ++m) { const int rl = ai * HALF + wr * 64 + m * 16 + fr; const float rrn = rt[rl] * -1.4426950408889634f;
#pragma unroll
                for (int bj = 0; bj < 2; ++bj) { f32x4 v0 = acc[ai][bj][m][0] * rrn, v1 = acc[ai][bj][m][1] * rrn;
#pragma unroll
                    for (int k = 0; k < 4; ++k) { v0[k] = __builtin_amdgcn_rcpf(1.f + __builtin_amdgcn_exp2f(v0[k])); v1[k] = __builtin_amdgcn_rcpf(1.f + __builtin_amdgcn_exp2f(v1[k])); }
                    st8(gsb + rl * 256 + colL + bj * HALF, v0, v1); } }
    } else {
#pragma unroll
        for (int ai = 0; ai < 2; ++ai) {
            u32x4 gw[4][2], pw[4][2];
#pragma unroll
            for (int m = 0; m < 4; ++m) { const int rl = ai * HALF + wr * 64 + m * 16 + fr; const int row = u.pm * BM + rl;
#pragma unroll
                for (int bj = 0; bj < 2; ++bj) { const int col = u.pn * BM + colL + bj * HALF;
                    gw[m][bj] = *(const u32x4*)(gsb + rl * 256 + colL + bj * HALF);
                    if (z > 0) pw[m][bj] = *(const u32x4*)(a.O + (size_t)row * 1024 + col); else pw[m][bj] = (u32x4){0u, 0u, 0u, 0u}; } }
            __builtin_amdgcn_sched_barrier(0);
#pragma unroll
            for (int m = 0; m < 4; ++m) { const int rl = ai * HALF + wr * 64 + m * 16 + fr; const int row = u.pm * BM + rl;
#pragma unroll
                for (int bj = 0; bj < 2; ++bj) { const int col = u.pn * BM + colL + bj * HALF; const u32x4 g4 = gw[m][bj], p4 = pw[m][bj];
                    f32x4 v0 = acc[ai][bj][m][0], v1 = acc[ai][bj][m][1];
                    v0[0] = v0[0] * bf2f(g4.x & 0xffffu) + bf2f(p4.x & 0xffffu); v0[1] = v0[1] * bf2f(g4.x >> 16) + bf2f(p4.x >> 16);
                    v0[2] = v0[2] * bf2f(g4.y & 0xffffu) + bf2f(p4.y & 0xffffu); v0[3] = v0[3] * bf2f(g4.y >> 16) + bf2f(p4.y >> 16);
                    v1[0] = v1[0] * bf2f(g4.z & 0xffffu) + bf2f(p4.z & 0xffffu); v1[1] = v1[1] * bf2f(g4.z >> 16) + bf2f(p4.z >> 16);
                    v1[2] = v1[2] * bf2f(g4.w & 0xffffu) + bf2f(p4.w & 0xffffu); v1[3] = v1[3] * bf2f(g4.w >> 16) + bf2f(p4.w >> 16);
                    st8(a.O + (size_t)row * 1024 + col, v0, v1); } }
        }
    }
}
struct SchedGM {
    int nM, nN, G, c;
    DI bool next(int i, Unit& u) const { const long L = (long)(i / 6) * G + c; if (L >= (long)nM * nN) return false; tile_decode((int)L, nM, nN, u.pm, u.pn); u.z = i % 6; return true; }
};
DI void gemm_phase_gm(LAS unsigned char* lds, const GmArgs ga, const SchedGM& S) {
    const int tid = opaque(threadIdx.x), wid = __builtin_amdgcn_readfirstlane(tid >> 6), lane = tid & 63, wr = wid >> 2, wc = wid & 3, fr = lane & 15, fq = lane >> 4;
    unsigned RA2, RB2, C2;
    { int R, C; stage_rc(tid * 16, R, C); const int Rb = (R & ~31) + perm32(R & 31); RA2 = (unsigned)R * 2u; RB2 = (unsigned)Rb * 2u; C2 = (unsigned)C * 2u; }
    const size_t kstep = (size_t)(BK * 2);
    const unsigned ldsw = (unsigned)wid * 1024u;
    const int aoff = lds_byte(wr * 64 + fr, fq * 8), boff = lds_byte(wc * 32 + fr, fq * 8);
#define PG8_SA(b, h) (((b) * 2 + (h)) * HTB)
#define PG8_SB(b, h) ((4 + (b) * 2 + (h)) * HTB)
#define GM_STAGE(bufoff, gbase, R2, ld_) do { _Pragma("unroll") for (int _i = 0; _i < 2; ++_i) \
        __builtin_amdgcn_global_load_lds((const unsigned*)((const char*)(gbase) + (size_t)_i * 128 * (size_t)(ld_) + ((R2) * (unsigned)(ld_) + C2)), (LAS unsigned*)(lds + (bufoff) + ldsw + _i * 8192), 16, 0, 0); } while (0)
#define PG8_LDA(dst, b, h) do { _Pragma("unroll") for (int m = 0; m < 4; ++m) _Pragma("unroll") for (int k = 0; k < 2; ++k) dst[m][k] = *(const LAS bf16x8*)(lds + PG8_SA(b, h) + aoff + m * 2048 + k * 1024); } while (0)
#define PG8_LDB(dst, b, h) do { _Pragma("unroll") for (int n = 0; n < 2; ++n) _Pragma("unroll") for (int k = 0; k < 2; ++k) dst[n][k] = *(const LAS bf16x8*)(lds + PG8_SB(b, h) + boff + n * 2048 + k * 1024); } while (0)
#define PG8_MMA(ai, bj, At, Bt) do { __builtin_amdgcn_s_setprio(1); _Pragma("unroll") for (int m = 0; m < 4; ++m) _Pragma("unroll") for (int n = 0; n < 2; ++n) _Pragma("unroll") for (int k = 0; k < 2; ++k) \
        acc[ai][bj][m][n] = __builtin_amdgcn_mfma_f32_16x16x32_bf16(Bt[n][k], At[m][k], acc[ai][bj][m][n], 0, 0, 0); __builtin_amdgcn_s_setprio(0); } while (0)
#define PG8_WAIT_V(n) asm volatile("s_waitcnt vmcnt(" #n ")" ::: "memory")
#define PG8_WAIT_L(n) asm volatile("s_waitcnt lgkmcnt(" #n ")" ::: "memory")
#define PG8_BAR __builtin_amdgcn_s_barrier()
#define PG8_SCHED __builtin_amdgcn_sched_barrier(0)
#define GM_RFILL(u_, ui_) do { if (tid < 256) { const f32x4* pp_ = (const f32x4*)(ga.part + (size_t)((u_).pm * BM + tid) * 16); \
        const f32x4 a_ = pp_[0], b_ = pp_[1], c_ = pp_[2], d_ = pp_[3]; const f32x4 s_ = (a_ + b_) + (c_ + d_); \
        ((LAS float*)(lds + STAGE_BYTES))[(ui_) * 256 + tid] = rsqrtf(((s_[0] + s_[1]) + (s_[2] + s_[3])) * (1.f / DM) + RMS_EPS); } } while (0)
    Unit cur, nxt; int ui = 0;
    if (!S.next(0, cur)) return;
    { Unit uu; for (int i = 0; i < 8 && S.next(6 * i, uu); ++i) GM_RFILL(uu, i); }
    f32x4 acc[2][2][4][2];
#pragma unroll
    for (int a = 0; a < 2; ++a)
#pragma unroll
        for (int b = 0; b < 2; ++b)
#pragma unroll
            for (int m = 0; m < 4; ++m)
#pragma unroll
                for (int n = 0; n < 2; ++n) acc[a][b][m][n] = (f32x4){0.f, 0.f, 0.f, 0.f};
    bf16x8 At[4][2], B0[2][2], B1[2][2];
    const char* cA; const char* cB; int ldc_, nt;
    gm_unit_info(ga, cur, cA, cB, ldc_, nt);
    size_t hsc = (size_t)HALF * ldc_ * 2;
    GM_STAGE(PG8_SB(0, 0), cB, RB2, ldc_); GM_STAGE(PG8_SB(0, 1), cB + hsc, RB2, ldc_); GM_STAGE(PG8_SA(0, 0), cA, RA2, ldc_); GM_STAGE(PG8_SA(0, 1), cA + hsc, RA2, ldc_);
    if (wr == 1) PG8_BAR;
    PG8_WAIT_V(2); PG8_BAR;
    GM_STAGE(PG8_SB(1, 0), cB + kstep, RB2, ldc_); GM_STAGE(PG8_SA(1, 0), cA + kstep, RA2, ldc_); GM_STAGE(PG8_SB(1, 1), cB + hsc + kstep, RB2, ldc_);
    PG8_WAIT_V(6); PG8_BAR;
    for (;;) {
        const bool has_next = S.next(ui + 1, nxt);
        const char* nA = cA; const char* nB = cB; int ldn = ldc_, ntn = nt;
        if (has_next) gm_unit_info(ga, nxt, nA, nB, ldn, ntn);
        const size_t hsn = (size_t)HALF * ldn * 2;
        for (int t = 0; t < nt; t += 2) {
            const bool last = (t == nt - 2);
            const char* a1 = cA + (size_t)(t + 1) * kstep;
            const char* a2 = last ? nA : cA + (size_t)(t + 2) * kstep; const char* b2 = last ? nB : cB + (size_t)(t + 2) * kstep;
            const char* a3 = a2 + kstep; const char* b3 = b2 + kstep;
            const int ld2 = last ? ldn : ldc_; const size_t hs2 = last ? hsn : hsc;
            PG8_LDB(B0, 0, 0); PG8_LDB(B1, 0, 1); PG8_SCHED; PG8_LDA(At, 0, 0); GM_STAGE(PG8_SA(1, 1), a1 + hsc, RA2, ldc_);
            PG8_WAIT_V(8); PG8_WAIT_L(0); PG8_BAR; PG8_MMA(0, 0, At, B0); PG8_MMA(0, 1, At, B1); PG8_BAR; PG8_SCHED;
            PG8_LDA(At, 0, 1); GM_STAGE(PG8_SB(0, 0), b2, RB2, ld2); GM_STAGE(PG8_SB(0, 1), b2 + hs2, RB2, ld2); GM_STAGE(PG8_SA(0, 0), a2, RA2, ld2);
            PG8_WAIT_V(8); PG8_WAIT_L(0); PG8_BAR; PG8_MMA(1, 0, At, B0); PG8_MMA(1, 1, At, B1); PG8_BAR; PG8_SCHED;
            PG8_LDB(B0, 1, 0); PG8_LDB(B1, 1, 1); PG8_SCHED; PG8_LDA(At, 1, 0); GM_STAGE(PG8_SA(0, 1), a2 + hs2, RA2, ld2);
            PG8_WAIT_V(8); PG8_WAIT_L(0); PG8_BAR; PG8_MMA(0, 0, At, B0); PG8_MMA(0, 1, At, B1); PG8_BAR; PG8_SCHED;
            PG8_LDA(At, 1, 1); GM_STAGE(PG8_SB(1, 0), b3, RB2, ld2); GM_STAGE(PG8_SB(1, 1), b3 + hs2, RB2, ld2); GM_STAGE(PG8_SA(1, 0), a3, RA2, ld2);
            PG8_WAIT_V(8); PG8_WAIT_L(0); PG8_BAR; PG8_MMA(1, 0, At, B0); PG8_MMA(1, 1, At, B1); PG8_BAR; PG8_SCHED;
        }
        if (wr == 0) PG8_BAR;
        gm_epilogue(ga, acc, cur, wr, wc, fr, fq, (const LAS float*)(lds + STAGE_BYTES) + ((ui / 6) & 7) * 256);
        if (!has_next) break;
#pragma unroll
        for (int a = 0; a < 2; ++a)
#pragma unroll
            for (int b = 0; b < 2; ++b)
#pragma unroll
                for (int m = 0; m < 4; ++m)
#pragma unroll
                    for (int n = 0; n < 2; ++n) acc[a][b][m][n] = (f32x4){0.f, 0.f, 0.f, 0.f};
        cur = nxt; cA = nA; cB = nB; ldc_ = ldn; nt = ntn; hsc = hsn; ++ui;
        if (wr == 1) PG8_BAR;
    }
    PG8_WAIT_V(0);
    PG8_BAR;
#undef GM_RFILL
#undef GM_STAGE
#undef PG8_SA
#undef PG8_SB
#undef PG8_LDA
#undef PG8_LDB
#undef PG8_MMA
#undef PG8_WAIT_V
#undef PG8_WAIT_L
#undef PG8_BAR
#undef PG8_SCHED
}
}

DI f32x16 mfma32(bf16x8 a, bf16x8 b, f32x16 c) { return __builtin_amdgcn_mfma_f32_32x32x16_bf16(a, b, c, 0, 0, 0); }
DI s16x4 vtr(const LAS unsigned char* p) { return __builtin_bit_cast(s16x4, __builtin_amdgcn_ds_read_tr16_b64_v4i16((LAS v4i16_t*)p)); }
DI int crow(int r, int hi) { return (r & 3) + 8 * (r >> 2) + 4 * hi; }
DI bf16x8 pack8(const float* w) { u32x4 p; p.x = pk2(w[0], w[1]); p.y = pk2(w[2], w[3]); p.z = pk2(w[4], w[5]); p.w = pk2(w[6], w[7]); return __builtin_bit_cast(bf16x8, p); }

template <bool MASK>
DI void sb_block(const f32x16& p, int kvbase, int qrow, int hi, float& carry, bf16x8& f0, bf16x8& f1) {
    float bt[16], om[16];
#pragma unroll
    for (int i = 0; i < 16; ++i) { const float e = __builtin_amdgcn_exp2f(-p[i]); float b = __builtin_amdgcn_rcpf(1.f + e); float o = 1.f - b;
        if (MASK) { const bool valid = (kvbase + crow(i, hi) < qrow); b = valid ? b : 0.f; o = valid ? o : 1.f; }
        bt[i] = b; om[i] = o; }
    float plo[4], phi[4];
#pragma unroll
    for (int g = 0; g < 4; ++g) { const float gp = (om[4 * g] * om[4 * g + 1]) * (om[4 * g + 2] * om[4 * g + 3]);
        auto rr = __builtin_amdgcn_permlane32_swap(__float_as_uint(gp), __float_as_uint(gp), false, false);
        plo[g] = __uint_as_float(rr[0]); phi[g] = __uint_as_float(rr[1]); }
    float T[4]; T[3] = 1.f; T[2] = plo[3] * phi[3]; T[1] = T[2] * (plo[2] * phi[2]); T[0] = T[1] * (plo[1] * phi[1]);
    const float tot = T[0] * (plo[0] * phi[0]);
    float w[16];
#pragma unroll
    for (int g = 0; g < 4; ++g) { const float w3 = carry * T[g] * (hi ? 1.f : phi[g]);
        const float w2 = w3 * om[4 * g + 3], w1 = w2 * om[4 * g + 2], w0 = w1 * om[4 * g + 1];
        w[4 * g + 3] = bt[4 * g + 3] * w3; w[4 * g + 2] = bt[4 * g + 2] * w2; w[4 * g + 1] = bt[4 * g + 1] * w1; w[4 * g] = bt[4 * g] * w0; }
    carry *= tot;
    f0 = pack8(w); f1 = pack8(w + 8);
}

constexpr int SB_KP = 144, SB_VP = 192, SB_FLAGS = 2 * 64 * SB_KP + 2 * 64 * SB_VP;
DI void sb_unit(int b, int h, int qb, const bf16_t* QO, bf16_t* Ob, const bf16_t* K, const bf16_t* V, LAS unsigned char* lds) {
    const int tid = opaque(threadIdx.x), lane = tid & 63, wid = __builtin_amdgcn_readfirstlane(tid >> 6), r32 = lane & 31, hi = lane >> 5;
    const size_t rowbase = (size_t)b * SEQ;
    const int q0w = qb * 256 + wid * 32, qrow = q0w + r32;
    const bf16_t* qp = QO + (rowbase + qrow) * 512 + h * 64;
    bf16x8 qf[4];
#pragma unroll
    for (int ks = 0; ks < 4; ++ks) qf[ks] = *(const bf16x8*)(qp + ks * 16 + hi * 8);
    const int nt = 4 * qb + 4;
    const int lrow = tid >> 3, lch = tid & 7;
    const bf16_t* kg = K + (rowbase + lrow) * 512 + h * 64 + lch * 8;
    const bf16_t* vg = V + (rowbase + lrow) * 512 + h * 64 + lch * 8;
    LAS unsigned char* Kb = lds; LAS unsigned char* Vb = lds + 2 * 64 * SB_KP;
    LAS unsigned char* flags = lds + SB_FLAGS;
    const int kst = lrow * SB_KP + lch * 16, vst = lrow * SB_VP + lch * 16;
    u32x4 kr = *(const u32x4*)(kg + (size_t)(nt - 1) * 64 * 512), vr = *(const u32x4*)(vg + (size_t)(nt - 1) * 64 * 512);
    *(LAS u32x4*)(Kb + kst) = kr; *(LAS u32x4*)(Vb + vst) = vr;
    __syncthreads();
    f32x16 o0, o1;
#pragma unroll
    for (int i = 0; i < 16; ++i) { o0[i] = 0.f; o1[i] = 0.f; }
    float carry = 1.f; int cur = 0;
    const int vlane = (4 * hi + ((lane & 15) >> 2)) * SB_VP + (16 * ((lane >> 4) & 1) + 4 * (lane & 3)) * 2;
    for (int t = nt - 1; t >= 0; --t) {
        if (t > 0) { kr = *(const u32x4*)(kg + (size_t)(t - 1) * 64 * 512); vr = *(const u32x4*)(vg + (size_t)(t - 1) * 64 * 512); }
        const LAS unsigned char* Kc = Kb + cur * 64 * SB_KP; const LAS unsigned char* Vc = Vb + cur * 64 * SB_VP;
        const bool wdone = !__any(carry >= 1e-30f);
        if (64 * t < q0w + 31 && !wdone) {
            f32x16 p0, p1;
#pragma unroll
            for (int i = 0; i < 16; ++i) { p0[i] = 0.f; p1[i] = 0.f; }
            { bf16x8 a0[4], a1[4];
#pragma unroll
              for (int ks = 0; ks < 4; ++ks) { a0[ks] = *(const LAS bf16x8*)(Kc + r32 * SB_KP + (ks * 16 + hi * 8) * 2); a1[ks] = *(const LAS bf16x8*)(Kc + (32 + r32) * SB_KP + (ks * 16 + hi * 8) * 2); }
              __builtin_amdgcn_sched_barrier(0);
#pragma unroll
              for (int ks = 0; ks < 4; ++ks) { p0 = mfma32(a0[ks], qf[ks], p0); p1 = mfma32(a1[ks], qf[ks], p1); } }
            s16x4 vlo[8], vhh[8];
#pragma unroll
            for (int kk = 0; kk < 4; ++kk) { const LAS unsigned char* vp = Vc + vlane + 16 * kk * SB_VP;
                vlo[2 * kk] = vtr(vp); vhh[2 * kk] = vtr(vp + 8 * SB_VP); vlo[2 * kk + 1] = vtr(vp + 64); vhh[2 * kk + 1] = vtr(vp + 64 + 8 * SB_VP); }
            __builtin_amdgcn_sched_barrier(0);
            bf16x8 fr[4];
            if (64 * t + 63 >= q0w) { sb_block<true>(p1, 64 * t + 32, qrow, hi, carry, fr[2], fr[3]); sb_block<true>(p0, 64 * t, qrow, hi, carry, fr[0], fr[1]); }
            else { sb_block<false>(p1, 64 * t + 32, qrow, hi, carry, fr[2], fr[3]); sb_block<false>(p0, 64 * t, qrow, hi, carry, fr[0], fr[1]); }
            __builtin_amdgcn_sched_barrier(0);
#pragma unroll
            for (int kk = 0; kk < 4; ++kk) {
                { const bf16x8 vb = __builtin_shufflevector(vlo[2 * kk], vhh[2 * kk], 0, 1, 2, 3, 4, 5, 6, 7); o0 = mfma32(fr[kk], vb, o0); }
                { const bf16x8 vb = __builtin_shufflevector(vlo[2 * kk + 1], vhh[2 * kk + 1], 0, 1, 2, 3, 4, 5, 6, 7); o1 = mfma32(fr[kk], vb, o1); }
            }
        }
        if (lane == 0) flags[(t & 1) * 8 + wid] = __any(carry >= 1e-30f) ? 0 : 1;
        if (t > 0) { *(LAS u32x4*)(Kb + (cur ^ 1) * 64 * SB_KP + kst) = kr; *(LAS u32x4*)(Vb + (cur ^ 1) * 64 * SB_VP + vst) = vr; }
        __syncthreads(); cur ^= 1;
        const unsigned long long fl = *(const LAS unsigned long long*)(flags + (t & 1) * 8);
        if (fl == 0x0101010101010101ull) break;
    }
    bf16_t* ob = Ob + (rowbase + q0w) * 512 + h * 64 + r32;
#pragma unroll
    for (int i = 0; i < 16; ++i) { const int r = crow(i, hi); ob[(size_t)r * 512] = f2bf(o0[i]); ob[(size_t)r * 512 + 32] = f2bf(o1[i]); }
}

constexpr int A2_KP = 272, A2_VP = 320, A2_WS = 2 * 64 * A2_KP + 2 * 64 * A2_VP;
DI void bcast_rows(LAS float* wsf, float v, int r32, int hi, float (&out)[16]) {
    if (hi == 0) wsf[r32] = v;
    asm volatile("s_waitcnt lgkmcnt(0)" ::: "memory");
#pragma unroll
    for (int i = 0; i < 16; ++i) out[i] = wsf[crow(i, hi)];
    asm volatile("s_waitcnt lgkmcnt(0)" ::: "memory");
}
DI float half_swap_max(float m) { auto rr = __builtin_amdgcn_permlane32_swap(__float_as_uint(m), __float_as_uint(m), false, false); return fmaxf(__uint_as_float(rr[0]), __uint_as_float(rr[1])); }
DI float half_swap_sum(float m) { auto rr = __builtin_amdgcn_permlane32_swap(__float_as_uint(m), __float_as_uint(m), false, false); return __uint_as_float(rr[0]) + __uint_as_float(rr[1]); }

template <bool DIFF>
DI void attn2_unit(int qb, const bf16_t* QO  , bf16_t* Ob, const bf16_t* K, const bf16_t* V  ,
                   int ntile, float lam, const float* gain, float post, LAS unsigned char* lds) {
    const int tid = opaque(threadIdx.x), lane = tid & 63, wid = __builtin_amdgcn_readfirstlane(tid >> 6), r32 = lane & 31, hi = lane >> 5;
    const int q0w = qb * 256 + wid * 32, qrow = q0w + r32;
    const bf16_t* qp = QO + (size_t)qrow * 512;
    LAS unsigned char* qst = lds + A2_WS + 2048 + wid * 8192 + lane * 16;
#pragma unroll
    for (int ks = 0; ks < 8; ++ks) *(LAS bf16x8*)(qst + ks * 1024) = *(const bf16x8*)(qp + ks * 16 + hi * 8);
    const int lrow = tid >> 3, lch = tid & 7;
    const bf16_t* kg = K + (size_t)lrow * 512 + lch * 16;
    const bf16_t* vg = V + (size_t)lrow * 512 + lch * 16;
    LAS unsigned char* Kb = lds; LAS unsigned char* Vb = lds + 2 * 64 * A2_KP;
    LAS float* wsf = (LAS float*)(lds + A2_WS) + wid * 64;
    const int kst = lrow * A2_KP + lch * 32, vst = lrow * A2_VP + lch * 32;
    const int vlane = (4 * hi + ((lane & 15) >> 2)) * A2_VP + (16 * ((lane >> 4) & 1) + 4 * (lane & 3)) * 2;
    constexpr int NC = DIFF ? 2 : 1;
    float mref[2] = {-1e30f, -1e30f}, ls[2] = {0.f, 0.f};
    bool ref0[2] = {false, false}, inited[2] = {false, false};
    f32x16 o1[4], o2[4];
#pragma unroll
    for (int d = 0; d < 4; ++d)
#pragma unroll
        for (int i = 0; i < 16; ++i) { o1[d][i] = 0.f; o2[d][i] = 0.f; }
    u32x4 kr0 = *(const u32x4*)(kg), kr1 = *(const u32x4*)(kg + 8), vr0 = *(const u32x4*)(vg), vr1 = *(const u32x4*)(vg + 8);
    *(LAS u32x4*)(Kb + kst) = kr0; *(LAS u32x4*)(Kb + kst + 16) = kr1; *(LAS u32x4*)(Vb + vst) = vr0; *(LAS u32x4*)(Vb + vst + 16) = vr1;
    __syncthreads();
    int cur = 0;
    for (int t = 0; t < ntile; ++t) {
        const bool more = (t + 1 < ntile);
        if (more) { const size_t go = (size_t)(t + 1) * 64 * 512; kr0 = *(const u32x4*)(kg + go); kr1 = *(const u32x4*)(kg + go + 8); vr0 = *(const u32x4*)(vg + go); vr1 = *(const u32x4*)(vg + go + 8); }
        const LAS unsigned char* Kc = Kb + cur * 64 * A2_KP; const LAS unsigned char* Vc = Vb + cur * 64 * A2_VP;
#pragma unroll
        for (int blk = 0; blk < 2; ++blk) {
            const int kv0 = 64 * t + 32 * blk;
            if (DIFF && kv0 > q0w + 31) continue;
            const bool diag = DIFF && (kv0 + 31 > q0w);
#pragma unroll
            for (int c = 0; c < NC; ++c) {
                f32x16 p;
#pragma unroll
                for (int i = 0; i < 16; ++i) p[i] = 0.f;
                constexpr int KS = DIFF ? 4 : 8;
                {
                    bf16x8 ka[KS], qa[KS];
#pragma unroll
                    for (int ks = 0; ks < KS; ++ks) { const int kk = c * 4 + ks;
                        ka[ks] = *(const LAS bf16x8*)(Kc + (32 * blk + r32) * A2_KP + (kk * 16 + hi * 8) * 2);
                        qa[ks] = *(const LAS bf16x8*)(qst + kk * 1024); }
                    __builtin_amdgcn_sched_barrier(0);
#pragma unroll
                    for (int ks = 0; ks < KS; ++ks) p = mfma32(ka[ks], qa[ks], p);
                }
                s16x4 vlo[8], vhh[8];
                { const LAS unsigned char* vp = Vc + vlane + 16 * (2 * blk) * A2_VP;
#pragma unroll
                    for (int d0 = 0; d0 < 4; ++d0) { vlo[d0] = vtr(vp + d0 * 64); vhh[d0] = vtr(vp + d0 * 64 + 8 * A2_VP); } }
                __builtin_amdgcn_sched_barrier(0);
                if (diag) {
#pragma unroll
                    for (int i = 0; i < 16; ++i) { if (kv0 + crow(i, hi) > qrow) p[i] = -1e30f; }
                }
                float mm = mref[c]; float w[16]; float sm = 0.f;
                if (ref0[c]) {
#pragma unroll
                    for (int i = 0; i < 16; ++i) { w[i] = __builtin_amdgcn_exp2f(p[i]); sm += w[i]; }
                } else {
#pragma unroll
                    for (int i = 0; i < 16; ++i) { w[i] = __builtin_amdgcn_exp2f(p[i] - mm); sm += w[i]; }
                }
                if (__any(!(sm <= (ref0[c] ? 1.0e30f : 256.f)))) {
                    float tm = fmaxf(p[0], p[1]);
#pragma unroll
                    for (int i = 2; i < 16; i += 2) tm = fmaxf(fmaxf(tm, p[i]), p[i + 1]);
                    tm = half_swap_max(tm);
                    if (!inited[c] && !__any(!(fabsf(tm) <= 40.f))) {
                        mref[c] = 0.f; mm = 0.f; ref0[c] = true;
                    } else {
                        const float mn = fmaxf(mref[c], tm); const float f = __builtin_amdgcn_exp2f(mref[c] - mn); ls[c] *= f; mref[c] = mn; mm = mn; ref0[c] = false;
                        float f16[16]; bcast_rows(wsf, f, r32, hi, f16);
                        if (c == 0) {
#pragma unroll
                            for (int d = 0; d < 4; ++d)
#pragma unroll
                                for (int i = 0; i < 16; ++i) o1[d][i] *= f16[i];
                        } else {
#pragma unroll
                            for (int d = 0; d < 4; ++d)
#pragma unroll
                                for (int i = 0; i < 16; ++i) o2[d][i] *= f16[i];
                        }
                    }
                    inited[c] = true;
                    sm = 0.f;
#pragma unroll
                    for (int i = 0; i < 16; ++i) { w[i] = __builtin_amdgcn_exp2f(p[i] - mm); sm += w[i]; }
                }
                ls[c] += sm;
                const bf16x8 fr0 = pack8(w), fr1 = pack8(w + 8);
                __builtin_amdgcn_sched_barrier(0);
                { const LAS unsigned char* vp = Vc + vlane + 16 * (2 * blk + 1) * A2_VP;
#pragma unroll
                    for (int d0 = 0; d0 < 4; ++d0) { vlo[4 + d0] = vtr(vp + d0 * 64); vhh[4 + d0] = vtr(vp + d0 * 64 + 8 * A2_VP); } }
                __builtin_amdgcn_sched_barrier(0);
#pragma unroll
                for (int s2 = 0; s2 < 2; ++s2) {
#pragma unroll
                    for (int d0 = 0; d0 < 4; ++d0) { const bf16x8 vb = __builtin_shufflevector(vlo[s2 * 4 + d0], vhh[s2 * 4 + d0], 0, 1, 2, 3, 4, 5, 6, 7);
                        if (c == 0) o1[d0] = mfma32(s2 ? fr1 : fr0, vb, o1[d0]); else o2[d0] = mfma32(s2 ? fr1 : fr0, vb, o2[d0]); }
                }
            }
        }
        if (more) { LAS unsigned char* kd = Kb + (cur ^ 1) * 64 * A2_KP + kst; *(LAS u32x4*)kd = kr0; *(LAS u32x4*)(kd + 16) = kr1;
            LAS unsigned char* vd = Vb + (cur ^ 1) * 64 * A2_VP + vst; *(LAS u32x4*)vd = vr0; *(LAS u32x4*)(vd + 16) = vr1; }
        __syncthreads(); cur ^= 1;
    }
    float a1[16], a2[16];
    { const float l1 = half_swap_sum(ls[0]); bcast_rows(wsf, 1.f / l1, r32, hi, a1); }
    if (DIFF) { const float l2 = half_swap_sum(ls[1]); bcast_rows(wsf, -lam / l2, r32, hi, a2); }
#pragma unroll
    for (int d = 0; d < 4; ++d)
#pragma unroll
        for (int i = 0; i < 16; ++i) { o1[d][i] *= a1[i]; if (DIFF) o1[d][i] += o2[d][i] * a2[i]; }
    bf16_t* ob = Ob + (size_t)q0w * 512 + r32;
    if (DIFF) {
        const float g0 = gain[r32] * post, g1 = gain[32 + r32] * post, g2 = gain[64 + r32] * post, g3 = gain[96 + r32] * post;
#pragma unroll
        for (int i = 0; i < 16; ++i) {
            float ss = o1[0][i] * o1[0][i] + o1[1][i] * o1[1][i] + o1[2][i] * o1[2][i] + o1[3][i] * o1[3][i];
            ss += __shfl_xor(ss, 1); ss += __shfl_xor(ss, 2); ss += __shfl_xor(ss, 4); ss += __shfl_xor(ss, 8); ss += __shfl_xor(ss, 16);
            const float rs = rsqrtf(ss * (1.f / 128.f) + RMS_EPS);
            bf16_t* rp = ob + (size_t)crow(i, hi) * 512;
            rp[0] = f2bf(o1[0][i] * rs * g0); rp[32] = f2bf(o1[1][i] * rs * g1); rp[64] = f2bf(o1[2][i] * rs * g2); rp[96] = f2bf(o1[3][i] * rs * g3);
        }
    } else {
#pragma unroll
        for (int i = 0; i < 16; ++i) { bf16_t* rp = ob + (size_t)crow(i, hi) * 512;
            rp[0] = f2bf(o1[0][i]); rp[32] = f2bf(o1[1][i]); rp[64] = f2bf(o1[2][i]); rp[96] = f2bf(o1[3][i]); }
    }
}

DI void transpose_item(const float* W, int K, int N, bf16_t* WT, int drow0, LAS float* scr, int k0, int n0, int lane, bool ropeperm) {
#pragma unroll
    for (int i = 0; i < 32; ++i) { const int kk = 2 * i + (lane >> 5); scr[kk * 33 + (lane & 31)] = W[(size_t)(k0 + kk) * N + n0 + (lane & 31)]; }
    asm volatile("s_waitcnt lgkmcnt(0)" ::: "memory");
    const int c = lane & 7;
#pragma unroll
    for (int j = 0; j < 4; ++j) { const int n = (lane >> 3) + 8 * j;
        int ns = n; if (ropeperm && n < 16) { const int gq = (n >> 2) & 3; ns = (n & 3) | ((gq == 1 ? 2 : gq == 2 ? 1 : gq) << 2); }
        const LAS float* s = scr + (8 * c) * 33 + ns;
        u32x4 o; o.x = pk2(s[0 * 33], s[1 * 33]); o.y = pk2(s[2 * 33], s[3 * 33]); o.z = pk2(s[4 * 33], s[5 * 33]); o.w = pk2(s[6 * 33], s[7 * 33]);
        *(u32x4*)(WT + (size_t)(drow0 + n) * K + k0 + 8 * c) = o; }
    asm volatile("s_waitcnt lgkmcnt(0)" ::: "memory");
}
DI void transpose_mat(const float* W, int K, int N, bf16_t* WT, bool glu, LAS float* scr, int gw, int ngw, int lane, int& goff, int rope_lo = -1, int rope_hi = -1) {
    lane = opaque(lane); gw = opaque_s(gw);
    const int nblk = N / 32, items = (K / 64) * nblk;
    int first = gw - (goff % ngw); if (first < 0) first += ngw;
    goff += items;
    for (int it = first; it < items; it += ngw) { const int kb = it / nblk, nb = it % nblk, n0 = nb * 32;
        int d0 = n0; if (glu) d0 = (n0 < 512) ? (n0 / 128) * 256 + (n0 % 128) : ((n0 - 512) / 128) * 256 + 128 + ((n0 - 512) % 128);
        transpose_item(W, K, N, WT, d0, scr, kb * 64, n0, lane, (n0 >= rope_lo) && (n0 < rope_hi) && ((n0 & 63) == 0)); }
}
DI void rms_row_bf16(const float* xrow, const float* gain, bf16_t* orow, int lane) {
    lane = opaque(lane);
    const f32x4* xr = (const f32x4*)xrow + lane; const f32x4* gr = (const f32x4*)gain + lane;
    f32x4 v[4]; float s = 0.f;
#pragma unroll
    for (int j = 0; j < 4; ++j) { v[j] = xr[64 * j]; s += (v[j].x * v[j].x + v[j].y * v[j].y) + (v[j].z * v[j].z + v[j].w * v[j].w); }
    const float r = rsqrtf(wave_sum(s) * (1.f / DM) + RMS_EPS);
    unsigned long long* o8 = (unsigned long long*)orow + lane;
#pragma unroll
    for (int j = 0; j < 4; ++j) { const f32x4 gq = gr[64 * j];
        o8[64 * j] = (unsigned long long)pk2(v[j].x * r * gq.x, v[j].y * r * gq.y) | ((unsigned long long)pk2(v[j].z * r * gq.z, v[j].w * r * gq.w) << 32); }
}
DI void prep_row_bf16(const float* xrow, const float* gain, bf16_t* orow, float* prow, int lane) {
    lane = opaque(lane);
    const f32x4* xr = (const f32x4*)xrow + lane; const f32x4* gr = (const f32x4*)gain + lane;
    f32x4 v[4]; float s = 0.f;
#pragma unroll
    for (int j = 0; j < 4; ++j) { v[j] = xr[64 * j]; s += (v[j].x * v[j].x + v[j].y * v[j].y) + (v[j].z * v[j].z + v[j].w * v[j].w); }
    s = wave_sum(s);
    if (lane < 16) prow[lane] = (lane == 0) ? s : 0.f;
    unsigned long long* o8 = (unsigned long long*)orow + lane;
#pragma unroll
    for (int j = 0; j < 4; ++j) { const f32x4 gq = gr[64 * j];
        o8[64 * j] = (unsigned long long)pk2(v[j].x * gq.x, v[j].y * gq.y) | ((unsigned long long)pk2(v[j].z * gq.z, v[j].w * gq.w) << 32); }
}
DI void rms_row_f32(float* xrow, const float* gain, int lane) {
    lane = opaque(lane);
    f32x4* xr = (f32x4*)xrow + lane; const f32x4* gr = (const f32x4*)gain + lane;
    f32x4 v[4]; float s = 0.f;
#pragma unroll
    for (int j = 0; j < 4; ++j) { v[j] = xr[64 * j]; s += (v[j].x * v[j].x + v[j].y * v[j].y) + (v[j].z * v[j].z + v[j].w * v[j].w); }
    const float r = rsqrtf(wave_sum(s) * (1.f / DM) + RMS_EPS);
#pragma unroll
    for (int j = 0; j < 4; ++j) xr[64 * j] = v[j] * r * gr[64 * j];
}

struct Params {
    const float* x; const float* mem; const int* pos;
    const float *norm_mix, *w_in, *lam_re, *lam_im, *log_dt, *b_re, *b_im, *c_re, *c_im, *ssm_d, *w_glu, *diff_lambda, *diff_subln, *w_branch, *w_out,
                *norm_cross, *norm_mem, *w_xq, *w_xkv, *w_xo, *norm_mlp, *w_up, *w_down, *norm_final;
    float* out; unsigned char* ws;
};

typedef const __attribute__((address_space(4))) Params* KPtr;
DI KPtr kp_get() { unsigned long long v = (unsigned long long)__builtin_amdgcn_kernarg_segment_ptr(); asm volatile("" : "+s"(v)); return (KPtr)v; }
#define PP (kp_get())

DI void ssm_prep(int l, LAS unsigned char* lds) {
    const int tid = opaque(threadIdx.x);
    LAS f32x2_t* E = (LAS f32x2_t*)lds;
    LAS f32x2_t* Bb = (LAS f32x2_t*)(lds + 33 * 64 * 8);
    LAS f32x2_t* Cc = (LAS f32x2_t*)(lds + 33 * 64 * 8 + 1024 * 8);
    LAS float* Kk = (LAS float*)(lds + 33 * 64 * 8 + 1024 * 8 + 64 * 8);
    bf16_t* toep = (bf16_t*)(PP->ws + WS_TOEP); bf16_t* wst = (bf16_t*)(PP->ws + WS_WST); f32x2_t* lamT = (f32x2_t*)(PP->ws + WS_LAMT);
    const float* lre = PP->lam_re + l * 2048; const float* lim = PP->lam_im + l * 2048; const float* ldt = PP->log_dt + l * 32;
    const float* bre = PP->b_re + (size_t)l * 32768; const float* bim = PP->b_im + (size_t)l * 32768;
    const float* cre = PP->c_re + (size_t)l * 32768; const float* cim = PP->c_im + (size_t)l * 32768; const float* dsk = PP->ssm_d + l * 512;
    for (int un = blockIdx.x; un < 512; un += gridDim.x) {
        const int g = un >> 4, co = un & 15; const float dt = __expf(ldt[g]);
        for (int idx = tid; idx < 33 * 64; idx += 512) { const int tau = idx >> 6, p = idx & 63; const float lr = lre[g * 64 + p] * dt; const double li = (double)(lim[g * 64 + p] * dt);
            const float mag = __expf(tau * lr); float s, c; sincos_red(tau * li, s, c); E[idx] = (f32x2_t){mag * c, mag * s}; }
        for (int idx = tid; idx < 1024; idx += 512) { const int p = idx >> 4, ci = idx & 15; const float ar = lre[g * 64 + p], ai = lim[g * 64 + p];
            const float mag = __expf(ar * dt); float s, c; sincos_red((double)(ai * dt), s, c);
            const float nr = mag * c - 1.f, ni = mag * s; const float den = 1.f / (ar * ar + ai * ai);
            const float qr = (nr * ar + ni * ai) * den, qi = (ni * ar - nr * ai) * den;
            const float br = bre[(size_t)(g * 64 + p) * 16 + ci], bi = bim[(size_t)(g * 64 + p) * 16 + ci];
            Bb[idx] = (f32x2_t){qr * br - qi * bi, qr * bi + qi * br}; }
        if (tid < 64) Cc[tid] = (f32x2_t){cre[(size_t)(g * 16 + co) * 64 + tid], cim[(size_t)(g * 16 + co) * 64 + tid]};
        __syncthreads();
        { const int tau = tid >> 4, ci = tid & 15; float a = 0.f;
            for (int p = 0; p < 64; ++p) { const f32x2_t e = E[tau * 64 + p], cc = Cc[p], bb = Bb[p * 16 + ci];
                const float cr = cc.x * e.x - cc.y * e.y, cim2 = cc.x * e.y + cc.y * e.x; a += cr * bb.x - cim2 * bb.y; }
            Kk[tid] = a; }
        __syncthreads();
        const float dval = dsk[g * 16 + co];
        for (int idx = tid; idx < 32 * SSM_K2; idx += 512) { const int t = idx / SSM_K2, k = idx % SSM_K2; float val;
            if (k < 512) { const int s = k >> 4, ci = k & 15; val = (t >= s) ? Kk[(t - s) * 16 + ci] : 0.f; if (s == t && ci == co) val += dval; }
            else { const int p = (k - 512) & 63; const f32x2_t e = E[(t + 1) * 64 + p], cc = Cc[p];
                val = (k < 576) ? (cc.x * e.x - cc.y * e.y) : -(cc.x * e.y + cc.y * e.x); }
            toep[(size_t)(g * 512 + t * 16 + co) * SSM_K2 + k] = f2bf(val); }
        __syncthreads();
    }
    for (int un = blockIdx.x; un < 2048; un += gridDim.x) {
        const int g = un >> 6, p = un & 63; const float dt = __expf(ldt[g]); const int s = tid >> 4, ci = tid & 15;
        const float ar = lre[g * 64 + p], ai = lim[g * 64 + p];
        float sn, cs; const float mag = __expf(ar * dt); sincos_red((double)(ai * dt), sn, cs);
        const float nr = mag * cs - 1.f, ni = mag * sn; const float den = 1.f / (ar * ar + ai * ai);
        const float qr = (nr * ar + ni * ai) * den, qi = (ni * ar - nr * ai) * den;
        const float br = bre[(size_t)(g * 64 + p) * 16 + ci], bi = bim[(size_t)(g * 64 + p) * 16 + ci];
        const float bbr = qr * br - qi * bi, bbi = qr * bi + qi * br;
        const int tau = 31 - s; const float em = __expf(tau * ar * dt); float es, ec; sincos_red((double)tau * (double)(ai * dt), es, ec);
        const float er = em * ec, ei = em * es;
        const size_t o = (size_t)(g * 256 + p) * 512 + s * 16 + ci;
        wst[o] = f2bf(er * bbr - ei * bbi); wst[o + 64 * 512] = f2bf(er * bbi + ei * bbr); wst[o + 128 * 512] = 0; wst[o + 192 * 512] = 0;
        if (tid == 0) { const float m32 = __expf(32.f * ar * dt); float s3, c3; sincos_red(32.0 * (double)(ai * dt), s3, c3); lamT[g * 64 + p] = (f32x2_t){m32 * c3, m32 * s3}; }
    }
}

DI void ssm_scan(LAS unsigned char* lds) {
    const int tid = opaque(threadIdx.x);
    const float* sloc = (const float*)(PP->ws + WS_SLOC); bf16_t* a2 = (bf16_t*)(PP->ws + WS_A2); const f32x2_t* lamT = (const f32x2_t*)(PP->ws + WS_LAMT);
    for (int un = blockIdx.x; un < NB * 32; un += gridDim.x) {
        const int g = un & 31, b = un >> 5; const size_t r0 = (size_t)g * SSM_M2 + b * SSM_NC;
        const f32x4* src = (const f32x4*)(sloc + r0 * 128) + tid;
#pragma unroll
        for (int j = 0; j < 8; ++j) ((LAS f32x4*)lds)[tid + j * 512] = src[j * 512];
        __syncthreads();
        if (tid < 64) { const int p = tid; const f32x2_t lt = lamT[g * 64 + p]; float sr = 0.f, si = 0.f; const LAS float* L = (const LAS float*)lds;
            bf16_t* dst = a2 + r0 * SSM_K2 + 512 + p;
#pragma unroll 8
            for (int c = 0; c < SSM_NC; ++c) { dst[(size_t)c * SSM_K2] = f2bf(sr); dst[(size_t)c * SSM_K2 + 64] = f2bf(si);
                const float lr = L[c * 128 + p], li = L[c * 128 + 64 + p];
                const float nr = lt.x * sr - lt.y * si + lr, ni = lt.x * si + lt.y * sr + li; sr = nr; si = ni; } }
        __syncthreads();
    }
}

#define XB_TMO      128
#define XB_XCNT(j)  (256  + 64 * (j))
#define XB_XSUB(j)  (1280 + 64 * (j))
#define XB_XGEN(j)  (2304 + 64 * (j))
#define XB_TOP      3328
#define XB_TOPGEN   3392
#define XCD_BAR_WORDS 3456
#define XB_SPIN_CAP (1u << 18)
DI unsigned xb_ld(unsigned* p)              { return __hip_atomic_load(p, __ATOMIC_RELAXED, __HIP_MEMORY_SCOPE_AGENT); }
DI unsigned xb_add(unsigned* p, unsigned v) { return __hip_atomic_fetch_add(p, v, __ATOMIC_RELAXED, __HIP_MEMORY_SCOPE_AGENT); }
DI unsigned xb_xcc_id() { return (unsigned)__builtin_amdgcn_s_getreg((3 << 11) | 20) & 0xFu; }
#define XB_SPIN(cond, bar) do { unsigned _sp = 0; while (cond) { __builtin_amdgcn_s_sleep(1); \
    if ((++_sp & 255u) == 0u) { if (xb_ld(&(bar)[XB_TMO])) break; if (_sp > XB_SPIN_CAP) { atomicAdd(&(bar)[XB_TMO], 1u); break; } } } } while (0)
struct XcdBarrier { unsigned* bar; unsigned x; volatile LAS unsigned* st; };
DI XcdBarrier xcd_barrier_post(unsigned* bar, volatile LAS unsigned* st) {
    XcdBarrier b; b.bar = bar; b.x = xb_xcc_id(); b.st = st;
    if (threadIdx.x == 0) (void)xb_add(&bar[XB_XCNT(b.x)], 1u);
    return b;
}
DI void xcd_barrier_complete(unsigned* bar, unsigned x, unsigned& nloc, unsigned& nx) {
    const unsigned G = gridDim.x * gridDim.y * gridDim.z;
    unsigned sum, cnt, mine, sp = 0u;
    for (;;) {
        sum = 0u; cnt = 0u; mine = 0u;
#pragma unroll
        for (unsigned j = 0; j < 16; ++j) { const unsigned c = xb_ld(&bar[XB_XCNT(j)]); sum += c; cnt += (c > 0u) ? 1u : 0u; mine = (j == x) ? c : mine; }
        if (sum == G) break;
        __builtin_amdgcn_s_sleep(1);
        if ((++sp & 255u) == 0u) { if (xb_ld(&bar[XB_TMO])) break; if (sp > XB_SPIN_CAP) { atomicAdd(&bar[XB_TMO], 1u); break; } }
    }
    nloc = mine > 0u ? mine : 1u; nx = cnt > 0u ? cnt : 1u;
}
DI void xcd_barrier(const XcdBarrier& b) {
    asm volatile("s_waitcnt vmcnt(0)" ::: "memory");
    __syncthreads();
    if (opaque((int)threadIdx.x) == 0) {
        unsigned* bar = b.bar;
        __builtin_amdgcn_s_waitcnt(0);
        unsigned nloc = b.st[0], nx = b.st[1];
        if (nloc == 0u) { xcd_barrier_complete(bar, b.x, nloc, nx); b.st[0] = nloc; b.st[1] = nx; }
        const unsigned old = xb_add(&bar[XB_XSUB(b.x)], 1u);
        const unsigned gen = old / nloc;
        if (old + 1u == (gen + 1u) * nloc) {
            __builtin_amdgcn_fence(__ATOMIC_RELEASE, "agent");
            asm volatile("s_waitcnt vmcnt(0)" ::: "memory");
            const unsigned og = xb_add(&bar[XB_TOP], 1u);
            const unsigned tg = og / nx;
            if (og + 1u == (tg + 1u) * nx) xb_add(&bar[XB_TOPGEN], 1u);
            else XB_SPIN(xb_ld(&bar[XB_TOPGEN]) == tg, bar);
            __builtin_amdgcn_fence(__ATOMIC_ACQUIRE, "agent");
            xb_add(&bar[XB_XGEN(b.x)], 1u);
            asm volatile("s_waitcnt vmcnt(0)" ::: "memory");
        } else {
            XB_SPIN(xb_ld(&bar[XB_XGEN(b.x)]) == gen, bar);
            __builtin_amdgcn_fence(__ATOMIC_ACQUIRE, "agent");
            asm volatile("s_waitcnt vmcnt(0)" ::: "memory");
        }
    }
    __syncthreads();
}

#define HBUF ((bf16_t*)(PP->ws + WS_H))
#define LAMS ((float*)(PP->ws + WS_LAMT + 65536))
__global__ void __launch_bounds__(512, 2) fwd_megakernel(Params P) {
    extern __shared__ __attribute__((aligned(16))) unsigned char lds_raw[];
    LAS unsigned char* lds = (LAS unsigned char*)lds_raw;
    cg::grid_group grid = cg::this_grid();
    const int tid = threadIdx.x, lane = tid & 63, wave = __builtin_amdgcn_readfirstlane(tid >> 6);
    const int G = gridDim.x, c = blockIdx.x;
    const int gw = c * 8 + wave, ngw = G * 8;
    LAS float* scr = (LAS float*)(lds + wave * 16384);
    if (tid < 4) ((LAS unsigned*)(lds + LDS_CTL + 64))[tid] = 0u;
    __syncthreads();
    if (c == 0) { unsigned* bw = (unsigned*)PP->ws + 4096; for (int i = tid; i < XCD_BAR_WORDS; i += 512) bw[i] = 0u; }
    XcdBarrier xbar; xbar.bar = (unsigned*)PP->ws + 4096; xbar.x = xb_xcc_id(); xbar.st = (volatile LAS unsigned*)(lds + LDS_CTL + 64);

    int goff = 0;
    for (int i = c * 512 + tid; i < MTOK * 8; i += G * 512) { const int row = i >> 3, j = i & 7;
        const float invf = __builtin_amdgcn_exp2f(-(float)j * 2.3664460712f);   const float ang = (float)PP->pos[row] * invf; float s, cs; sincos_red((double)ang, s, cs);
        ((f32x2_t*)(PP->ws + WS_ROPE))[i] = (f32x2_t){cs, s}; }
    if (c == 0 && tid < DEPTH) { const float* lv = PP->diff_lambda + tid * 256; float a = 0.f, b = 0.f;
        for (int k = 0; k < 64; ++k) { a += lv[k] * lv[64 + k]; b += lv[128 + k] * lv[192 + k]; }
        LAMS[tid] = expf(a) - expf(b) + (0.8f - 0.6f * expf(-0.3f * (float)tid)); }
    for (int r = gw; r < DEPTH * NB * MEML; r += ngw) { const int l = r / (NB * MEML), m = r % (NB * MEML);
        rms_row_bf16(PP->mem + (size_t)m * DM, PP->norm_mem + l * DM, (bf16_t*)(PP->ws + WS_MEMN) + (size_t)r * DM, lane); }
    for (int l = 0; l < DEPTH; ++l) transpose_mat(PP->w_xkv + (size_t)l * DM * 1024, DM, 1024, (bf16_t*)(PP->ws + WS_WXKV) + (size_t)l * 1024 * DM, false, scr, gw, ngw, lane, goff);

    for (int l = 0; l < DEPTH; ++l) {
        const float* xin = (l == 0) ? PP->x : PP->out;
        transpose_mat(PP->w_in + (size_t)l * DM * NIN, DM, NIN, (bf16_t*)(PP->ws + WS_WIN), false, scr, gw, ngw, lane, goff, 2048, 3072);
        transpose_mat(PP->w_glu + (size_t)l * 512 * 1024, 512, 1024, (bf16_t*)(PP->ws + WS_WGLU), true, scr, gw, ngw, lane, goff);
        for (int z = 0; z < 3; ++z) transpose_mat(PP->w_branch + ((size_t)l * 3 + z) * 512 * DM, 512, DM, (bf16_t*)(PP->ws + WS_WB) + (size_t)z * DM * 512, false, scr, gw, ngw, lane, goff);
        transpose_mat(PP->w_out + (size_t)l * DM * DM, DM, DM, (bf16_t*)(PP->ws + WS_WOUT), false, scr, gw, ngw, lane, goff);
        transpose_mat(PP->w_xq + (size_t)l * DM * 512, DM, 512, (bf16_t*)(PP->ws + WS_WXQ), false, scr, gw, ngw, lane, goff);
        transpose_mat(PP->w_xo + (size_t)l * 512 * DM, 512, DM, (bf16_t*)(PP->ws + WS_WXO), false, scr, gw, ngw, lane, goff);
        transpose_mat(PP->w_up + (size_t)l * DM * 4096, DM, 4096, (bf16_t*)(PP->ws + WS_WUP), false, scr, gw, ngw, lane, goff);
        transpose_mat(PP->w_down + (size_t)l * 4096 * DM, 4096, DM, (bf16_t*)(PP->ws + WS_WDN), false, scr, gw, ngw, lane, goff);
        __syncthreads();
        ssm_prep(l, lds);
        if (l == 0) for (int r = gw; r < MTOK; r += ngw) prep_row_bf16(xin + (size_t)r * DM, PP->norm_mix, HBUF + (size_t)r * DM, (float*)(PP->ws + WS_PART) + (size_t)r * 16, lane);
        if (l == 0) { grid.sync(); if (opaque((int)threadIdx.x) == 0) (void)xb_add(&xbar.bar[XB_XCNT(xbar.x)], 1u); }
        else xcd_barrier(xbar);

        { pg8::Gemm g{HBUF, (const bf16_t*)(PP->ws + WS_WIN), DM, DM, DM, 0, 0}; pg8::SchedMN S{MTOK / 256, NINA / 256, G, c};
          pg8::EpiInProj E{PP->ws, (const f32x2_t*)(PP->ws + WS_ROPE), (const float*)(PP->ws + WS_PART)}; pg8::gemm_phase(lds, g, S, E); }
        if (l == 0) { pg8::Gemm g{(const bf16_t*)(PP->ws + WS_MEMN), (const bf16_t*)(PP->ws + WS_WXKV), DM, DM, DM, (long)NB * MEML * DM, (long)1024 * DM};
          pg8::SchedZ S{DEPTH, NB * MEML / 256, 1024 / 256, G, c}; pg8::EpiMemKV E{(bf16_t*)(PP->ws + WS_MEMKV)}; pg8::gemm_phase(lds, g, S, E); }
        xcd_barrier(xbar);

        { pg8::Gemm g{(const bf16_t*)(PP->ws + WS_A2), (const bf16_t*)(PP->ws + WS_WST), SSM_K2, 512, 512, (long)SSM_M2 * SSM_K2, (long)256 * 512};
          pg8::SchedZ S{32, SSM_M2 / 256, 1, G, c}; pg8::EpiSloc E{(float*)(PP->ws + WS_SLOC)}; pg8::gemm_phase(lds, g, S, E); }
        xcd_barrier(xbar);
        ssm_scan(lds);
        xcd_barrier(xbar);
        { pg8::Gemm g{(const bf16_t*)(PP->ws + WS_A2), (const bf16_t*)(PP->ws + WS_TOEP), SSM_K2, SSM_K2, SSM_K2, (long)SSM_M2 * SSM_K2, (long)512 * SSM_K2};
          pg8::SchedZ S{32, SSM_M2 / 256, 2, G, c}; pg8::EpiGelu E{(bf16_t*)(PP->ws + WS_YACT)}; pg8::gemm_phase(lds, g, S, E); }
        xcd_barrier(xbar);
        { pg8::Gemm g{(const bf16_t*)(PP->ws + WS_YACT), (const bf16_t*)(PP->ws + WS_WGLU), 512, 512, 512, 0, 0}; pg8::SchedMN S{MTOK / 256, 4, G, c};
          pg8::EpiGlu E{(bf16_t*)(PP->ws + WS_YSSM)}; pg8::gemm_phase(lds, g, S, E); }
        for (int r = 0;; ++r) { const int pos = (r & 1) ? G - 1 - c : c; const int idx = r * G + pos; if (idx >= 1024) break;
            const int qb = 15 - idx / 64, bh = idx % 64;
            sb_unit(bh >> 3, bh & 7, qb, (const bf16_t*)(PP->ws + WS_SQ), (bf16_t*)(PP->ws + WS_SQ), (const bf16_t*)(PP->ws + WS_SK), (const bf16_t*)(PP->ws + WS_SV), lds); }
        { const float lam = LAMS[l]; const float post = 1.f - (0.8f - 0.6f * expf(-0.3f * (float)l));
          for (int r = 0;; ++r) { const int pos = (r & 1) ? G - 1 - c : c; const int idx = r * G + pos; if (idx >= 512) break;
            const int qb = 15 - idx / 32, bh = idx % 32, b = bh >> 2, hh = bh & 3; const size_t off = (size_t)b * SEQ * 512 + hh * 128;
            attn2_unit<true>(qb, (const bf16_t*)(PP->ws + WS_DQ) + off, (bf16_t*)(PP->ws + WS_DQ) + off, (const bf16_t*)(PP->ws + WS_DK) + off, (const bf16_t*)(PP->ws + WS_DV) + off, 4 * qb + 4, lam, PP->diff_subln + l * 128, post, lds); } }
        xcd_barrier(xbar);
        { pg8::GmArgs ga{HBUF, (const bf16_t*)(PP->ws + WS_WIN) + (size_t)NINA * DM, (const bf16_t*)(PP->ws + WS_YSSM), (long)(WS_SQ - WS_YSSM) / 2, (const bf16_t*)(PP->ws + WS_WB),
                         (bf16_t*)(PP->ws + WS_GS), (bf16_t*)(PP->ws + WS_H2), (const float*)(PP->ws + WS_PART)};
          pg8::SchedGM S{MTOK / 256, 4, G, c}; pg8::gemm_phase_gm(lds, ga, S); }
        xcd_barrier(xbar);
        { pg8::Gemm g{(const bf16_t*)(PP->ws + WS_H2), (const bf16_t*)(PP->ws + WS_WOUT), DM, DM, DM, 0, 0}; pg8::SchedMN S{MTOK / 256, 4, G, c}; pg8::EpiResid E{xin, PP->out, HBUF, PP->norm_cross + l * DM, (float*)(PP->ws + WS_PART)}; pg8::gemm_phase(lds, g, S, E); }
        xcd_barrier(xbar);
        { pg8::Gemm g{HBUF, (const bf16_t*)(PP->ws + WS_WXQ), DM, DM, DM, 0, 0}; pg8::SchedMN S{MTOK / 256, 2, G, c};
          pg8::EpiBf16<0, true> E{(bf16_t*)(PP->ws + WS_XQ), 512, 0.12751743074602334f, (const float*)(PP->ws + WS_PART)}; pg8::gemm_phase(lds, g, S, E); }
        xcd_barrier(xbar);
        for (int idx = c; idx < 512; idx += G) { const int qb = idx & 15, bh = idx >> 4, b = bh >> 2, hh = bh & 3;
            const bf16_t* kb = (const bf16_t*)(PP->ws + WS_MEMKV) + (size_t)(l * 2) * 2048 * 512 + (size_t)b * MEML * 512 + hh * 128;
            attn2_unit<false>(qb, (const bf16_t*)(PP->ws + WS_XQ) + (size_t)b * SEQ * 512 + hh * 128, (bf16_t*)(PP->ws + WS_XQ) + (size_t)b * SEQ * 512 + hh * 128, kb, kb + (size_t)2048 * 512, 4, 0.f, nullptr, 1.f, lds); }
        xcd_barrier(xbar);
        { pg8::Gemm g{(const bf16_t*)(PP->ws + WS_XQ), (const bf16_t*)(PP->ws + WS_WXO), 512, 512, 512, 0, 0}; pg8::SchedMN S{MTOK / 256, 4, G, c}; pg8::EpiResid E{PP->out, PP->out, HBUF, PP->norm_mlp + l * DM, (float*)(PP->ws + WS_PART)}; pg8::gemm_phase(lds, g, S, E); }
        xcd_barrier(xbar);
        { pg8::Gemm g{HBUF, (const bf16_t*)(PP->ws + WS_WUP), DM, DM, DM, 0, 0}; pg8::SchedMN S{MTOK / 256, 16, G, c};
          pg8::EpiBf16<2, true> E{(bf16_t*)(PP->ws + WS_HID), 4096, 1.f, (const float*)(PP->ws + WS_PART)}; pg8::gemm_phase(lds, g, S, E); }
        xcd_barrier(xbar);
        { pg8::Gemm g{(const bf16_t*)(PP->ws + WS_HID), (const bf16_t*)(PP->ws + WS_WDN), 4096, 4096, 4096, 0, 0}; pg8::SchedMN S{MTOK / 256, 4, G, c}; pg8::EpiResid E{PP->out, PP->out, HBUF, PP->norm_mix + (l + 1 < DEPTH ? l + 1 : l) * DM, (float*)(PP->ws + WS_PART)}; pg8::gemm_phase(lds, g, S, E); }
        xcd_barrier(xbar);
    }
    for (int r = gw; r < MTOK; r += ngw) rms_row_f32(PP->out + (size_t)r * DM, PP->norm_final, lane);
}

extern "C" void kernel_launch(void* const* d_in, const int* in_sizes, int n_in, void* d_out, int out_size, void* d_ws, size_t ws_size, hipStream_t stream) {
    static int grid = 0;
    if (grid == 0) {
        if (n_in != 27 || ws_size < WS_END) { fprintf(stderr, "kernel_launch: unexpected n_in %d / ws %zu\n", n_in, ws_size); grid = -1; return; }
        int dev = 0, cus = 0, per_cu = 0;
        hipGetDevice(&dev); hipDeviceGetAttribute(&cus, hipDeviceAttributeMultiprocessorCount, dev);
        hipFuncSetAttribute((const void*)fwd_megakernel, hipFuncAttributeMaxDynamicSharedMemorySize, LDS_BYTES);
        hipOccupancyMaxActiveBlocksPerMultiprocessor(&per_cu, (const void*)fwd_megakernel, 512, LDS_BYTES);
        if (per_cu < 1) per_cu = 1;
        grid = cus * 1; (void)per_cu;
        (void)hipGetLastError();
    }
    if (grid < 0) return;
    Params p{};
    p.x = (const float*)d_in[0]; p.mem = (const float*)d_in[1]; p.pos = (const int*)d_in[2];
    p.norm_mix = (const float*)d_in[3]; p.w_in = (const float*)d_in[4]; p.lam_re = (const float*)d_in[5]; p.lam_im = (const float*)d_in[6]; p.log_dt = (const float*)d_in[7];
    p.b_re = (const float*)d_in[8]; p.b_im = (const float*)d_in[9]; p.c_re = (const float*)d_in[10]; p.c_im = (const float*)d_in[11]; p.ssm_d = (const float*)d_in[12];
    p.w_glu = (const float*)d_in[13]; p.diff_lambda = (const float*)d_in[14]; p.diff_subln = (const float*)d_in[15]; p.w_branch = (const float*)d_in[16]; p.w_out = (const float*)d_in[17];
    p.norm_cross = (const float*)d_in[18]; p.norm_mem = (const float*)d_in[19]; p.w_xq = (const float*)d_in[20]; p.w_xkv = (const float*)d_in[21]; p.w_xo = (const float*)d_in[22];
    p.norm_mlp = (const float*)d_in[23]; p.w_up = (const float*)d_in[24]; p.w_down = (const float*)d_in[25]; p.norm_final = (const float*)d_in[26];
    p.out = (float*)d_out; p.ws = (unsigned char*)d_ws;
    void* args[] = {&p};
    hipError_t e = hipLaunchCooperativeKernel((const void*)fwd_megakernel, dim3(grid), dim3(512), args, LDS_BYTES, stream);
    if (e != hipSuccess) fprintf(stderr, "cooperative launch failed: %s (grid %d)\n", hipGetErrorString(e), grid);
}
```

```cpp
#include <hip/hip_runtime.h>
#include <hip/hip_cooperative_groups.h>
#include <cstdint>
#include <cstdio>
namespace cg = cooperative_groups;

#define LAS __attribute__((address_space(3)))
#define DI __device__ __forceinline__
typedef unsigned short bf16_t;
typedef short bf16x8 __attribute__((ext_vector_type(8)));
typedef short s16x4 __attribute__((ext_vector_type(4)));
typedef short v4i16_t __attribute__((ext_vector_type(4)));
typedef float f32x4 __attribute__((ext_vector_type(4)));
typedef float f32x16 __attribute__((ext_vector_type(16)));
typedef unsigned u32x4 __attribute__((ext_vector_type(4)));
typedef float f32x2_t __attribute__((ext_vector_type(2)));
typedef __bf16 bf16x2_t __attribute__((ext_vector_type(2)));

constexpr int DM = 1024, NB = 8, SEQ = 4096, MTOK = NB * SEQ, DEPTH = 2, MEML = 256;
constexpr int NIN = 6656, NINA = 3584;
constexpr float RMS_EPS = 1e-6f;
constexpr int SSM_T = 32, SSM_NC = SEQ / SSM_T  , SSM_M2 = NB * SSM_NC  , SSM_K2 = 640;

constexpr size_t MiB = 1u << 20;
constexpr size_t WS_ROPE = 1 * MiB;
constexpr size_t WS_LAMT = 3 * MiB;
constexpr size_t WS_MEMN = 4 * MiB;
constexpr size_t WS_WXKV = 12 * MiB;
constexpr size_t WS_MEMKV = 16 * MiB;
constexpr size_t WS_WIN = 24 * MiB;
constexpr size_t WS_WGLU = 37 * MiB;
constexpr size_t WS_WB = 38 * MiB;
constexpr size_t WS_WOUT = 41 * MiB;
constexpr size_t WS_WXQ = 43 * MiB;
constexpr size_t WS_WXO = 44 * MiB;
constexpr size_t WS_WUP = 45 * MiB;
constexpr size_t WS_WDN = 53 * MiB;
constexpr size_t WS_WST = 61 * MiB;
constexpr size_t WS_TOEP = 69 * MiB;
constexpr size_t WS_H = 90 * MiB;
constexpr size_t WS_YSSM = 154 * MiB;
constexpr size_t WS_SQ = 186 * MiB;
constexpr size_t WS_DQ = 218 * MiB;
constexpr size_t WS_SK = 250 * MiB;
constexpr size_t WS_SV = 282 * MiB;
constexpr size_t WS_DK = 314 * MiB;
constexpr size_t WS_DV = 346 * MiB;
constexpr size_t WS_A2 = 378 * MiB;
constexpr size_t WS_SLOC = 418 * MiB;
constexpr size_t WS_YACT = 434 * MiB;
constexpr size_t WS_GATES = 250 * MiB;
constexpr size_t WS_HID = 154 * MiB;
constexpr size_t WS_XQ = 154 * MiB;
constexpr size_t WS_H2 = 250 * MiB;
constexpr size_t WS_GS = 314 * MiB;
constexpr size_t WS_PART = 466 * MiB;
constexpr size_t WS_END = 468 * MiB;

constexpr int LDS_CTL = 143360;
constexpr int LDS_BYTES = LDS_CTL + 1024;

DI unsigned pk2(float lo, float hi) { f32x2_t v = {lo, hi}; bf16x2_t b = __builtin_convertvector(v, bf16x2_t); return __builtin_bit_cast(unsigned, b); }
DI bf16_t f2bf(float f) { return (bf16_t)(pk2(f, 0.f) & 0xffffu); }
DI float bf2f(unsigned u) { return __uint_as_float(u << 16); }
DI void st8(bf16_t* p, f32x4 a, f32x4 b) { u32x4 w; w.x = pk2(a[0], a[1]); w.y = pk2(a[2], a[3]); w.z = pk2(b[0], b[1]); w.w = pk2(b[2], b[3]); *(u32x4*)p = w; }
DI int opaque(int v) { asm volatile("" : "+v"(v)); return v; }
DI int opaque_s(int v) { asm volatile("" : "+s"(v)); return v; }
DI float sigmoidf_(float x) { return __builtin_amdgcn_rcpf(1.f + __builtin_amdgcn_exp2f(x * -1.4426950408889634f)); }
DI float wave_sum(float v) {
#pragma unroll
    for (int o = 1; o < 64; o <<= 1) v += __shfl_xor(v, o);
    return v;
}
DI void sincos_red(double a, float& s, float& c) {
    const double k = rint(a * 0.15915494309189535);
    const float r = (float)(a - k * 6.283185307179586);
    s = __sinf(r); c = __cosf(r);
}

namespace pg8 {
constexpr int BM = 256, BK = 64, HALF = 128, HTB = HALF * BK * 2, STAGE_BYTES = 8 * HTB, NXCD = 8, WGM = 8;
DI int lds_byte(int r, int c) { const int st = (r >> 4) * 2 + (c >> 5), rr = r & 15, cc = c & 31, ob = rr * 64 + cc * 2; return st * 1024 + (ob ^ (((ob >> 9) & 1) << 5)); }
DI void stage_rc(int b, int& R, int& C) { const int st = b / 1024, sb = b % 1024, swz = sb ^ (((sb >> 9) & 1) << 5); R = (st >> 1) * 16 + swz / 64; C = (st & 1) * 32 + (swz % 64) / 2; }
DI int perm32(int rho) { const int n = rho >> 4, i = rho & 15; return 8 * (i >> 2) + 4 * n + (i & 3); }

struct Unit { int pm, pn, z; };
struct Gemm { const bf16_t* A; const bf16_t* Bt; int lda, ldb, K; long zA, zB; };

DI void tile_decode(int wgid, int nM, int nN, int& pm, int& pn) {
    const int nwg = nM * nN;
    { const int q = nwg / NXCD, r = nwg % NXCD, xcd = wgid % NXCD, off = wgid / NXCD; wgid = (xcd < r ? xcd * (q + 1) : r * (q + 1) + (xcd - r) * q) + off; }
    const int nig = WGM * nN, gid = wgid / nig, fm = gid * WGM, gsz = (nM - fm) < WGM ? (nM - fm) : WGM;
    pm = fm + ((wgid % nig) % gsz); pn = (wgid % nig) / gsz;
}
struct SchedMN {
    int nM, nN, G, c;
    DI bool next(int i, Unit& u) const { const long L = (long)i * G + c; if (L >= (long)nM * nN) return false; tile_decode((int)L, nM, nN, u.pm, u.pn); u.z = 0; return true; }
};
struct SchedZ {
    int nZ, nM, nN, G, c;
    DI bool next(int i, Unit& u) const { const long L = (long)i * G + c; if (L >= (long)nZ * nM * nN) return false; const int l = (int)L; u.z = l / (nM * nN); const int r = l % (nM * nN); u.pm = r / nN; u.pn = r % nN; return true; }
};
struct SchedMerge {
    int nM, nN, G, c;
    DI bool next(int i, Unit& u) const { const long L = (long)(i / 3) * G + c; if (L >= (long)nM * nN) return false; tile_decode((int)L, nM, nN, u.pm, u.pn); u.z = i % 3; return true; }
};

template <class Epi, class Sched>
DI void gemm_phase(LAS unsigned char* lds, const Gemm g, const Sched& S, const Epi& E) {
    const int tid = opaque(threadIdx.x), wid = __builtin_amdgcn_readfirstlane(tid >> 6), lane = tid & 63, wr = wid >> 2, wc = wid & 3, fr = lane & 15, fq = lane >> 4;
    const int nt = g.K / BK;
    unsigned voffA[2], voffB[2];
#pragma unroll
    for (int i = 0; i < 2; ++i) { int R, C; stage_rc(tid * 16 + i * 8192, R, C); const int Rb = (R & ~31) + perm32(R & 31);
        voffA[i] = (unsigned)(R * g.lda + C) * 2u; voffB[i] = (unsigned)(Rb * g.ldb + C) * 2u; }
    const size_t kstep = (size_t)(BK * 2);
    const size_t hstepA = (size_t)HALF * g.lda * 2, hstepB = (size_t)HALF * g.ldb * 2;
    const unsigned ldsw = (unsigned)wid * 1024u;
    const int aoff = lds_byte(wr * 64 + fr, fq * 8), boff = lds_byte(wc * 32 + fr, fq * 8);
#define PG8_SA(b, h) (((b) * 2 + (h)) * HTB)
#define PG8_SB(b, h) ((4 + (b) * 2 + (h)) * HTB)
#define PG8_STAGE(bufoff, gbase, voff) do { _Pragma("unroll") for (int _i = 0; _i < 2; ++_i) \
        __builtin_amdgcn_global_load_lds((const unsigned*)((const char*)(gbase) + (voff)[_i]), (LAS unsigned*)(lds + (bufoff) + ldsw + _i * 8192), 16, 0, 0); } while (0)
#define PG8_LDA(dst, b, h) do { _Pragma("unroll") for (int m = 0; m < 4; ++m) _Pragma("unroll") for (int k = 0; k < 2; ++k) dst[m][k] = *(const LAS bf16x8*)(lds + PG8_SA(b, h) + aoff + m * 2048 + k * 1024); } while (0)
#define PG8_LDB(dst, b, h) do { _Pragma("unroll") for (int n = 0; n < 2; ++n) _Pragma("unroll") for (int k = 0; k < 2; ++k) dst[n][k] = *(const LAS bf16x8*)(lds + PG8_SB(b, h) + boff + n * 2048 + k * 1024); } while (0)
#define PG8_MMA(ai, bj, At, Bt) do { __builtin_amdgcn_s_setprio(1); _Pragma("unroll") for (int m = 0; m < 4; ++m) _Pragma("unroll") for (int n = 0; n < 2; ++n) _Pragma("unroll") for (int k = 0; k < 2; ++k) \
        acc[ai][bj][m][n] = __builtin_amdgcn_mfma_f32_16x16x32_bf16(Bt[n][k], At[m][k], acc[ai][bj][m][n], 0, 0, 0); __builtin_amdgcn_s_setprio(0); } while (0)
#define PG8_WAIT_V(n) asm volatile("s_waitcnt vmcnt(" #n ")" ::: "memory")
#define PG8_WAIT_L(n) asm volatile("s_waitcnt lgkmcnt(" #n ")" ::: "memory")
#define PG8_BAR __builtin_amdgcn_s_barrier()
#define PG8_SCHED __builtin_amdgcn_sched_barrier(0)
    Unit cur, nxt; int ui = 0;
    if (!S.next(0, cur)) return;
#define PG8_RFILL(u_, ui_) do { if (tid < 256) { const f32x4* pp_ = (const f32x4*)(E.part + (size_t)((u_).pm * BM + tid) * 16); \
        const f32x4 a_ = pp_[0], b_ = pp_[1], c_ = pp_[2], d_ = pp_[3]; const f32x4 s_ = (a_ + b_) + (c_ + d_); \
        ((LAS float*)(lds + STAGE_BYTES))[(ui_) * 256 + tid] = rsqrtf(((s_[0] + s_[1]) + (s_[2] + s_[3])) * (1.f / DM) + RMS_EPS); } } while (0)
    if constexpr (Epi::NEEDS_R) {
        Unit uu; for (int i = 0; i < 8 && S.next(i, uu); ++i) PG8_RFILL(uu, i);
    }
    f32x4 acc[2][2][4][2];
#pragma unroll
    for (int a = 0; a < 2; ++a)
#pragma unroll
        for (int b = 0; b < 2; ++b)
#pragma unroll
            for (int m = 0; m < 4; ++m)
#pragma unroll
                for (int n = 0; n < 2; ++n) acc[a][b][m][n] = (f32x4){0.f, 0.f, 0.f, 0.f};
    bf16x8 At[4][2], B0[2][2], B1[2][2];
    const char* cA = (const char*)g.A + (size_t)cur.z * g.zA * 2 + (size_t)cur.pm * 2 * hstepA;
    const char* cB = (const char*)g.Bt + (size_t)cur.z * g.zB * 2 + (size_t)cur.pn * 2 * hstepB;
    PG8_STAGE(PG8_SB(0, 0), cB, voffB); PG8_STAGE(PG8_SB(0, 1), cB + hstepB, voffB); PG8_STAGE(PG8_SA(0, 0), cA, voffA); PG8_STAGE(PG8_SA(0, 1), cA + hstepA, voffA);
    if (wr == 1) PG8_BAR;
    PG8_WAIT_V(2); PG8_BAR;
    PG8_STAGE(PG8_SB(1, 0), cB + kstep, voffB); PG8_STAGE(PG8_SA(1, 0), cA + kstep, voffA); PG8_STAGE(PG8_SB(1, 1), cB + hstepB + kstep, voffB);
    PG8_WAIT_V(6); PG8_BAR;
    for (;;) {
        const bool has_next = S.next(ui + 1, nxt);
        const char* nA = has_next ? (const char*)g.A + (size_t)nxt.z * g.zA * 2 + (size_t)nxt.pm * 2 * hstepA : cA;
        const char* nB = has_next ? (const char*)g.Bt + (size_t)nxt.z * g.zB * 2 + (size_t)nxt.pn * 2 * hstepB : cB;
        for (int t = 0; t < nt; t += 2) {
            const bool last = (t == nt - 2);
            const char* a1 = cA + (size_t)(t + 1) * kstep;
            const char* a2 = last ? nA : cA + (size_t)(t + 2) * kstep; const char* b2 = last ? nB : cB + (size_t)(t + 2) * kstep;
            const char* a3 = a2 + kstep; const char* b3 = b2 + kstep;
            PG8_LDB(B0, 0, 0); PG8_LDB(B1, 0, 1); PG8_SCHED; PG8_LDA(At, 0, 0); PG8_STAGE(PG8_SA(1, 1), a1 + hstepA, voffA);
            PG8_WAIT_V(8); PG8_WAIT_L(0); PG8_BAR; PG8_MMA(0, 0, At, B0); PG8_MMA(0, 1, At, B1); PG8_BAR; PG8_SCHED;
            PG8_LDA(At, 0, 1); PG8_STAGE(PG8_SB(0, 0), b2, voffB); PG8_STAGE(PG8_SB(0, 1), b2 + hstepB, voffB); PG8_STAGE(PG8_SA(0, 0), a2, voffA);
            PG8_WAIT_V(8); PG8_WAIT_L(0); PG8_BAR; PG8_MMA(1, 0, At, B0); PG8_MMA(1, 1, At, B1); PG8_BAR; PG8_SCHED;
            PG8_LDB(B0, 1, 0); PG8_LDB(B1, 1, 1); PG8_SCHED; PG8_LDA(At, 1, 0); PG8_STAGE(PG8_SA(0, 1), a2 + hstepA, voffA);
            PG8_WAIT_V(8); PG8_WAIT_L(0); PG8_BAR; PG8_MMA(0, 0, At, B0); PG8_MMA(0, 1, At, B1); PG8_BAR; PG8_SCHED;
            PG8_LDA(At, 1, 1); PG8_STAGE(PG8_SB(1, 0), b3, voffB); PG8_STAGE(PG8_SB(1, 1), b3 + hstepB, voffB); PG8_STAGE(PG8_SA(1, 0), a3, voffA);
            PG8_WAIT_V(8); PG8_WAIT_L(0); PG8_BAR; PG8_MMA(1, 0, At, B0); PG8_MMA(1, 1, At, B1); PG8_BAR; PG8_SCHED;
        }
        if (wr == 0) PG8_BAR;
        E(acc, cur, wr, wc, fr, fq, (const LAS float*)(lds + STAGE_BYTES) + (ui & 7) * 256);
        if (!has_next) break;
#pragma unroll
        for (int a = 0; a < 2; ++a)
#pragma unroll
            for (int b = 0; b < 2; ++b)
#pragma unroll
                for (int m = 0; m < 4; ++m)
#pragma unroll
                    for (int n = 0; n < 2; ++n) acc[a][b][m][n] = (f32x4){0.f, 0.f, 0.f, 0.f};
        cur = nxt; cA = nA; cB = nB; ++ui;
        if (wr == 1) PG8_BAR;
    }
    PG8_WAIT_V(0);
    PG8_BAR;
#undef PG8_RFILL
#undef PG8_SA
#undef PG8_SB
#undef PG8_STAGE
#undef PG8_LDA
#undef PG8_LDB
#undef PG8_MMA
#undef PG8_WAIT_V
#undef PG8_WAIT_L
#undef PG8_BAR
#undef PG8_SCHED
}

typedef f32x4 AccT[2][2][4][2];

struct EpiInProj {
    static constexpr bool PERM = true, NEEDS_R = true;
    unsigned char* ws; const f32x2_t* rope; const float* part;
    DI void operator()(const AccT& acc, const Unit& u, int wr, int wc, int fr, int fq, const LAS float* rt) const {
        const int colt = u.pn * BM; const int seg = colt >> 9; const int cbase = (colt & 511) + wc * 32 + 8 * fq;
        const size_t off = seg == 1 ? WS_SQ : seg == 2 ? WS_SK : seg == 3 ? WS_SV : seg == 4 ? WS_DQ : seg == 5 ? WS_DK : WS_DV;
        bf16_t* base = (bf16_t*)(ws + off); bf16_t* a2 = (bf16_t*)(ws + WS_A2);
        const bool rot = (seg == 4 || seg == 5) && ((wc & 1) == 0) && (fq < 2);
        const float sc = (seg == 1 || seg == 4) ? 0.18033688011112042f : 1.f;
#pragma unroll
        for (int ai = 0; ai < 2; ++ai) {
            f32x2_t rc[4][4];
            if (rot) {
#pragma unroll
                for (int m = 0; m < 4; ++m) { const f32x2_t* cs = rope + (size_t)(u.pm * BM + ai * HALF + wr * 64 + m * 16 + fr) * 8 + 4 * fq;
#pragma unroll
                    for (int k = 0; k < 4; ++k) rc[m][k] = cs[k]; }
            }
            __builtin_amdgcn_sched_barrier(0);
#pragma unroll
            for (int m = 0; m < 4; ++m) {
                const int row = u.pm * BM + ai * HALF + wr * 64 + m * 16 + fr; const float rr = rt[ai * HALF + wr * 64 + m * 16 + fr] * sc;
#pragma unroll
                for (int bj = 0; bj < 2; ++bj) {
                    const int cs = cbase + bj * HALF; f32x4 v0 = acc[ai][bj][m][0] * rr, v1 = acc[ai][bj][m][1] * rr;
                    if (seg == 0) {
                        const int g = cs >> 4, ci = cs & 15, b = row >> 12, t = row & 4095, c = t >> 5, s = t & 31;
                        st8(a2 + ((size_t)(g * SSM_M2 + b * SSM_NC + c) * SSM_K2 + s * 16 + ci), v0, v1);
                    } else if (rot) {
#pragma unroll
                        for (int k = 0; k < 4; ++k) { const float t1 = v0[k], t2 = v1[k]; v0[k] = t1 * rc[m][k].x - t2 * rc[m][k].y; v1[k] = t2 * rc[m][k].x + t1 * rc[m][k].y; }
                        bf16_t* dp = base + (size_t)row * 512 + (cs - 8 * fq) + 4 * fq;
                        *(unsigned long long*)dp = (unsigned long long)pk2(v0[0], v0[1]) | ((unsigned long long)pk2(v0[2], v0[3]) << 32);
                        *(unsigned long long*)(dp + 8) = (unsigned long long)pk2(v1[0], v1[1]) | ((unsigned long long)pk2(v1[2], v1[3]) << 32);
                    } else {
                        st8(base + (size_t)row * 512 + cs, v0, v1);
                    }
                }
            }
        }
    }
};
struct EpiMemKV {
    static constexpr bool PERM = true, NEEDS_R = false;
    bf16_t* kv;
    DI void operator()(const AccT& acc, const Unit& u, int wr, int wc, int fr, int fq, const LAS float* rt) const {
        const int colt = u.pn * BM; bf16_t* base = kv + (size_t)(u.z * 2 + (colt >> 9)) * 2048 * 512; const int cbase = (colt & 511) + wc * 32 + 8 * fq;
#pragma unroll
        for (int ai = 0; ai < 2; ++ai)
#pragma unroll
            for (int m = 0; m < 4; ++m) { const int row = u.pm * BM + ai * HALF + wr * 64 + m * 16 + fr;
#pragma unroll
                for (int bj = 0; bj < 2; ++bj) st8(base + (size_t)row * 512 + cbase + bj * HALF, acc[ai][bj][m][0], acc[ai][bj][m][1]); }
    }
};
template <int ACT, bool RS> struct EpiBf16 {
    static constexpr bool PERM = true, NEEDS_R = RS;
    bf16_t* O; int ldc; float scale; const float* part;
    DI void operator()(const AccT& acc, const Unit& u, int wr, int wc, int fr, int fq, const LAS float* rt) const {
        const int col0 = u.pn * BM + wc * 32 + 8 * fq;
#pragma unroll
        for (int ai = 0; ai < 2; ++ai)
#pragma unroll
            for (int m = 0; m < 4; ++m) { const int row = u.pm * BM + ai * HALF + wr * 64 + m * 16 + fr; const float rr = RS ? rt[ai * HALF + wr * 64 + m * 16 + fr] * scale : scale;
#pragma unroll
                for (int bj = 0; bj < 2; ++bj) { f32x4 v0 = acc[ai][bj][m][0] * rr, v1 = acc[ai][bj][m][1] * rr;
                    if (ACT == 1) {
#pragma unroll
                        for (int k = 0; k < 4; ++k) { v0[k] = sigmoidf_(v0[k]); v1[k] = sigmoidf_(v1[k]); } }
                    if (ACT == 2) {
#pragma unroll
                        for (int k = 0; k < 4; ++k) { const float a = fmaxf(v0[k], 0.f), b = fmaxf(v1[k], 0.f); v0[k] = a * a; v1[k] = b * b; } }
                    st8(O + (size_t)row * ldc + col0 + bj * HALF, v0, v1); } }
    }
};
struct EpiGlu {
    static constexpr bool PERM = true, NEEDS_R = false;
    bf16_t* O;
    DI void operator()(const AccT& acc, const Unit& u, int wr, int wc, int fr, int fq, const LAS float* rt) const {
        const int col0 = u.pn * HALF + wc * 32 + 8 * fq;
#pragma unroll
        for (int ai = 0; ai < 2; ++ai)
#pragma unroll
            for (int m = 0; m < 4; ++m) { const int row = u.pm * BM + ai * HALF + wr * 64 + m * 16 + fr;
                f32x4 v0, v1;
#pragma unroll
                for (int k = 0; k < 4; ++k) { v0[k] = acc[ai][0][m][0][k] * sigmoidf_(acc[ai][1][m][0][k]); v1[k] = acc[ai][0][m][1][k] * sigmoidf_(acc[ai][1][m][1][k]); }
                st8(O + (size_t)row * 512 + col0, v0, v1); }
    }
};
struct EpiSloc {
    static constexpr bool PERM = true, NEEDS_R = false;
    float* S;
    DI void operator()(const AccT& acc, const Unit& u, int wr, int wc, int fr, int fq, const LAS float* rt) const {
        const int col0 = wc * 32 + 8 * fq;
#pragma unroll
        for (int ai = 0; ai < 2; ++ai)
#pragma unroll
            for (int m = 0; m < 4; ++m) { const int row = u.pm * BM + ai * HALF + wr * 64 + m * 16 + fr;
                float* p = S + ((size_t)(u.z * SSM_M2 + row) * 128 + col0);
                *(f32x4*)p = acc[ai][0][m][0]; *(f32x4*)(p + 4) = acc[ai][0][m][1]; }
    }
};
struct EpiGelu {
    static constexpr bool PERM = true, NEEDS_R = false;
    bf16_t* Y;
    DI void operator()(const AccT& acc, const Unit& u, int wr, int wc, int fr, int fq, const LAS float* rt) const {
        const int col0 = u.pn * BM + wc * 32 + 8 * fq;
#pragma unroll
        for (int ai = 0; ai < 2; ++ai)
#pragma unroll
            for (int m = 0; m < 4; ++m) { const int row = u.pm * BM + ai * HALF + wr * 64 + m * 16 + fr; const int b = row >> 7, c = row & 127;
#pragma unroll
                for (int bj = 0; bj < 2; ++bj) { const int n = col0 + bj * HALF, t = n >> 4, co = n & 15;
                    f32x4 v0 = acc[ai][bj][m][0], v1 = acc[ai][bj][m][1];
#pragma unroll
                    for (int k = 0; k < 4; ++k) { float x = v0[k]; v0[k] = x * __builtin_amdgcn_rcpf(1.f + __builtin_amdgcn_exp2f(x * (-2.3022082f - 0.10294324f * (x * x))));
                        x = v1[k]; v1[k] = x * __builtin_amdgcn_rcpf(1.f + __builtin_amdgcn_exp2f(x * (-2.3022082f - 0.10294324f * (x * x)))); }
                    st8(Y + ((size_t)(b * SEQ + c * SSM_T + t) * 512 + u.z * 16 + co), v0, v1); } }
    }
};
struct EpiMerge {
    static constexpr bool PERM = true, NEEDS_R = false;
    const bf16_t* gates; bf16_t* O;
    DI void operator()(const AccT& acc, const Unit& u, int wr, int wc, int fr, int fq, const LAS float* rt) const {
        const int col0 = u.pn * BM + wc * 32 + 8 * fq;
#pragma unroll
        for (int ai = 0; ai < 2; ++ai) {
            u32x4 gw[4][2], pw[4][2];
#pragma unroll
            for (int m = 0; m < 4; ++m) { const int row = u.pm * BM + ai * HALF + wr * 64 + m * 16 + fr;
#pragma unroll
                for (int bj = 0; bj < 2; ++bj) { const int col = col0 + bj * HALF;
                    gw[m][bj] = *(const u32x4*)(gates + (size_t)row * 3072 + u.z * 1024 + col);
                    if (u.z > 0) pw[m][bj] = *(const u32x4*)(O + (size_t)row * 1024 + col); else pw[m][bj] = (u32x4){0u, 0u, 0u, 0u}; } }
            __builtin_amdgcn_sched_barrier(0);
#pragma unroll
            for (int m = 0; m < 4; ++m) { const int row = u.pm * BM + ai * HALF + wr * 64 + m * 16 + fr;
#pragma unroll
                for (int bj = 0; bj < 2; ++bj) { const int col = col0 + bj * HALF; const u32x4 g4 = gw[m][bj], p4 = pw[m][bj];
                    f32x4 v0 = acc[ai][bj][m][0], v1 = acc[ai][bj][m][1];
                    v0[0] = v0[0] * bf2f(g4.x & 0xffffu) + bf2f(p4.x & 0xffffu); v0[1] = v0[1] * bf2f(g4.x >> 16) + bf2f(p4.x >> 16);
                    v0[2] = v0[2] * bf2f(g4.y & 0xffffu) + bf2f(p4.y & 0xffffu); v0[3] = v0[3] * bf2f(g4.y >> 16) + bf2f(p4.y >> 16);
                    v1[0] = v1[0] * bf2f(g4.z & 0xffffu) + bf2f(p4.z & 0xffffu); v1[1] = v1[1] * bf2f(g4.z >> 16) + bf2f(p4.z >> 16);
                    v1[2] = v1[2] * bf2f(g4.w & 0xffffu) + bf2f(p4.w & 0xffffu); v1[3] = v1[3] * bf2f(g4.w >> 16) + bf2f(p4.w >> 16);
                    st8(O + (size_t)row * 1024 + col, v0, v1); } }
        }
    }
};
struct EpiResid {
    static constexpr bool PERM = true, NEEDS_R = false;
    const float* base; float* out; bf16_t* hb; const float* gain; float* part;
    DI void operator()(const AccT& acc, const Unit& u, int wr, int wc, int fr, int fq, const LAS float* rt) const {
        const int col0 = u.pn * BM + wc * 32 + 8 * fq;
        f32x4 gv[2][2];
#pragma unroll
        for (int bj = 0; bj < 2; ++bj) { gv[bj][0] = *(const f32x4*)(gain + col0 + bj * HALF); gv[bj][1] = *(const f32x4*)(gain + col0 + bj * HALF + 4); }
#pragma unroll
        for (int ai = 0; ai < 2; ++ai)
#pragma unroll
            for (int mh = 0; mh < 2; ++mh) {
                f32x4 bx[2][2][2];
#pragma unroll
                for (int mm = 0; mm < 2; ++mm) { const int row = u.pm * BM + ai * HALF + wr * 64 + (mh * 2 + mm) * 16 + fr;
#pragma unroll
                    for (int bj = 0; bj < 2; ++bj) { const size_t o = (size_t)row * DM + col0 + bj * HALF; bx[mm][bj][0] = *(const f32x4*)(base + o); bx[mm][bj][1] = *(const f32x4*)(base + o + 4); } }
                __builtin_amdgcn_sched_barrier(0);
#pragma unroll
                for (int mm = 0; mm < 2; ++mm) { const int m = mh * 2 + mm; const int row = u.pm * BM + ai * HALF + wr * 64 + m * 16 + fr; float ss = 0.f;
#pragma unroll
                    for (int bj = 0; bj < 2; ++bj) { const size_t o = (size_t)row * DM + col0 + bj * HALF;
                        const f32x4 x0 = bx[mm][bj][0] + acc[ai][bj][m][0], x1 = bx[mm][bj][1] + acc[ai][bj][m][1];
                        *(f32x4*)(out + o) = x0; *(f32x4*)(out + o + 4) = x1;
                        ss += (x0[0] * x0[0] + x0[1] * x0[1]) + (x0[2] * x0[2] + x0[3] * x0[3]) + (x1[0] * x1[0] + x1[1] * x1[1]) + (x1[2] * x1[2] + x1[3] * x1[3]);
                        st8(hb + o, x0 * gv[bj][0], x1 * gv[bj][1]); }
                    ss += __shfl_xor(ss, 16); ss += __shfl_xor(ss, 32);
                    if (fq == 0) part[(size_t)row * 16 + u.pn * 4 + wc] = ss; }
            }
    }
};

struct GmArgs { const bf16_t* Ah; const bf16_t* Wg; const bf16_t* Y; long zY; const bf16_t* Wb; bf16_t* gs; bf16_t* O; const float* part; };
DI void gm_unit_info(const GmArgs& a, const Unit& u, const char*& cA, const char*& cB, int& ld, int& nt) {
    const int z = u.z >> 1;
    if (u.z & 1) { ld = 512; nt = 8; cA = (const char*)(a.Y + (size_t)z * a.zY) + (size_t)u.pm * 256 * 512 * 2; cB = (const char*)a.Wb + ((size_t)z * 1024 + u.pn * 256) * 512 * 2; }
    else { ld = 1024; nt = 16; cA = (const char*)a.Ah + (size_t)u.pm * 256 * 1024 * 2; cB = (const char*)a.Wg + ((size_t)z * 1024 + u.pn * 256) * 1024 * 2; }
}
DI void gm_epilogue(const GmArgs& a, const AccT& acc, const Unit& u, int wr, int wc, int fr, int fq, const LAS float* rt) {
    const int z = u.z >> 1; const int colL = wc * 32 + 8 * fq;
    bf16_t* gsb = a.gs + (size_t)blockIdx.x * 65536;
    if (!(u.z & 1)) {
#pragma unroll
        for (int ai = 0; ai < 2; ++ai)
#pragma unroll
            for (int m = 0; m < 4; ++m) { const int rl = ai * HALF + wr * 64 + m * 16 + fr; const float rrn = rt[rl] * -1.4426950408889634f;
#pragma unroll
                for (int bj = 0; bj < 2; ++bj) { f32x4 v0 = acc[ai][bj][m][0] * rrn, v1 = acc[ai][bj][m][1] * rrn;
#pragma unroll
                    for (int k = 0; k < 4; ++k) { v0[k] = __builtin_amdgcn_rcpf(1.f + __builtin_amdgcn_exp2f(v0[k])); v1[k] = __builtin_amdgcn_rcpf(1.f + __builtin_amdgcn_exp2f(v1[k])); }
                    st8(gsb + rl * 256 + colL + bj * HALF, v0, v1); } }
    } else {
#pragma unroll
        for (int ai = 0; ai < 2; ++ai) {
            u32x4 gw[4][2], pw[4][2];
#pragma unroll
            for (int m = 0; m < 4; ++m) { const int rl = ai * HALF + wr * 64 + m * 16 + fr; const int row = u.pm * BM + rl;
#pragma unroll
                for (int bj = 0; bj < 2; ++bj) { const int col = u.pn * BM + colL + bj * HALF;
                    gw[m][bj] = *(const u32x4*)(gsb + rl * 256 + colL + bj * HALF);
                    if (z > 0) pw[m][bj] = *(const u32x4*)(a.O + (size_t)row * 1024 + col); else pw[m][bj] = (u32x4){0u, 0u, 0u, 0u}; } }
            __builtin_amdgcn_sched_barrier(0);
#pragma unroll
            for (int m = 0; m < 4; ++m) { const int rl = ai * HALF + wr * 64 + m * 16 + fr; const int row = u.pm * BM + rl;
#pragma unroll
                for (int bj = 0; bj < 2; ++bj) { const int col = u.pn * BM + colL + bj * HALF; const u32x4 g4 = gw[m][bj], p4 = pw[m][bj];
                    f32x4 v0 = acc[ai][bj][m][0], v1 = acc[ai][bj][m][1];
                    v0[0] = v0[0] * bf2f(g4.x & 0xffffu) + bf2f(p4.x & 0xffffu); v0[1] = v0[1] * bf2f(g4.x >> 16) + bf2f(p4.x >> 16);
                    v0[2] = v0[2] * bf2f(g4.y & 0xffffu) + bf2f(p4.y & 0xffffu); v0[3] = v0[3] * bf2f(g4.y >> 16) + bf2f(p4.y >> 16);
                    v1[0] = v1[0] * bf2f(g4.z & 0xffffu) + bf2f(p4.z & 0xffffu); v1[1] = v1[1] * bf2f(g4.z >> 16) + bf2f(p4.z >> 16);
                    v1[2] = v1[2] * bf2f(g4.w & 0xffffu) + bf2f(p4.w & 0xffffu); v1[3] = v1[3] * bf2f(g4.w >> 16) + bf2f(p4.w >> 16);
                    st8(a.O + (size_t)row * 1024 + col, v0, v1); } }
        }
    }
}
struct SchedGM {
    int nM, nN, G, c;
    DI bool next(int i, Unit& u) const { const long L = (long)(i / 6) * G + c; if (L >= (long)nM * nN) return false; tile_decode((int)L, nM, nN, u.pm, u.pn); u.z = i % 6; return true; }
};
DI void gemm_phase_gm(LAS unsigned char* lds, const GmArgs ga, const SchedGM& S) {
    const int tid = opaque(threadIdx.x), wid = __builtin_amdgcn_readfirstlane(tid >> 6), lane = tid & 63, wr = wid >> 2, wc = wid & 3, fr = lane & 15, fq = lane >> 4;
    unsigned RA2, RB2, C2;
    { int R, C; stage_rc(tid * 16, R, C); const int Rb = (R & ~31) + perm32(R & 31); RA2 = (unsigned)R * 2u; RB2 = (unsigned)Rb * 2u; C2 = (unsigned)C * 2u; }
    const size_t kstep = (size_t)(BK * 2);
    const unsigned ldsw = (unsigned)wid * 1024u;
    const int aoff = lds_byte(wr * 64 + fr, fq * 8), boff = lds_byte(wc * 32 + fr, fq * 8);
#define PG8_SA(b, h) (((b) * 2 + (h)) * HTB)
#define PG8_SB(b, h) ((4 + (b) * 2 + (h)) * HTB)
#define GM_STAGE(bufoff, gbase, R2, ld_) do { _Pragma("unroll") for (int _i = 0; _i < 2; ++_i) \
        __builtin_amdgcn_global_load_lds((const unsigned*)((const char*)(gbase) + (size_t)_i * 128 * (size_t)(ld_) + ((R2) * (unsigned)(ld_) + C2)), (LAS unsigned*)(lds + (bufoff) + ldsw + _i * 8192), 16, 0, 0); } while (0)
#define PG8_LDA(dst, b, h) do { _Pragma("unroll") for (int m = 0; m < 4; ++m) _Pragma("unroll") for (int k = 0; k < 2; ++k) dst[m][k] = *(const LAS bf16x8*)(lds + PG8_SA(b, h) + aoff + m * 2048 + k * 1024); } while (0)
#define PG8_LDB(dst, b, h) do { _Pragma("unroll") for (int n = 0; n < 2; ++n) _Pragma("unroll") for (int k = 0; k < 2; ++k) dst[n][k] = *(const LAS bf16x8*)(lds + PG8_SB(b, h) + boff + n * 2048 + k * 1024); } while (0)
#define PG8_MMA(ai, bj, At, Bt) do { __builtin_amdgcn_s_setprio(1); _Pragma("unroll") for (int m = 0; m < 4; ++m) _Pragma("unroll") for (int n = 0; n < 2; ++n) _Pragma("unroll") for (int k = 0; k < 2; ++k) \
        acc[ai][bj][m][n] = __builtin_amdgcn_mfma_f32_16x16x32_bf16(Bt[n][k], At[m][k], acc[ai][bj][m][n], 0, 0, 0); __builtin_amdgcn_s_setprio(0); } while (0)
#define PG8_WAIT_V(n) asm volatile("s_waitcnt vmcnt(" #n ")" ::: "memory")
#define PG8_WAIT_L(n) asm volatile("s_waitcnt lgkmcnt(" #n ")" ::: "memory")
#define PG8_BAR __builtin_amdgcn_s_barrier()
#define PG8_SCHED __builtin_amdgcn_sched_barrier(0)
#define GM_RFILL(u_, ui_) do { if (tid < 256) { const f32x4* pp_ = (const f32x4*)(ga.part + (size_t)((u_).pm * BM + tid) * 16); \
        const f32x4 a_ = pp_[0], b_ = pp_[1], c_ = pp_[2], d_ = pp_[3]; const f32x4 s_ = (a_ + b_) + (c_ + d_); \
        ((LAS float*)(lds + STAGE_BYTES))[(ui_) * 256 + tid] = rsqrtf(((s_[0] + s_[1]) + (s_[2] + s_[3])) * (1.f / DM) + RMS_EPS); } } while (0)
    Unit cur, nxt; int ui = 0;
    if (!S.next(0, cur)) return;
    { Unit uu; for (int i = 0; i < 8 && S.next(6 * i, uu); ++i) GM_RFILL(uu, i); }
    f32x4 acc[2][2][4][2];
#pragma unroll
    for (int a = 0; a < 2; ++a)
#pragma unroll
        for (int b = 0; b < 2; ++b)
#pragma unroll
            for (int m = 0; m < 4; ++m)
#pragma unroll
                for (int n = 0; n < 2; ++n) acc[a][b][m][n] = (f32x4){0.f, 0.f, 0.f, 0.f};
    bf16x8 At[4][2], B0[2][2], B1[2][2];
    const char* cA; const char* cB; int ldc_, nt;
    gm_unit_info(ga, cur, cA, cB, ldc_, nt);
    size_t hsc = (size_t)HALF * ldc_ * 2;
    GM_STAGE(PG8_SB(0, 0), cB, RB2, ldc_); GM_STAGE(PG8_SB(0, 1), cB + hsc, RB2, ldc_); GM_STAGE(PG8_SA(0, 0), cA, RA2, ldc_); GM_STAGE(PG8_SA(0, 1), cA + hsc, RA2, ldc_);
    if (wr == 1) PG8_BAR;
    PG8_WAIT_V(2); PG8_BAR;
    GM_STAGE(PG8_SB(1, 0), cB + kstep, RB2, ldc_); GM_STAGE(PG8_SA(1, 0), cA + kstep, RA2, ldc_); GM_STAGE(PG8_SB(1, 1), cB + hsc + kstep, RB2, ldc_);
    PG8_WAIT_V(6); PG8_BAR;
    for (;;) {
        const bool has_next = S.next(ui + 1, nxt);
        const char* nA = cA; const char* nB = cB; int ldn = ldc_, ntn = nt;
        if (has_next) gm_unit_info(ga, nxt, nA, nB, ldn, ntn);
        const size_t hsn = (size_t)HALF * ldn * 2;
        for (int t = 0; t < nt; t += 2) {
            const bool last = (t == nt - 2);
            const char* a1 = cA + (size_t)(t + 1) * kstep;
            const char* a2 = last ? nA : cA + (size_t)(t + 2) * kstep; const char* b2 = last ? nB : cB + (size_t)(t + 2) * kstep;
            const char* a3 = a2 + kstep; const char* b3 = b2 + kstep;
            const int ld2 = last ? ldn : ldc_; const size_t hs2 = last ? hsn : hsc;
            PG8_LDB(B0, 0, 0); PG8_LDB(B1, 0, 1); PG8_SCHED; PG8_LDA(At, 0, 0); GM_STAGE(PG8_SA(1, 1), a1 + hsc, RA2, ldc_);
            PG8_WAIT_V(8); PG8_WAIT_L(0); PG8_BAR; PG8_MMA(0, 0, At, B0); PG8_MMA(0, 1, At, B1); PG8_BAR; PG8_SCHED;
            PG8_LDA(At, 0, 1); GM_STAGE(PG8_SB(0, 0), b2, RB2, ld2); GM_STAGE(PG8_SB(0, 1), b2 + hs2, RB2, ld2); GM_STAGE(PG8_SA(0, 0), a2, RA2, ld2);
            PG8_WAIT_V(8); PG8_WAIT_L(0); PG8_BAR; PG8_MMA(1, 0, At, B0); PG8_MMA(1, 1, At, B1); PG8_BAR; PG8_SCHED;
            PG8_LDB(B0, 1, 0); PG8_LDB(B1, 1, 1); PG8_SCHED; PG8_LDA(At, 1, 0); GM_STAGE(PG8_SA(0, 1), a2 + hs2, RA2, ld2);
            PG8_WAIT_V(8); PG8_WAIT_L(0); PG8_BAR; PG8_MMA(0, 0, At, B0); PG8_MMA(0, 1, At, B1); PG8_BAR; PG8_SCHED;
            PG8_LDA(At, 1, 1); GM_STAGE(PG8_SB(1, 0), b3, RB2, ld2); GM_STAGE(PG8_SB(1, 1), b3 + hs2, RB2, ld2); GM_STAGE(PG8_SA(1, 0), a3, RA2, ld2);
            PG8_WAIT_V(8); PG8_WAIT_L(0); PG8_BAR; PG8_MMA(1, 0, At, B0); PG8_MMA(1, 1, At, B1); PG8_BAR; PG8_SCHED;
        }
        if (wr == 0) PG8_BAR;
        gm_epilogue(ga, acc, cur, wr, wc, fr, fq, (const LAS float*)(lds + STAGE_BYTES) + ((ui / 6) & 7) * 256);
        if (!has_next) break;
#pragma unroll
        for (int a = 0; a < 2; ++a)
#pragma unroll
            for (int b = 0; b < 2; ++b)
#pragma unroll
                for (int m = 0; m < 4; ++m)
#pragma unroll
                    for (int n = 0; n < 2; ++n) acc[a][b][m][n] = (f32x4){0.f, 0.f, 0.f, 0.f};
        cur = nxt; cA = nA; cB = nB; ldc_ = ldn; nt = ntn; hsc = hsn; ++ui;
        if (wr == 1) PG8_BAR;
    }
    PG8_WAIT_V(0);
    PG8_BAR;
#undef GM_RFILL
#undef GM_STAGE
#undef PG8_SA
#undef PG8_SB
#undef PG8_LDA
#undef PG8_LDB
#undef PG8_MMA
#undef PG8_WAIT_V
#undef PG8_WAIT_L
#undef PG8_BAR
#undef PG8_SCHED
}
}

DI f32x16 mfma32(bf16x8 a, bf16x8 b, f32x16 c) { return __builtin_amdgcn_mfma_f32_32x32x16_bf16(a, b, c, 0, 0, 0); }
DI s16x4 vtr(const LAS unsigned char* p) { return __builtin_bit_cast(s16x4, __builtin_amdgcn_ds_read_tr16_b64_v4i16((LAS v4i16_t*)p)); }
DI int crow(int r, int hi) { return (r & 3) + 8 * (r >> 2) + 4 * hi; }
DI bf16x8 pack8(const float* w) { u32x4 p; p.x = pk2(w[0], w[1]); p.y = pk2(w[2], w[3]); p.z = pk2(w[4], w[5]); p.w = pk2(w[6], w[7]); return __builtin_bit_cast(bf16x8, p); }

template <bool MASK>
DI void sb_block(const f32x16& p, int kvbase, int qrow, int hi, float& carry, bf16x8& f0, bf16x8& f1) {
    float bt[16], om[16];
#pragma unroll
    for (int i = 0; i < 16; ++i) { const float e = __builtin_amdgcn_exp2f(-p[i]); float b = __builtin_amdgcn_rcpf(1.f + e); float o = 1.f - b;
        if (MASK) { const bool valid = (kvbase + crow(i, hi) < qrow); b = valid ? b : 0.f; o = valid ? o : 1.f; }
        bt[i] = b; om[i] = o; }
    float plo[4], phi[4];
#pragma unroll
    for (int g = 0; g < 4; ++g) { const float gp = (om[4 * g] * om[4 * g + 1]) * (om[4 * g + 2] * om[4 * g + 3]);
        auto rr = __builtin_amdgcn_permlane32_swap(__float_as_uint(gp), __float_as_uint(gp), false, false);
        plo[g] = __uint_as_float(rr[0]); phi[g] = __uint_as_float(rr[1]); }
    float T[4]; T[3] = 1.f; T[2] = plo[3] * phi[3]; T[1] = T[2] * (plo[2] * phi[2]); T[0] = T[1] * (plo[1] * phi[1]);
    const float tot = T[0] * (plo[0] * phi[0]);
    float w[16];
#pragma unroll
    for (int g = 0; g < 4; ++g) { const float w3 = carry * T[g] * (hi ? 1.f : phi[g]);
        const float w2 = w3 * om[4 * g + 3], w1 = w2 * om[4 * g + 2], w0 = w1 * om[4 * g + 1];
        w[4 * g + 3] = bt[4 * g + 3] * w3; w[4 * g + 2] = bt[4 * g + 2] * w2; w[4 * g + 1] = bt[4 * g + 1] * w1; w[4 * g] = bt[4 * g] * w0; }
    carry *= tot;
    f0 = pack8(w); f1 = pack8(w + 8);
}

constexpr int SB_KP = 144, SB_VP = 192, SB_FLAGS = 2 * 64 * SB_KP + 2 * 64 * SB_VP;
DI void sb_unit(int b, int h, int qb, const bf16_t* QO, bf16_t* Ob, const bf16_t* K, const bf16_t* V, LAS unsigned char* lds) {
    const int tid = opaque(threadIdx.x), lane = tid & 63, wid = __builtin_amdgcn_readfirstlane(tid >> 6), r32 = lane & 31, hi = lane >> 5;
    const size_t rowbase = (size_t)b * SEQ;
    const int q0w = qb * 256 + wid * 32, qrow = q0w + r32;
    const bf16_t* qp = QO + (rowbase + qrow) * 512 + h * 64;
    bf16x8 qf[4];
#pragma unroll
    for (int ks = 0; ks < 4; ++ks) qf[ks] = *(const bf16x8*)(qp + ks * 16 + hi * 8);
    const int nt = 4 * qb + 4;
    const int lrow = tid >> 3, lch = tid & 7;
    const bf16_t* kg = K + (rowbase + lrow) * 512 + h * 64 + lch * 8;
    const bf16_t* vg = V + (rowbase + lrow) * 512 + h * 64 + lch * 8;
    LAS unsigned char* Kb = lds; LAS unsigned char* Vb = lds + 2 * 64 * SB_KP;
    LAS unsigned char* flags = lds + SB_FLAGS;
    const int kst = lrow * SB_KP + lch * 16, vst = lrow * SB_VP + lch * 16;
    u32x4 kr = *(const u32x4*)(kg + (size_t)(nt - 1) * 64 * 512), vr = *(const u32x4*)(vg + (size_t)(nt - 1) * 64 * 512);
    *(LAS u32x4*)(Kb + kst) = kr; *(LAS u32x4*)(Vb + vst) = vr;
    __syncthreads();
    f32x16 o0, o1;
#pragma unroll
    for (int i = 0; i < 16; ++i) { o0[i] = 0.f; o1[i] = 0.f; }
    float carry = 1.f; int cur = 0;
    const int vlane = (4 * hi + ((lane & 15) >> 2)) * SB_VP + (16 * ((lane >> 4) & 1) + 4 * (lane & 3)) * 2;
    for (int t = nt - 1; t >= 0; --t) {
        if (t > 0) { kr = *(const u32x4*)(kg + (size_t)(t - 1) * 64 * 512); vr = *(const u32x4*)(vg + (size_t)(t - 1) * 64 * 512); }
        const LAS unsigned char* Kc = Kb + cur * 64 * SB_KP; const LAS unsigned char* Vc = Vb + cur * 64 * SB_VP;
        const bool wdone = !__any(carry >= 1e-30f);
        if (64 * t < q0w + 31 && !wdone) {
            f32x16 p0, p1;
#pragma unroll
            for (int i = 0; i < 16; ++i) { p0[i] = 0.f; p1[i] = 0.f; }
            { bf16x8 a0[4], a1[4];
#pragma unroll
              for (int ks = 0; ks < 4; ++ks) { a0[ks] = *(const LAS bf16x8*)(Kc + r32 * SB_KP + (ks * 16 + hi * 8) * 2); a1[ks] = *(const LAS bf16x8*)(Kc + (32 + r32) * SB_KP + (ks * 16 + hi * 8) * 2); }
              __builtin_amdgcn_sched_barrier(0);
#pragma unroll
              for (int ks = 0; ks < 4; ++ks) { p0 = mfma32(a0[ks], qf[ks], p0); p1 = mfma32(a1[ks], qf[ks], p1); } }
            s16x4 vlo[8], vhh[8];
#pragma unroll
            for (int kk = 0; kk < 4; ++kk) { const LAS unsigned char* vp = Vc + vlane + 16 * kk * SB_VP;
                vlo[2 * kk] = vtr(vp); vhh[2 * kk] = vtr(vp + 8 * SB_VP); vlo[2 * kk + 1] = vtr(vp + 64); vhh[2 * kk + 1] = vtr(vp + 64 + 8 * SB_VP); }
            __builtin_amdgcn_sched_barrier(0);
            bf16x8 fr[4];
            if (64 * t + 63 >= q0w) { sb_block<true>(p1, 64 * t + 32, qrow, hi, carry, fr[2], fr[3]); sb_block<true>(p0, 64 * t, qrow, hi, carry, fr[0], fr[1]); }
            else { sb_block<false>(p1, 64 * t + 32, qrow, hi, carry, fr[2], fr[3]); sb_block<false>(p0, 64 * t, qrow, hi, carry, fr[0], fr[1]); }
            __builtin_amdgcn_sched_barrier(0);
#pragma unroll
            for (int kk = 0; kk < 4; ++kk) {
                { const bf16x8 vb = __builtin_shufflevector(vlo[2 * kk], vhh[2 * kk], 0, 1, 2, 3, 4, 5, 6, 7); o0 = mfma32(fr[kk], vb, o0); }
                { const bf16x8 vb = __builtin_shufflevector(vlo[2 * kk + 1], vhh[2 * kk + 1], 0, 1, 2, 3, 4, 5, 6, 7); o1 = mfma32(fr[kk], vb, o1); }
            }
        }
        if (lane == 0) flags[(t & 1) * 8 + wid] = __any(carry >= 1e-30f) ? 0 : 1;
        if (t > 0) { *(LAS u32x4*)(Kb + (cur ^ 1) * 64 * SB_KP + kst) = kr; *(LAS u32x4*)(Vb + (cur ^ 1) * 64 * SB_VP + vst) = vr; }
        __syncthreads(); cur ^= 1;
        const unsigned long long fl = *(const LAS unsigned long long*)(flags + (t & 1) * 8);
        if (fl == 0x0101010101010101ull) break;
    }
    bf16_t* ob = Ob + (rowbase + q0w) * 512 + h * 64 + r32;
#pragma unroll
    for (int i = 0; i < 16; ++i) { const int r = crow(i, hi); ob[(size_t)r * 512] = f2bf(o0[i]); ob[(size_t)r * 512 + 32] = f2bf(o1[i]); }
}

constexpr int A2_KP = 272, A2_VP = 320, A2_WS = 2 * 64 * A2_KP + 2 * 64 * A2_VP;
DI void bcast_rows(LAS float* wsf, float v, int r32, int hi, float (&out)[16]) {
    if (hi == 0) wsf[r32] = v;
    asm volatile("s_waitcnt lgkmcnt(0)" ::: "memory");
#pragma unroll
    for (int i = 0; i < 16; ++i) out[i] = wsf[crow(i, hi)];
    asm volatile("s_waitcnt lgkmcnt(0)" ::: "memory");
}
DI float half_swap_max(float m) { auto rr = __builtin_amdgcn_permlane32_swap(__float_as_uint(m), __float_as_uint(m), false, false); return fmaxf(__uint_as_float(rr[0]), __uint_as_float(rr[1])); }
DI float half_swap_sum(float m) { auto rr = __builtin_amdgcn_permlane32_swap(__float_as_uint(m), __float_as_uint(m), false, false); return __uint_as_float(rr[0]) + __uint_as_float(rr[1]); }

template <bool DIFF>
DI void attn2_unit(int qb, const bf16_t* QO  , bf16_t* Ob, const bf16_t* K, const bf16_t* V  ,
                   int ntile, float lam, const float* gain, float post, LAS unsigned char* lds) {
    const int tid = opaque(threadIdx.x), lane = tid & 63, wid = __builtin_amdgcn_readfirstlane(tid >> 6), r32 = lane & 31, hi = lane >> 5;
    const int q0w = qb * 256 + wid * 32, qrow = q0w + r32;
    const bf16_t* qp = QO + (size_t)qrow * 512;
    LAS unsigned char* qst = lds + A2_WS + 2048 + wid * 8192 + lane * 16;
#pragma unroll
    for (int ks = 0; ks < 8; ++ks) *(LAS bf16x8*)(qst + ks * 1024) = *(const bf16x8*)(qp + ks * 16 + hi * 8);
    const int lrow = tid >> 3, lch = tid & 7;
    const bf16_t* kg = K + (size_t)lrow * 512 + lch * 16;
    const bf16_t* vg = V + (size_t)lrow * 512 + lch * 16;
    LAS unsigned char* Kb = lds; LAS unsigned char* Vb = lds + 2 * 64 * A2_KP;
    LAS float* wsf = (LAS float*)(lds + A2_WS) + wid * 64;
    const int kst = lrow * A2_KP + lch * 32, vst = lrow * A2_VP + lch * 32;
    const int vlane = (4 * hi + ((lane & 15) >> 2)) * A2_VP + (16 * ((lane >> 4) & 1) + 4 * (lane & 3)) * 2;
    constexpr int NC = DIFF ? 2 : 1;
    float mref[2] = {-1e30f, -1e30f}, ls[2] = {0.f, 0.f};
    bool ref0[2] = {false, false}, inited[2] = {false, false};
    f32x16 o1[4], o2[4];
#pragma unroll
    for (int d = 0; d < 4; ++d)
#pragma unroll
        for (int i = 0; i < 16; ++i) { o1[d][i] = 0.f; o2[d][i] = 0.f; }
    u32x4 kr0 = *(const u32x4*)(kg), kr1 = *(const u32x4*)(kg + 8), vr0 = *(const u32x4*)(vg), vr1 = *(const u32x4*)(vg + 8);
    *(LAS u32x4*)(Kb + kst) = kr0; *(LAS u32x4*)(Kb + kst + 16) = kr1; *(LAS u32x4*)(Vb + vst) = vr0; *(LAS u32x4*)(Vb + vst + 16) = vr1;
    __syncthreads();
    int cur = 0;
    for (int t = 0; t < ntile; ++t) {
        const bool more = (t + 1 < ntile);
        if (more) { const size_t go = (size_t)(t + 1) * 64 * 512; kr0 = *(const u32x4*)(kg + go); kr1 = *(const u32x4*)(kg + go + 8); vr0 = *(const u32x4*)(vg + go); vr1 = *(const u32x4*)(vg + go + 8); }
        const LAS unsigned char* Kc = Kb + cur * 64 * A2_KP; const LAS unsigned char* Vc = Vb + cur * 64 * A2_VP;
#pragma unroll
        for (int blk = 0; blk < 2; ++blk) {
            const int kv0 = 64 * t + 32 * blk;
            if (DIFF && kv0 > q0w + 31) continue;
            const bool diag = DIFF && (kv0 + 31 > q0w);
#pragma unroll
            for (int c = 0; c < NC; ++c) {
                f32x16 p;
#pragma unroll
                for (int i = 0; i < 16; ++i) p[i] = 0.f;
                constexpr int KS = DIFF ? 4 : 8;
                {
                    bf16x8 ka[KS], qa[KS];
#pragma unroll
                    for (int ks = 0; ks < KS; ++ks) { const int kk = c * 4 + ks;
                        ka[ks] = *(const LAS bf16x8*)(Kc + (32 * blk + r32) * A2_KP + (kk * 16 + hi * 8) * 2);
                        qa[ks] = *(const LAS bf16x8*)(qst + kk * 1024); }
                    __builtin_amdgcn_sched_barrier(0);
#pragma unroll
                    for (int ks = 0; ks < KS; ++ks) p = mfma32(ka[ks], qa[ks], p);
                }
                s16x4 vlo[8], vhh[8];
                { const LAS unsigned char* vp = Vc + vlane + 16 * (2 * blk) * A2_VP;
#pragma unroll
                    for (int d0 = 0; d0 < 4; ++d0) { vlo[d0] = vtr(vp + d0 * 64); vhh[d0] = vtr(vp + d0 * 64 + 8 * A2_VP); } }
                __builtin_amdgcn_sched_barrier(0);
                if (diag) {
#pragma unroll
                    for (int i = 0; i < 16; ++i) { if (kv0 + crow(i, hi) > qrow) p[i] = -1e30f; }
                }
                float mm = mref[c]; float w[16]; float sm = 0.f;
                if (ref0[c]) {
#pragma unroll
                    for (int i = 0; i < 16; ++i) { w[i] = __builtin_amdgcn_exp2f(p[i]); sm += w[i]; }
                } else {
#pragma unroll
                    for (int i = 0; i < 16; ++i) { w[i] = __builtin_amdgcn_exp2f(p[i] - mm); sm += w[i]; }
                }
                if (__any(!(sm <= (ref0[c] ? 1.0e30f : 256.f)))) {
                    float tm = fmaxf(p[0], p[1]);
#pragma unroll
                    for (int i = 2; i < 16; i += 2) tm = fmaxf(fmaxf(tm, p[i]), p[i + 1]);
                    tm = half_swap_max(tm);
                    if (!inited[c] && !__any(!(fabsf(tm) <= 40.f))) {
                        mref[c] = 0.f; mm = 0.f; ref0[c] = true;
                    } else {
                        const float mn = fmaxf(mref[c], tm); const float f = __builtin_amdgcn_exp2f(mref[c] - mn); ls[c] *= f; mref[c] = mn; mm = mn; ref0[c] = false;
                        float f16[16]; bcast_rows(wsf, f, r32, hi, f16);
                        if (c == 0) {
#pragma unroll
                            for (int d = 0; d < 4; ++d)
#pragma unroll
                                for (int i = 0; i < 16; ++i) o1[d][i] *= f16[i];
                        } else {
#pragma unroll
                            for (int d = 0; d < 4; ++d)
#pragma unroll
                                for (int i = 0; i < 16; ++i) o2[d][i] *= f16[i];
                        }
                    }
                    inited[c] = true;
                    sm = 0.f;
#pragma unroll
                    for (int i = 0; i < 16; ++i) { w[i] = __builtin_amdgcn_exp2f(p[i] - mm); sm += w[i]; }
                }
                ls[c] += sm;
                const bf16x8 fr0 = pack8(w), fr1 = pack8(w + 8);
                __builtin_amdgcn_sched_barrier(0);
                { const LAS unsigned char* vp = Vc + vlane + 16 * (2 * blk + 1) * A2_VP;
#pragma unroll
                    for (int d0 = 0; d0 < 4; ++d0) { vlo[4 + d0] = vtr(vp + d0 * 64); vhh[4 + d0] = vtr(vp + d0 * 64 + 8 * A2_VP); } }
                __builtin_amdgcn_sched_barrier(0);
#pragma unroll
                for (int s2 = 0; s2 < 2; ++s2) {
#pragma unroll
                    for (int d0 = 0; d0 < 4; ++d0) { const bf16x8 vb = __builtin_shufflevector(vlo[s2 * 4 + d0], vhh[s2 * 4 + d0], 0, 1, 2, 3, 4, 5, 6, 7);
                        if (c == 0) o1[d0] = mfma32(s2 ? fr1 : fr0, vb, o1[d0]); else o2[d0] = mfma32(s2 ? fr1 : fr0, vb, o2[d0]); }
                }
            }
        }
        if (more) { LAS unsigned char* kd = Kb + (cur ^ 1) * 64 * A2_KP + kst; *(LAS u32x4*)kd = kr0; *(LAS u32x4*)(kd + 16) = kr1;
            LAS unsigned char* vd = Vb + (cur ^ 1) * 64 * A2_VP + vst; *(LAS u32x4*)vd = vr0; *(LAS u32x4*)(vd + 16) = vr1; }
        __syncthreads(); cur ^= 1;
    }
    float a1[16], a2[16];
    { const float l1 = half_swap_sum(ls[0]); bcast_rows(wsf, 1.f / l1, r32, hi, a1); }
    if (DIFF) { const float l2 = half_swap_sum(ls[1]); bcast_rows(wsf, -lam / l2, r32, hi, a2); }
#pragma unroll
    for (int d = 0; d < 4; ++d)
#pragma unroll
        for (int i = 0; i < 16; ++i) { o1[d][i] *= a1[i]; if (DIFF) o1[d][i] += o2[d][i] * a2[i]; }
    bf16_t* ob = Ob + (size_t)q0w * 512 + r32;
    if (DIFF) {
        const float g0 = gain[r32] * post, g1 = gain[32 + r32] * post, g2 = gain[64 + r32] * post, g3 = gain[96 + r32] * post;
#pragma unroll
        for (int i = 0; i < 16; ++i) {
            float ss = o1[0][i] * o1[0][i] + o1[1][i] * o1[1][i] + o1[2][i] * o1[2][i] + o1[3][i] * o1[3][i];
            ss += __shfl_xor(ss, 1); ss += __shfl_xor(ss, 2); ss += __shfl_xor(ss, 4); ss += __shfl_xor(ss, 8); ss += __shfl_xor(ss, 16);
            const float rs = rsqrtf(ss * (1.f / 128.f) + RMS_EPS);
            bf16_t* rp = ob + (size_t)crow(i, hi) * 512;
            rp[0] = f2bf(o1[0][i] * rs * g0); rp[32] = f2bf(o1[1][i] * rs * g1); rp[64] = f2bf(o1[2][i] * rs * g2); rp[96] = f2bf(o1[3][i] * rs * g3);
        }
    } else {
#pragma unroll
        for (int i = 0; i < 16; ++i) { bf16_t* rp = ob + (size_t)crow(i, hi) * 512;
            rp[0] = f2bf(o1[0][i]); rp[32] = f2bf(o1[1][i]); rp[64] = f2bf(o1[2][i]); rp[96] = f2bf(o1[3][i]); }
    }
}

DI void transpose_item(const float* W, int K, int N, bf16_t* WT, int drow0, LAS float* scr, int k0, int n0, int lane, bool ropeperm) {
#pragma unroll
    for (int i = 0; i < 32; ++i) { const int kk = 2 * i + (lane >> 5); scr[kk * 33 + (lane & 31)] = W[(size_t)(k0 + kk) * N + n0 + (lane & 31)]; }
    asm volatile("s_waitcnt lgkmcnt(0)" ::: "memory");
    const int c = lane & 7;
#pragma unroll
    for (int j = 0; j < 4; ++j) { const int n = (lane >> 3) + 8 * j;
        int ns = n; if (ropeperm && n < 16) { const int gq = (n >> 2) & 3; ns = (n & 3) | ((gq == 1 ? 2 : gq == 2 ? 1 : gq) << 2); }
        const LAS float* s = scr + (8 * c) * 33 + ns;
        u32x4 o; o.x = pk2(s[0 * 33], s[1 * 33]); o.y = pk2(s[2 * 33], s[3 * 33]); o.z = pk2(s[4 * 33], s[5 * 33]); o.w = pk2(s[6 * 33], s[7 * 33]);
        *(u32x4*)(WT + (size_t)(drow0 + n) * K + k0 + 8 * c) = o; }
    asm volatile("s_waitcnt lgkmcnt(0)" ::: "memory");
}
DI void transpose_mat(const float* W, int K, int N, bf16_t* WT, bool glu, LAS float* scr, int gw, int ngw, int lane, int& goff, int rope_lo = -1, int rope_hi = -1) {
    lane = opaque(lane); gw = opaque_s(gw);
    const int nblk = N / 32, items = (K / 64) * nblk;
    int first = gw - (goff % ngw); if (first < 0) first += ngw;
    goff += items;
    for (int it = first; it < items; it += ngw) { const int kb = it / nblk, nb = it % nblk, n0 = nb * 32;
        int d0 = n0; if (glu) d0 = (n0 < 512) ? (n0 / 128) * 256 + (n0 % 128) : ((n0 - 512) / 128) * 256 + 128 + ((n0 - 512) % 128);
        transpose_item(W, K, N, WT, d0, scr, kb * 64, n0, lane, (n0 >= rope_lo) && (n0 < rope_hi) && ((n0 & 63) == 0)); }
}
DI void rms_row_bf16(const float* xrow, const float* gain, bf16_t* orow, int lane) {
    lane = opaque(lane);
    const f32x4* xr = (const f32x4*)xrow + lane; const f32x4* gr = (const f32x4*)gain + lane;
    f32x4 v[4]; float s = 0.f;
#pragma unroll
    for (int j = 0; j < 4; ++j) { v[j] = xr[64 * j]; s += (v[j].x * v[j].x + v[j].y * v[j].y) + (v[j].z * v[j].z + v[j].w * v[j].w); }
    const float r = rsqrtf(wave_sum(s) * (1.f / DM) + RMS_EPS);
    unsigned long long* o8 = (unsigned long long*)orow + lane;
#pragma unroll
    for (int j = 0; j < 4; ++j) { const f32x4 gq = gr[64 * j];
        o8[64 * j] = (unsigned long long)pk2(v[j].x * r * gq.x, v[j].y * r * gq.y) | ((unsigned long long)pk2(v[j].z * r * gq.z, v[j].w * r * gq.w) << 32); }
}
DI void prep_row_bf16(const float* xrow, const float* gain, bf16_t* orow, float* prow, int lane) {
    lane = opaque(lane);
    const f32x4* xr = (const f32x4*)xrow + lane; const f32x4* gr = (const f32x4*)gain + lane;
    f32x4 v[4]; float s = 0.f;
#pragma unroll
    for (int j = 0; j < 4; ++j) { v[j] = xr[64 * j]; s += (v[j].x * v[j].x + v[j].y * v[j].y) + (v[j].z * v[j].z + v[j].w * v[j].w); }
    s = wave_sum(s);
    if (lane < 16) prow[lane] = (lane == 0) ? s : 0.f;
    unsigned long long* o8 = (unsigned long long*)orow + lane;
#pragma unroll
    for (int j = 0; j < 4; ++j) { const f32x4 gq = gr[64 * j];
        o8[64 * j] = (unsigned long long)pk2(v[j].x * gq.x, v[j].y * gq.y) | ((unsigned long long)pk2(v[j].z * gq.z, v[j].w * gq.w) << 32); }
}
DI void rms_row_f32(float* xrow, const float* gain, int lane) {
    lane = opaque(lane);
    f32x4* xr = (f32x4*)xrow + lane; const f32x4* gr = (const f32x4*)gain + lane;
    f32x4 v[4]; float s = 0.f;
#pragma unroll
    for (int j = 0; j < 4; ++j) { v[j] = xr[64 * j]; s += (v[j].x * v[j].x + v[j].y * v[j].y) + (v[j].z * v[j].z + v[j].w * v[j].w); }
    const float r = rsqrtf(wave_sum(s) * (1.f / DM) + RMS_EPS);
#pragma unroll
    for (int j = 0; j < 4; ++j) xr[64 * j] = v[j] * r * gr[64 * j];
}

struct Params {
    const float* x; const float* mem; const int* pos;
    const float *norm_mix, *w_in, *lam_re, *lam_im, *log_dt, *b_re, *b_im, *c_re, *c_im, *ssm_d, *w_glu, *diff_lambda, *diff_subln, *w_branch, *w_out,
                *norm_cross, *norm_mem, *w_xq, *w_xkv, *w_xo, *norm_mlp, *w_up, *w_down, *norm_final;
    float* out; unsigned char* ws;
};

typedef const __attribute__((address_space(4))) Params* KPtr;
DI KPtr kp_get() { unsigned long long v = (unsigned long long)__builtin_amdgcn_kernarg_segment_ptr(); asm volatile("" : "+s"(v)); return (KPtr)v; }
#define PP (kp_get())

DI void ssm_prep(int l, LAS unsigned char* lds) {
    const int tid = opaque(threadIdx.x);
    LAS f32x2_t* E = (LAS f32x2_t*)lds;
    LAS f32x2_t* Bb = (LAS f32x2_t*)(lds + 33 * 64 * 8);
    LAS f32x2_t* Cc = (LAS f32x2_t*)(lds + 33 * 64 * 8 + 1024 * 8);
    LAS float* Kk = (LAS float*)(lds + 33 * 64 * 8 + 1024 * 8 + 64 * 8);
    bf16_t* toep = (bf16_t*)(PP->ws + WS_TOEP); bf16_t* wst = (bf16_t*)(PP->ws + WS_WST); f32x2_t* lamT = (f32x2_t*)(PP->ws + WS_LAMT);
    const float* lre = PP->lam_re + l * 2048; const float* lim = PP->lam_im + l * 2048; const float* ldt = PP->log_dt + l * 32;
    const float* bre = PP->b_re + (size_t)l * 32768; const float* bim = PP->b_im + (size_t)l * 32768;
    const float* cre = PP->c_re + (size_t)l * 32768; const float* cim = PP->c_im + (size_t)l * 32768; const float* dsk = PP->ssm_d + l * 512;
    for (int un = blockIdx.x; un < 512; un += gridDim.x) {
        const int g = un >> 4, co = un & 15; const float dt = __expf(ldt[g]);
        for (int idx = tid; idx < 33 * 64; idx += 512) { const int tau = idx >> 6, p = idx & 63; const float lr = lre[g * 64 + p] * dt; const double li = (double)(lim[g * 64 + p] * dt);
            const float mag = __expf(tau * lr); float s, c; sincos_red(tau * li, s, c); E[idx] = (f32x2_t){mag * c, mag * s}; }
        for (int idx = tid; idx < 1024; idx += 512) { const int p = idx >> 4, ci = idx & 15; const float ar = lre[g * 64 + p], ai = lim[g * 64 + p];
            const float mag = __expf(ar * dt); float s, c; sincos_red((double)(ai * dt), s, c);
            const float nr = mag * c - 1.f, ni = mag * s; const float den = 1.f / (ar * ar + ai * ai);
            const float qr = (nr * ar + ni * ai) * den, qi = (ni * ar - nr * ai) * den;
            const float br = bre[(size_t)(g * 64 + p) * 16 + ci], bi = bim[(size_t)(g * 64 + p) * 16 + ci];
            Bb[idx] = (f32x2_t){qr * br - qi * bi, qr * bi + qi * br}; }
        if (tid < 64) Cc[tid] = (f32x2_t){cre[(size_t)(g * 16 + co) * 64 + tid], cim[(size_t)(g * 16 + co) * 64 + tid]};
        __syncthreads();
        { const int tau = tid >> 4, ci = tid & 15; float a = 0.f;
            for (int p = 0; p < 64; ++p) { const f32x2_t e = E[tau * 64 + p], cc = Cc[p], bb = Bb[p * 16 + ci];
                const float cr = cc.x * e.x - cc.y * e.y, cim2 = cc.x * e.y + cc.y * e.x; a += cr * bb.x - cim2 * bb.y; }
            Kk[tid] = a; }
        __syncthreads();
        const float dval = dsk[g * 16 + co];
        for (int idx = tid; idx < 32 * SSM_K2; idx += 512) { const int t = idx / SSM_K2, k = idx % SSM_K2; float val;
            if (k < 512) { const int s = k >> 4, ci = k & 15; val = (t >= s) ? Kk[(t - s) * 16 + ci] : 0.f; if (s == t && ci == co) val += dval; }
            else { const int p = (k - 512) & 63; const f32x2_t e = E[(t + 1) * 64 + p], cc = Cc[p];
                val = (k < 576) ? (cc.x * e.x - cc.y * e.y) : -(cc.x * e.y + cc.y * e.x); }
            toep[(size_t)(g * 512 + t * 16 + co) * SSM_K2 + k] = f2bf(val); }
        __syncthreads();
    }
    for (int un = blockIdx.x; un < 2048; un += gridDim.x) {
        const int g = un >> 6, p = un & 63; const float dt = __expf(ldt[g]); const int s = tid >> 4, ci = tid & 15;
        const float ar = lre[g * 64 + p], ai = lim[g * 64 + p];
        float sn, cs; const float mag = __expf(ar * dt); sincos_red((double)(ai * dt), sn, cs);
        const float nr = mag * cs - 1.f, ni = mag * sn; const float den = 1.f / (ar * ar + ai * ai);
        const float qr = (nr * ar + ni * ai) * den, qi = (ni * ar - nr * ai) * den;
        const float br = bre[(size_t)(g * 64 + p) * 16 + ci], bi = bim[(size_t)(g * 64 + p) * 16 + ci];
        const float bbr = qr * br - qi * bi, bbi = qr * bi + qi * br;
        const int tau = 31 - s; const float em = __expf(tau * ar * dt); float es, ec; sincos_red((double)tau * (double)(ai * dt), es, ec);
        const float er = em * ec, ei = em * es;
        const size_t o = (size_t)(g * 256 + p) * 512 + s * 16 + ci;
        wst[o] = f2bf(er * bbr - ei * bbi); wst[o + 64 * 512] = f2bf(er * bbi + ei * bbr); wst[o + 128 * 512] = 0; wst[o + 192 * 512] = 0;
        if (tid == 0) { const float m32 = __expf(32.f * ar * dt); float s3, c3; sincos_red(32.0 * (double)(ai * dt), s3, c3); lamT[g * 64 + p] = (f32x2_t){m32 * c3, m32 * s3}; }
    }
}

DI void ssm_scan(LAS unsigned char* lds) {
    const int tid = opaque(threadIdx.x);
    const float* sloc = (const float*)(PP->ws + WS_SLOC); bf16_t* a2 = (bf16_t*)(PP->ws + WS_A2); const f32x2_t* lamT = (const f32x2_t*)(PP->ws + WS_LAMT);
    for (int un = blockIdx.x; un < NB * 32; un += gridDim.x) {
        const int g = un & 31, b = un >> 5; const size_t r0 = (size_t)g * SSM_M2 + b * SSM_NC;
        const f32x4* src = (const f32x4*)(sloc + r0 * 128) + tid;
#pragma unroll
        for (int j = 0; j < 8; ++j) ((LAS f32x4*)lds)[tid + j * 512] = src[j * 512];
        __syncthreads();
        if (tid < 64) { const int p = tid; const f32x2_t lt = lamT[g * 64 + p]; float sr = 0.f, si = 0.f; const LAS float* L = (const LAS float*)lds;
            bf16_t* dst = a2 + r0 * SSM_K2 + 512 + p;
#pragma unroll 8
            for (int c = 0; c < SSM_NC; ++c) { dst[(size_t)c * SSM_K2] = f2bf(sr); dst[(size_t)c * SSM_K2 + 64] = f2bf(si);
                const float lr = L[c * 128 + p], li = L[c * 128 + 64 + p];
                const float nr = lt.x * sr - lt.y * si + lr, ni = lt.x * si + lt.y * sr + li; sr = nr; si = ni; } }
        __syncthreads();
    }
}

#define XB_TMO      128
#define XB_XCNT(j)  (256  + 64 * (j))
#define XB_XSUB(j)  (1280 + 64 * (j))
#define XB_XGEN(j)  (2304 + 64 * (j))
#define XB_TOP      3328
#define XB_TOPGEN   3392
#define XCD_BAR_WORDS 3456
#define XB_SPIN_CAP (1u << 18)
DI unsigned xb_ld(unsigned* p)              { return __hip_atomic_load(p, __ATOMIC_RELAXED, __HIP_MEMORY_SCOPE_AGENT); }
DI unsigned xb_add(unsigned* p, unsigned v) { return __hip_atomic_fetch_add(p, v, __ATOMIC_RELAXED, __HIP_MEMORY_SCOPE_AGENT); }
DI unsigned xb_xcc_id() { return (unsigned)__builtin_amdgcn_s_getreg((3 << 11) | 20) & 0xFu; }
#define XB_SPIN(cond, bar) do { unsigned _sp = 0; while (cond) { __builtin_amdgcn_s_sleep(1); \
    if ((++_sp & 255u) == 0u) { if (xb_ld(&(bar)[XB_TMO])) break; if (_sp > XB_SPIN_CAP) { atomicAdd(&(bar)[XB_TMO], 1u); break; } } } } while (0)
struct XcdBarrier { unsigned* bar; unsigned x; volatile LAS unsigned* st; };
DI XcdBarrier xcd_barrier_post(unsigned* bar, volatile LAS unsigned* st) {
    XcdBarrier b; b.bar = bar; b.x = xb_xcc_id(); b.st = st;
    if (threadIdx.x == 0) (void)xb_add(&bar[XB_XCNT(b.x)], 1u);
    return b;
}
DI void xcd_barrier_complete(unsigned* bar, unsigned x, unsigned& nloc, unsigned& nx) {
    const unsigned G = gridDim.x * gridDim.y * gridDim.z;
    unsigned sum, cnt, mine, sp = 0u;
    for (;;) {
        sum = 0u; cnt = 0u; mine = 0u;
#pragma unroll
        for (unsigned j = 0; j < 16; ++j) { const unsigned c = xb_ld(&bar[XB_XCNT(j)]); sum += c; cnt += (c > 0u) ? 1u : 0u; mine = (j == x) ? c : mine; }
        if (sum == G) break;
        __builtin_amdgcn_s_sleep(1);
        if ((++sp & 255u) == 0u) { if (xb_ld(&bar[XB_TMO])) break; if (sp > XB_SPIN_CAP) { atomicAdd(&bar[XB_TMO], 1u); break; } }
    }
    nloc = mine > 0u ? mine : 1u; nx = cnt > 0u ? cnt : 1u;
}
DI void xcd_barrier(const XcdBarrier& b) {
    asm volatile("s_waitcnt vmcnt(0)" ::: "memory");
    __syncthreads();
    if (opaque((int)threadIdx.x) == 0) {
        unsigned* bar = b.bar;
        __builtin_amdgcn_s_waitcnt(0);
        unsigned nloc = b.st[0], nx = b.st[1];
        if (nloc == 0u) { xcd_barrier_complete(bar, b.x, nloc, nx); b.st[0] = nloc; b.st[1] = nx; }
        const unsigned old = xb_add(&bar[XB_XSUB(b.x)], 1u);
        const unsigned gen = old / nloc;
        if (old + 1u == (gen + 1u) * nloc) {
            __builtin_amdgcn_fence(__ATOMIC_RELEASE, "agent");
            asm volatile("s_waitcnt vmcnt(0)" ::: "memory");
            const unsigned og = xb_add(&bar[XB_TOP], 1u);
            const unsigned tg = og / nx;
            if (og + 1u == (tg + 1u) * nx) xb_add(&bar[XB_TOPGEN], 1u);
            else XB_SPIN(xb_ld(&bar[XB_TOPGEN]) == tg, bar);
            __builtin_amdgcn_fence(__ATOMIC_ACQUIRE, "agent");
            xb_add(&bar[XB_XGEN(b.x)], 1u);
            asm volatile("s_waitcnt vmcnt(0)" ::: "memory");
        } else {
            XB_SPIN(xb_ld(&bar[XB_XGEN(b.x)]) == gen, bar);
            __builtin_amdgcn_fence(__ATOMIC_ACQUIRE, "agent");
            asm volatile("s_waitcnt vmcnt(0)" ::: "memory");
        }
    }
    __syncthreads();
}

#define HBUF ((bf16_t*)(PP->ws + WS_H))
#define LAMS ((float*)(PP->ws + WS_LAMT + 65536))
__global__ void __launch_bounds__(512, 2) fwd_megakernel(Params P) {
    extern __shared__ __attribute__((aligned(16))) unsigned char lds_raw[];
    LAS unsigned char* lds = (LAS unsigned char*)lds_raw;
    cg::grid_group grid = cg::this_grid();
    const int tid = threadIdx.x, lane = tid & 63, wave = __builtin_amdgcn_readfirstlane(tid >> 6);
    const int G = gridDim.x, c = blockIdx.x;
    const int gw = c * 8 + wave, ngw = G * 8;
    LAS float* scr = (LAS float*)(lds + wave * 16384);
    if (tid < 4) ((LAS unsigned*)(lds + LDS_CTL + 64))[tid] = 0u;
    __syncthreads();
    if (c == 0) { unsigned* bw = (unsigned*)PP->ws + 4096; for (int i = tid; i < XCD_BAR_WORDS; i += 512) bw[i] = 0u; }
    XcdBarrier xbar; xbar.bar = (unsigned*)PP->ws + 4096; xbar.x = xb_xcc_id(); xbar.st = (volatile LAS unsigned*)(lds + LDS_CTL + 64);
    grid.sync();
    if (opaque((int)threadIdx.x) == 0) (void)xb_add(&xbar.bar[XB_XCNT(xbar.x)], 1u);

    int goff = 0;
    for (int i = c * 512 + tid; i < MTOK * 8; i += G * 512) { const int row = i >> 3, j = i & 7;
        const float invf = __builtin_amdgcn_exp2f(-(float)j * 2.3664460712f);   const float ang = (float)PP->pos[row] * invf; float s, cs; sincos_red((double)ang, s, cs);
        ((f32x2_t*)(PP->ws + WS_ROPE))[i] = (f32x2_t){cs, s}; }
    if (c == 0 && tid < DEPTH) { const float* lv = PP->diff_lambda + tid * 256; float a = 0.f, b = 0.f;
        for (int k = 0; k < 64; ++k) { a += lv[k] * lv[64 + k]; b += lv[128 + k] * lv[192 + k]; }
        LAMS[tid] = expf(a) - expf(b) + (0.8f - 0.6f * expf(-0.3f * (float)tid)); }
    for (int r = gw; r < DEPTH * NB * MEML; r += ngw) { const int l = r / (NB * MEML), m = r % (NB * MEML);
        rms_row_bf16(PP->mem + (size_t)m * DM, PP->norm_mem + l * DM, (bf16_t*)(PP->ws + WS_MEMN) + (size_t)r * DM, lane); }
    for (int l = 0; l < DEPTH; ++l) transpose_mat(PP->w_xkv + (size_t)l * DM * 1024, DM, 1024, (bf16_t*)(PP->ws + WS_WXKV) + (size_t)l * 1024 * DM, false, scr, gw, ngw, lane, goff);

    for (int l = 0; l < DEPTH; ++l) {
        const float* xin = (l == 0) ? PP->x : PP->out;
        transpose_mat(PP->w_in + (size_t)l * DM * NIN, DM, NIN, (bf16_t*)(PP->ws + WS_WIN), false, scr, gw, ngw, lane, goff, 2048, 3072);
        transpose_mat(PP->w_glu + (size_t)l * 512 * 1024, 512, 1024, (bf16_t*)(PP->ws + WS_WGLU), true, scr, gw, ngw, lane, goff);
        for (int z = 0; z < 3; ++z) transpose_mat(PP->w_branch + ((size_t)l * 3 + z) * 512 * DM, 512, DM, (bf16_t*)(PP->ws + WS_WB) + (size_t)z * DM * 512, false, scr, gw, ngw, lane, goff);
        transpose_mat(PP->w_out + (size_t)l * DM * DM, DM, DM, (bf16_t*)(PP->ws + WS_WOUT), false, scr, gw, ngw, lane, goff);
        transpose_mat(PP->w_xq + (size_t)l * DM * 512, DM, 512, (bf16_t*)(PP->ws + WS_WXQ), false, scr, gw, ngw, lane, goff);
        transpose_mat(PP->w_xo + (size_t)l * 512 * DM, 512, DM, (bf16_t*)(PP->ws + WS_WXO), false, scr, gw, ngw, lane, goff);
        transpose_mat(PP->w_up + (size_t)l * DM * 4096, DM, 4096, (bf16_t*)(PP->ws + WS_WUP), false, scr, gw, ngw, lane, goff);
        transpose_mat(PP->w_down + (size_t)l * 4096 * DM, 4096, DM, (bf16_t*)(PP->ws + WS_WDN), false, scr, gw, ngw, lane, goff);
        __syncthreads();
        ssm_prep(l, lds);
        if (l == 0) for (int r = gw; r < MTOK; r += ngw) prep_row_bf16(xin + (size_t)r * DM, PP->norm_mix, HBUF + (size_t)r * DM, (float*)(PP->ws + WS_PART) + (size_t)r * 16, lane);
        xcd_barrier(xbar);

        { pg8::Gemm g{HBUF, (const bf16_t*)(PP->ws + WS_WIN), DM, DM, DM, 0, 0}; pg8::SchedMN S{MTOK / 256, NINA / 256, G, c};
          pg8::EpiInProj E{PP->ws, (const f32x2_t*)(PP->ws + WS_ROPE), (const float*)(PP->ws + WS_PART)}; pg8::gemm_phase(lds, g, S, E); }
        if (l == 0) { pg8::Gemm g{(const bf16_t*)(PP->ws + WS_MEMN), (const bf16_t*)(PP->ws + WS_WXKV), DM, DM, DM, (long)NB * MEML * DM, (long)1024 * DM};
          pg8::SchedZ S{DEPTH, NB * MEML / 256, 1024 / 256, G, c}; pg8::EpiMemKV E{(bf16_t*)(PP->ws + WS_MEMKV)}; pg8::gemm_phase(lds, g, S, E); }
        xcd_barrier(xbar);

        { pg8::Gemm g{(const bf16_t*)(PP->ws + WS_A2), (const bf16_t*)(PP->ws + WS_WST), SSM_K2, 512, 512, (long)SSM_M2 * SSM_K2, (long)256 * 512};
          pg8::SchedZ S{32, SSM_M2 / 256, 1, G, c}; pg8::EpiSloc E{(float*)(PP->ws + WS_SLOC)}; pg8::gemm_phase(lds, g, S, E); }
        xcd_barrier(xbar);
        ssm_scan(lds);
        xcd_barrier(xbar);
        { pg8::Gemm g{(const bf16_t*)(PP->ws + WS_A2), (const bf16_t*)(PP->ws + WS_TOEP), SSM_K2, SSM_K2, SSM_K2, (long)SSM_M2 * SSM_K2, (long)512 * SSM_K2};
          pg8::SchedZ S{32, SSM_M2 / 256, 2, G, c}; pg8::EpiGelu E{(bf16_t*)(PP->ws + WS_YACT)}; pg8::gemm_phase(lds, g, S, E); }
        xcd_barrier(xbar);
        { pg8::Gemm g{(const bf16_t*)(PP->ws + WS_YACT), (const bf16_t*)(PP->ws + WS_WGLU), 512, 512, 512, 0, 0}; pg8::SchedMN S{MTOK / 256, 4, G, c};
          pg8::EpiGlu E{(bf16_t*)(PP->ws + WS_YSSM)}; pg8::gemm_phase(lds, g, S, E); }
        for (int r = 0;; ++r) { const int pos = (r & 1) ? G - 1 - c : c; const int idx = r * G + pos; if (idx >= 1024) break;
            const int qb = 15 - idx / 64, bh = idx % 64;
            sb_unit(bh >> 3, bh & 7, qb, (const bf16_t*)(PP->ws + WS_SQ), (bf16_t*)(PP->ws + WS_SQ), (const bf16_t*)(PP->ws + WS_SK), (const bf16_t*)(PP->ws + WS_SV), lds); }
        { const float lam = LAMS[l]; const float post = 1.f - (0.8f - 0.6f * expf(-0.3f * (float)l));
          for (int r = 0;; ++r) { const int pos = (r & 1) ? G - 1 - c : c; const int idx = r * G + pos; if (idx >= 512) break;
            const int qb = 15 - idx / 32, bh = idx % 32, b = bh >> 2, hh = bh & 3; const size_t off = (size_t)b * SEQ * 512 + hh * 128;
            attn2_unit<true>(qb, (const bf16_t*)(PP->ws + WS_DQ) + off, (bf16_t*)(PP->ws + WS_DQ) + off, (const bf16_t*)(PP->ws + WS_DK) + off, (const bf16_t*)(PP->ws + WS_DV) + off, 4 * qb + 4, lam, PP->diff_subln + l * 128, post, lds); } }
        xcd_barrier(xbar);
        { pg8::GmArgs ga{HBUF, (const bf16_t*)(PP->ws + WS_WIN) + (size_t)NINA * DM, (const bf16_t*)(PP->ws + WS_YSSM), (long)(WS_SQ - WS_YSSM) / 2, (const bf16_t*)(PP->ws + WS_WB),
                         (bf16_t*)(PP->ws + WS_GS), (bf16_t*)(PP->ws + WS_H2), (const float*)(PP->ws + WS_PART)};
          pg8::SchedGM S{MTOK / 256, 4, G, c}; pg8::gemm_phase_gm(lds, ga, S); }
        xcd_barrier(xbar);
        { pg8::Gemm g{(const bf16_t*)(PP->ws + WS_H2), (const bf16_t*)(PP->ws + WS_WOUT), DM, DM, DM, 0, 0}; pg8::SchedMN S{MTOK / 256, 4, G, c}; pg8::EpiResid E{xin, PP->out, HBUF, PP->norm_cross + l * DM, (float*)(PP->ws + WS_PART)}; pg8::gemm_phase(lds, g, S, E); }
        xcd_barrier(xbar);
        { pg8::Gemm g{HBUF, (const bf16_t*)(PP->ws + WS_WXQ), DM, DM, DM, 0, 0}; pg8::SchedMN S{MTOK / 256, 2, G, c};
          pg8::EpiBf16<0, true> E{(bf16_t*)(PP->ws + WS_XQ), 512, 0.12751743074602334f, (const float*)(PP->ws + WS_PART)}; pg8::gemm_phase(lds, g, S, E); }
        xcd_barrier(xbar);
        for (int idx = c; idx < 512; idx += G) { const int qb = idx & 15, bh = idx >> 4, b = bh >> 2, hh = bh & 3;
            const bf16_t* kb = (const bf16_t*)(PP->ws + WS_MEMKV) + (size_t)(l * 2) * 2048 * 512 + (size_t)b * MEML * 512 + hh * 128;
            attn2_unit<false>(qb, (const bf16_t*)(PP->ws + WS_XQ) + (size_t)b * SEQ * 512 + hh * 128, (bf16_t*)(PP->ws + WS_XQ) + (size_t)b * SEQ * 512 + hh * 128, kb, kb + (size_t)2048 * 512, 4, 0.f, nullptr, 1.f, lds); }
        xcd_barrier(xbar);
        { pg8::Gemm g{(const bf16_t*)(PP->ws + WS_XQ), (const bf16_t*)(PP->ws + WS_WXO), 512, 512, 512, 0, 0}; pg8::SchedMN S{MTOK / 256, 4, G, c}; pg8::EpiResid E{PP->out, PP->out, HBUF, PP->norm_mlp + l * DM, (float*)(PP->ws + WS_PART)}; pg8::gemm_phase(lds, g, S, E); }
        xcd_barrier(xbar);
        { pg8::Gemm g{HBUF, (const bf16_t*)(PP->ws + WS_WUP), DM, DM, DM, 0, 0}; pg8::SchedMN S{MTOK / 256, 16, G, c};
          pg8::EpiBf16<2, true> E{(bf16_t*)(PP->ws + WS_HID), 4096, 1.f, (const float*)(PP->ws + WS_PART)}; pg8::gemm_phase(lds, g, S, E); }
        xcd_barrier(xbar);
        { pg8::Gemm g{(const bf16_t*)(PP->ws + WS_HID), (const bf16_t*)(PP->ws + WS_WDN), 4096, 4096, 4096, 0, 0}; pg8::SchedMN S{MTOK / 256, 4, G, c}; pg8::EpiResid E{PP->out, PP->out, HBUF, PP->norm_mix + (l + 1 < DEPTH ? l + 1 : l) * DM, (float*)(PP->ws + WS_PART)}; pg8::gemm_phase(lds, g, S, E); }
        xcd_barrier(xbar);
    }
    for (int r = gw; r < MTOK; r += ngw) rms_row_f32(PP->out + (size_t)r * DM, PP->norm_final, lane);
}

extern "C" void kernel_launch(void* const* d_in, const int* in_sizes, int n_in, void* d_out, int out_size, void* d_ws, size_t ws_size, hipStream_t stream) {
    static int grid = 0;
    if (grid == 0) {
        if (n_in != 27 || ws_size < WS_END) { fprintf(stderr, "kernel_launch: unexpected n_in %d / ws %zu\n", n_in, ws_size); grid = -1; return; }
        int dev = 0, cus = 0, per_cu = 0;
        hipGetDevice(&dev); hipDeviceGetAttribute(&cus, hipDeviceAttributeMultiprocessorCount, dev);
        hipFuncSetAttribute((const void*)fwd_megakernel, hipFuncAttributeMaxDynamicSharedMemorySize, LDS_BYTES);
        hipOccupancyMaxActiveBlocksPerMultiprocessor(&per_cu, (const void*)fwd_megakernel, 512, LDS_BYTES);
        if (per_cu < 1) per_cu = 1;
        grid = cus * 1; (void)per_cu;
        (void)hipGetLastError();
    }
    if (grid < 0) return;
    Params p{};
    p.x = (const float*)d_in[0]; p.mem = (const float*)d_in[1]; p.pos = (const int*)d_in[2];
    p.norm_mix = (const float*)d_in[3]; p.w_in = (const float*)d_in[4]; p.lam_re = (const float*)d_in[5]; p.lam_im = (const float*)d_in[6]; p.log_dt = (const float*)d_in[7];
    p.b_re = (const float*)d_in[8]; p.b_im = (const float*)d_in[9]; p.c_re = (const float*)d_in[10]; p.c_im = (const float*)d_in[11]; p.ssm_d = (const float*)d_in[12];
    p.w_glu = (const float*)d_in[13]; p.diff_lambda = (const float*)d_in[14]; p.diff_subln = (const float*)d_in[15]; p.w_branch = (const float*)d_in[16]; p.w_out = (const float*)d_in[17];
    p.norm_cross = (const float*)d_in[18]; p.norm_mem = (const float*)d_in[19]; p.w_xq = (const float*)d_in[20]; p.w_xkv = (const float*)d_in[21]; p.w_xo = (const float*)d_in[22];
    p.norm_mlp = (const float*)d_in[23]; p.w_up = (const float*)d_in[24]; p.w_down = (const float*)d_in[25]; p.norm_final = (const float*)d_in[26];
    p.out = (float*)d_out; p.ws = (unsigned char*)d_ws;
    void* args[] = {&p};
    hipError_t e = hipLaunchCooperativeKernel((const void*)fwd_megakernel, dim3(grid), dim3(512), args, LDS_BYTES, stream);
    if (e != hipSuccess) fprintf(stderr, "cooperative launch failed: %s (grid %d)\n", hipGetErrorString(e), grid);
}
```

```cpp
#include <hip/hip_runtime.h>
#include <hip/hip_cooperative_groups.h>
#include <cstdint>
#include <cstdio>
namespace cg = cooperative_groups;

#define LAS __attribute__((address_space(3)))
#define DI __device__ __forceinline__
typedef unsigned short bf16_t;
typedef short bf16x8 __attribute__((ext_vector_type(8)));
typedef short s16x4 __attribute__((ext_vector_type(4)));
typedef short v4i16_t __attribute__((ext_vector_type(4)));
typedef float f32x4 __attribute__((ext_vector_type(4)));
typedef float f32x16 __attribute__((ext_vector_type(16)));
typedef unsigned u32x4 __attribute__((ext_vector_type(4)));
typedef float f32x2_t __attribute__((ext_vector_type(2)));
typedef __bf16 bf16x2_t __attribute__((ext_vector_type(2)));

constexpr int DM = 1024, NB = 8, SEQ = 4096, MTOK = NB * SEQ, DEPTH = 2, MEML = 256;
constexpr int NIN = 6656, NINA = 3584;
constexpr float RMS_EPS = 1e-6f;
constexpr int SSM_T = 32, SSM_NC = SEQ / SSM_T  , SSM_M2 = NB * SSM_NC  , SSM_K2 = 640;

constexpr size_t MiB = 1u << 20;
constexpr size_t WS_ROPE = 1 * MiB;
constexpr size_t WS_LAMT = 3 * MiB;
constexpr size_t WS_MEMN = 4 * MiB;
constexpr size_t WS_WXKV = 12 * MiB;
constexpr size_t WS_MEMKV = 16 * MiB;
constexpr size_t WS_WIN = 24 * MiB;
constexpr size_t WS_WGLU = 37 * MiB;
constexpr size_t WS_WB = 38 * MiB;
constexpr size_t WS_WOUT = 41 * MiB;
constexpr size_t WS_WXQ = 43 * MiB;
constexpr size_t WS_WXO = 44 * MiB;
constexpr size_t WS_WUP = 45 * MiB;
constexpr size_t WS_WDN = 53 * MiB;
constexpr size_t WS_WST = 61 * MiB;
constexpr size_t WS_TOEP = 69 * MiB;
constexpr size_t WS_H = 90 * MiB;
constexpr size_t WS_YSSM = 154 * MiB;
constexpr size_t WS_SQ = 186 * MiB;
constexpr size_t WS_DQ = 218 * MiB;
constexpr size_t WS_SK = 250 * MiB;
constexpr size_t WS_SV = 282 * MiB;
constexpr size_t WS_DK = 314 * MiB;
constexpr size_t WS_DV = 346 * MiB;
constexpr size_t WS_A2 = 378 * MiB;
constexpr size_t WS_SLOC = 418 * MiB;
constexpr size_t WS_YACT = 434 * MiB;
constexpr size_t WS_GATES = 250 * MiB;
constexpr size_t WS_HID = 154 * MiB;
constexpr size_t WS_XQ = 154 * MiB;
constexpr size_t WS_H2 = 250 * MiB;
constexpr size_t WS_GS = 314 * MiB;
constexpr size_t WS_PART = 466 * MiB;
constexpr size_t WS_END = 468 * MiB;

constexpr int LDS_CTL = 143360;
constexpr int LDS_BYTES = LDS_CTL + 1024;

DI unsigned pk2(float lo, float hi) { f32x2_t v = {lo, hi}; bf16x2_t b = __builtin_convertvector(v, bf16x2_t); return __builtin_bit_cast(unsigned, b); }
DI bf16_t f2bf(float f) { return (bf16_t)(pk2(f, 0.f) & 0xffffu); }
DI float bf2f(unsigned u) { return __uint_as_float(u << 16); }
DI void st8(bf16_t* p, f32x4 a, f32x4 b) { u32x4 w; w.x = pk2(a[0], a[1]); w.y = pk2(a[2], a[3]); w.z = pk2(b[0], b[1]); w.w = pk2(b[2], b[3]); *(u32x4*)p = w; }
DI int opaque(int v) { asm volatile("" : "+v"(v)); return v; }
DI int opaque_s(int v) { asm volatile("" : "+s"(v)); return v; }
DI float sigmoidf_(float x) { return __builtin_amdgcn_rcpf(1.f + __builtin_amdgcn_exp2f(x * -1.4426950408889634f)); }
DI float wave_sum(float v) {
#pragma unroll
    for (int o = 1; o < 64; o <<= 1) v += __shfl_xor(v, o);
    return v;
}
DI void sincos_red(double a, float& s, float& c) {
    const double k = rint(a * 0.15915494309189535);
    const float r = (float)(a - k * 6.283185307179586);
    s = __sinf(r); c = __cosf(r);
}

namespace pg8 {
constexpr int BM = 256, BK = 64, HALF = 128, HTB = HALF * BK * 2, STAGE_BYTES = 8 * HTB, NXCD = 8, WGM = 8;
DI int lds_byte(int r, int c) { const int st = (r >> 4) * 2 + (c >> 5), rr = r & 15, cc = c & 31, ob = rr * 64 + cc * 2; return st * 1024 + (ob ^ (((ob >> 9) & 1) << 5)); }
DI void stage_rc(int b, int& R, int& C) { const int st = b / 1024, sb = b % 1024, swz = sb ^ (((sb >> 9) & 1) << 5); R = (st >> 1) * 16 + swz / 64; C = (st & 1) * 32 + (swz % 64) / 2; }
DI int perm32(int rho) { const int n = rho >> 4, i = rho & 15; return 8 * (i >> 2) + 4 * n + (i & 3); }

struct Unit { int pm, pn, z; };
struct Gemm { const bf16_t* A; const bf16_t* Bt; int lda, ldb, K; long zA, zB; };

DI void tile_decode(int wgid, int nM, int nN, int& pm, int& pn) {
    const int nwg = nM * nN;
    { const int q = nwg / NXCD, r = nwg % NXCD, xcd = wgid % NXCD, off = wgid / NXCD; wgid = (xcd < r ? xcd * (q + 1) : r * (q + 1) + (xcd - r) * q) + off; }
    const int nig = WGM * nN, gid = wgid / nig, fm = gid * WGM, gsz = (nM - fm) < WGM ? (nM - fm) : WGM;
    pm = fm + ((wgid % nig) % gsz); pn = (wgid % nig) / gsz;
}
struct SchedMN {
    int nM, nN, G, c;
    DI bool next(int i, Unit& u) const { const long L = (long)i * G + c; if (L >= (long)nM * nN) return false; tile_decode((int)L, nM, nN, u.pm, u.pn); u.z = 0; return true; }
};
struct SchedZ {
    int nZ, nM, nN, G, c;
    DI bool next(int i, Unit& u) const { const long L = (long)i * G + c; if (L >= (long)nZ * nM * nN) return false; const int l = (int)L; u.z = l / (nM * nN); const int r = l % (nM * nN); u.pm = r / nN; u.pn = r % nN; return true; }
};
struct SchedMerge {
    int nM, nN, G, c;
    DI bool next(int i, Unit& u) const { const long L = (long)(i / 3) * G + c; if (L >= (long)nM * nN) return false; tile_decode((int)L, nM, nN, u.pm, u.pn); u.z = i % 3; return true; }
};

template <class Epi, class Sched>
DI void gemm_phase(LAS unsigned char* lds, const Gemm g, const Sched& S, const Epi& E) {
    const int tid = opaque(threadIdx.x), wid = __builtin_amdgcn_readfirstlane(tid >> 6), lane = tid & 63, wr = wid >> 2, wc = wid & 3, fr = lane & 15, fq = lane >> 4;
    const int nt = g.K / BK;
    unsigned voffA[2], voffB[2];
#pragma unroll
    for (int i = 0; i < 2; ++i) { int R, C; stage_rc(tid * 16 + i * 8192, R, C); const int Rb = (R & ~31) + perm32(R & 31);
        voffA[i] = (unsigned)(R * g.lda + C) * 2u; voffB[i] = (unsigned)(Rb * g.ldb + C) * 2u; }
    const size_t kstep = (size_t)(BK * 2);
    const size_t hstepA = (size_t)HALF * g.lda * 2, hstepB = (size_t)HALF * g.ldb * 2;
    const unsigned ldsw = (unsigned)wid * 1024u;
    const int aoff = lds_byte(wr * 64 + fr, fq * 8), boff = lds_byte(wc * 32 + fr, fq * 8);
#define PG8_SA(b, h) (((b) * 2 + (h)) * HTB)
#define PG8_SB(b, h) ((4 + (b) * 2 + (h)) * HTB)
#define PG8_STAGE(bufoff, gbase, voff) do { _Pragma("unroll") for (int _i = 0; _i < 2; ++_i) \
        __builtin_amdgcn_global_load_lds((const unsigned*)((const char*)(gbase) + (voff)[_i]), (LAS unsigned*)(lds + (bufoff) + ldsw + _i * 8192), 16, 0, 0); } while (0)
#define PG8_LDA(dst, b, h) do { _Pragma("unroll") for (int m = 0; m < 4; ++m) _Pragma("unroll") for (int k = 0; k < 2; ++k) dst[m][k] = *(const LAS bf16x8*)(lds + PG8_SA(b, h) + aoff + m * 2048 + k * 1024); } while (0)
#define PG8_LDB(dst, b, h) do { _Pragma("unroll") for (int n = 0; n < 2; ++n) _Pragma("unroll") for (int k = 0; k < 2; ++k) dst[n][k] = *(const LAS bf16x8*)(lds + PG8_SB(b, h) + boff + n * 2048 + k * 1024); } while (0)
#define PG8_MMA(ai, bj, At, Bt) do { __builtin_amdgcn_s_setprio(1); _Pragma("unroll") for (int m = 0; m < 4; ++m) _Pragma("unroll") for (int n = 0; n < 2; ++n) _Pragma("unroll") for (int k = 0; k < 2; ++k) \
        acc[ai][bj][m][n] = __builtin_amdgcn_mfma_f32_16x16x32_bf16(Bt[n][k], At[m][k], acc[ai][bj][m][n], 0, 0, 0); __builtin_amdgcn_s_setprio(0); } while (0)
#define PG8_WAIT_V(n) asm volatile("s_waitcnt vmcnt(" #n ")" ::: "memory")
#define PG8_WAIT_L(n) asm volatile("s_waitcnt lgkmcnt(" #n ")" ::: "memory")
#define PG8_BAR __builtin_amdgcn_s_barrier()
#define PG8_SCHED __builtin_amdgcn_sched_barrier(0)
    Unit cur, nxt; int ui = 0;
    if (!S.next(0, cur)) return;
#define PG8_RFILL(u_, ui_) do { if (tid < 256) { const f32x4* pp_ = (const f32x4*)(E.part + (size_t)((u_).pm * BM + tid) * 16); \
        const f32x4 a_ = pp_[0], b_ = pp_[1], c_ = pp_[2], d_ = pp_[3]; const f32x4 s_ = (a_ + b_) + (c_ + d_); \
        ((LAS float*)(lds + STAGE_BYTES))[(ui_) * 256 + tid] = rsqrtf(((s_[0] + s_[1]) + (s_[2] + s_[3])) * (1.f / DM) + RMS_EPS); } } while (0)
    if constexpr (Epi::NEEDS_R) {
        Unit uu; for (int i = 0; i < 8 && S.next(i, uu); ++i) PG8_RFILL(uu, i);
    }
    f32x4 acc[2][2][4][2];
#pragma unroll
    for (int a = 0; a < 2; ++a)
#pragma unroll
        for (int b = 0; b < 2; ++b)
#pragma unroll
            for (int m = 0; m < 4; ++m)
#pragma unroll
                for (int n = 0; n < 2; ++n) acc[a][b][m][n] = (f32x4){0.f, 0.f, 0.f, 0.f};
    bf16x8 At[4][2], B0[2][2], B1[2][2];
    const char* cA = (const char*)g.A + (size_t)cur.z * g.zA * 2 + (size_t)cur.pm * 2 * hstepA;
    const char* cB = (const char*)g.Bt + (size_t)cur.z * g.zB * 2 + (size_t)cur.pn * 2 * hstepB;
    PG8_STAGE(PG8_SB(0, 0), cB, voffB); PG8_STAGE(PG8_SB(0, 1), cB + hstepB, voffB); PG8_STAGE(PG8_SA(0, 0), cA, voffA); PG8_STAGE(PG8_SA(0, 1), cA + hstepA, voffA);
    if (wr == 1) PG8_BAR;
    PG8_WAIT_V(2); PG8_BAR;
    PG8_STAGE(PG8_SB(1, 0), cB + kstep, voffB); PG8_STAGE(PG8_SA(1, 0), cA + kstep, voffA); PG8_STAGE(PG8_SB(1, 1), cB + hstepB + kstep, voffB);
    PG8_WAIT_V(6); PG8_BAR;
    for (;;) {
        const bool has_next = S.next(ui + 1, nxt);
        const char* nA = has_next ? (const char*)g.A + (size_t)nxt.z * g.zA * 2 + (size_t)nxt.pm * 2 * hstepA : cA;
        const char* nB = has_next ? (const char*)g.Bt + (size_t)nxt.z * g.zB * 2 + (size_t)nxt.pn * 2 * hstepB : cB;
        for (int t = 0; t < nt; t += 2) {
            const bool last = (t == nt - 2);
            const char* a1 = cA + (size_t)(t + 1) * kstep;
            const char* a2 = last ? nA : cA + (size_t)(t + 2) * kstep; const char* b2 = last ? nB : cB + (size_t)(t + 2) * kstep;
            const char* a3 = a2 + kstep; const char* b3 = b2 + kstep;
            PG8_LDB(B0, 0, 0); PG8_LDB(B1, 0, 1); PG8_SCHED; PG8_LDA(At, 0, 0); PG8_STAGE(PG8_SA(1, 1), a1 + hstepA, voffA);
            PG8_WAIT_V(8); PG8_WAIT_L(0); PG8_BAR; PG8_MMA(0, 0, At, B0); PG8_MMA(0, 1, At, B1); PG8_BAR; PG8_SCHED;
            PG8_LDA(At, 0, 1); PG8_STAGE(PG8_SB(0, 0), b2, voffB); PG8_STAGE(PG8_SB(0, 1), b2 + hstepB, voffB); PG8_STAGE(PG8_SA(0, 0), a2, voffA);
            PG8_WAIT_V(8); PG8_WAIT_L(0); PG8_BAR; PG8_MMA(1, 0, At, B0); PG8_MMA(1, 1, At, B1); PG8_BAR; PG8_SCHED;
            PG8_LDB(B0, 1, 0); PG8_LDB(B1, 1, 1); PG8_SCHED; PG8_LDA(At, 1, 0); PG8_STAGE(PG8_SA(0, 1), a2 + hstepA, voffA);
            PG8_WAIT_V(8); PG8_WAIT_L(0); PG8_BAR; PG8_MMA(0, 0, At, B0); PG8_MMA(0, 1, At, B1); PG8_BAR; PG8_SCHED;
            PG8_LDA(At, 1, 1); PG8_STAGE(PG8_SB(1, 0), b3, voffB); PG8_STAGE(PG8_SB(1, 1), b3 + hstepB, voffB); PG8_STAGE(PG8_SA(1, 0), a3, voffA);
            PG8_WAIT_V(8); PG8_WAIT_L(0); PG8_BAR; PG8_MMA(1, 0, At, B0); PG8_MMA(1, 1, At, B1); PG8_BAR; PG8_SCHED;
        }
        if (wr == 0) PG8_BAR;
        E(acc, cur, wr, wc, fr, fq, (const LAS float*)(lds + STAGE_BYTES) + (ui & 7) * 256);
        if (!has_next) break;
#pragma unroll
        for (int a = 0; a < 2; ++a)
#pragma unroll
            for (int b = 0; b < 2; ++b)
#pragma unroll
                for (int m = 0; m < 4; ++m)
#pragma unroll
                    for (int n = 0; n < 2; ++n) acc[a][b][m][n] = (f32x4){0.f, 0.f, 0.f, 0.f};
        cur = nxt; cA = nA; cB = nB; ++ui;
        if (wr == 1) PG8_BAR;
    }
    PG8_WAIT_V(0);
    PG8_BAR;
#undef PG8_RFILL
#undef PG8_SA
#undef PG8_SB
#undef PG8_STAGE
#undef PG8_LDA
#undef PG8_LDB
#undef PG8_MMA
#undef PG8_WAIT_V
#undef PG8_WAIT_L
#undef PG8_BAR
#undef PG8_SCHED
}

typedef f32x4 AccT[2][2][4][2];

struct EpiInProj {
    static constexpr bool PERM = true, NEEDS_R = true;
    unsigned char* ws; const f32x2_t* rope; const float* part;
    DI void operator()(const AccT& acc, const Unit& u, int wr, int wc, int fr, int fq, const LAS float* rt) const {
        const int colt = u.pn * BM; const int seg = colt >> 9; const int cbase = (colt & 511) + wc * 32 + 8 * fq;
        const size_t off = seg == 1 ? WS_SQ : seg == 2 ? WS_SK : seg == 3 ? WS_SV : seg == 4 ? WS_DQ : seg == 5 ? WS_DK : WS_DV;
        bf16_t* base = (bf16_t*)(ws + off); bf16_t* a2 = (bf16_t*)(ws + WS_A2);
        const bool rot = (seg == 4 || seg == 5) && ((wc & 1) == 0) && (fq < 2);
        const float sc = (seg == 1 || seg == 4) ? 0.18033688011112042f : 1.f;
#pragma unroll
        for (int ai = 0; ai < 2; ++ai) {
            f32x2_t rc[4][4];
            if (rot) {
#pragma unroll
                for (int m = 0; m < 4; ++m) { const f32x2_t* cs = rope + (size_t)(u.pm * BM + ai * HALF + wr * 64 + m * 16 + fr) * 8 + 4 * fq;
#pragma unroll
                    for (int k = 0; k < 4; ++k) rc[m][k] = cs[k]; }
            }
            __builtin_amdgcn_sched_barrier(0);
#pragma unroll
            for (int m = 0; m < 4; ++m) {
                const int row = u.pm * BM + ai * HALF + wr * 64 + m * 16 + fr; const float rr = rt[ai * HALF + wr * 64 + m * 16 + fr] * sc;
#pragma unroll
                for (int bj = 0; bj < 2; ++bj) {
                    const int cs = cbase + bj * HALF; f32x4 v0 = acc[ai][bj][m][0] * rr, v1 = acc[ai][bj][m][1] * rr;
                    if (seg == 0) {
                        const int g = cs >> 4, ci = cs & 15, b = row >> 12, t = row & 4095, c = t >> 5, s = t & 31;
                        st8(a2 + ((size_t)(g * SSM_M2 + b * SSM_NC + c) * SSM_K2 + s * 16 + ci), v0, v1);
                    } else if (rot) {
#pragma unroll
                        for (int k = 0; k < 4; ++k) { const float t1 = v0[k], t2 = v1[k]; v0[k] = t1 * rc[m][k].x - t2 * rc[m][k].y; v1[k] = t2 * rc[m][k].x + t1 * rc[m][k].y; }
                        bf16_t* dp = base + (size_t)row * 512 + (cs - 8 * fq) + 4 * fq;
                        *(unsigned long long*)dp = (unsigned long long)pk2(v0[0], v0[1]) | ((unsigned long long)pk2(v0[2], v0[3]) << 32);
                        *(unsigned long long*)(dp + 8) = (unsigned long long)pk2(v1[0], v1[1]) | ((unsigned long long)pk2(v1[2], v1[3]) << 32);
                    } else {
                        st8(base + (size_t)row * 512 + cs, v0, v1);
                    }
                }
            }
        }
    }
};
struct EpiMemKV {
    static constexpr bool PERM = true, NEEDS_R = false;
    bf16_t* kv;
    DI void operator()(const AccT& acc, const Unit& u, int wr, int wc, int fr, int fq, const LAS float* rt) const {
        const int colt = u.pn * BM; bf16_t* base = kv + (size_t)(u.z * 2 + (colt >> 9)) * 2048 * 512; const int cbase = (colt & 511) + wc * 32 + 8 * fq;
#pragma unroll
        for (int ai = 0; ai < 2; ++ai)
#pragma unroll
            for (int m = 0; m < 4; ++m) { const int row = u.pm * BM + ai * HALF + wr * 64 + m * 16 + fr;
#pragma unroll
                for (int bj = 0; bj < 2; ++bj) st8(base + (size_t)row * 512 + cbase + bj * HALF, acc[ai][bj][m][0], acc[ai][bj][m][1]); }
    }
};
template <int ACT, bool RS> struct EpiBf16 {
    static constexpr bool PERM = true, NEEDS_R = RS;
    bf16_t* O; int ldc; float scale; const float* part;
    DI void operator()(const AccT& acc, const Unit& u, int wr, int wc, int fr, int fq, const LAS float* rt) const {
        const int col0 = u.pn * BM + wc * 32 + 8 * fq;
#pragma unroll
        for (int ai = 0; ai < 2; ++ai)
#pragma unroll
            for (int m = 0; m < 4; ++m) { const int row = u.pm * BM + ai * HALF + wr * 64 + m * 16 + fr; const float rr = RS ? rt[ai * HALF + wr * 64 + m * 16 + fr] * scale : scale;
#pragma unroll
                for (int bj = 0; bj < 2; ++bj) { f32x4 v0 = acc[ai][bj][m][0] * rr, v1 = acc[ai][bj][m][1] * rr;
                    if (ACT == 1) {
#pragma unroll
                        for (int k = 0; k < 4; ++k) { v0[k] = sigmoidf_(v0[k]); v1[k] = sigmoidf_(v1[k]); } }
                    if (ACT == 2) {
#pragma unroll
                        for (int k = 0; k < 4; ++k) { const float a = fmaxf(v0[k], 0.f), b = fmaxf(v1[k], 0.f); v0[k] = a * a; v1[k] = b * b; } }
                    st8(O + (size_t)row * ldc + col0 + bj * HALF, v0, v1); } }
    }
};
struct EpiGlu {
    static constexpr bool PERM = true, NEEDS_R = false;
    bf16_t* O;
    DI void operator()(const AccT& acc, const Unit& u, int wr, int wc, int fr, int fq, const LAS float* rt) const {
        const int col0 = u.pn * HALF + wc * 32 + 8 * fq;
#pragma unroll
        for (int ai = 0; ai < 2; ++ai)
#pragma unroll
            for (int m = 0; m < 4; ++m) { const int row = u.pm * BM + ai * HALF + wr * 64 + m * 16 + fr;
                f32x4 v0, v1;
#pragma unroll
                for (int k = 0; k < 4; ++k) { v0[k] = acc[ai][0][m][0][k] * sigmoidf_(acc[ai][1][m][0][k]); v1[k] = acc[ai][0][m][1][k] * sigmoidf_(acc[ai][1][m][1][k]); }
                st8(O + (size_t)row * 512 + col0, v0, v1); }
    }
};
struct EpiSloc {
    static constexpr bool PERM = true, NEEDS_R = false;
    float* S;
    DI void operator()(const AccT& acc, const Unit& u, int wr, int wc, int fr, int fq, const LAS float* rt) const {
        const int col0 = wc * 32 + 8 * fq;
#pragma unroll
        for (int ai = 0; ai < 2; ++ai)
#pragma unroll
            for (int m = 0; m < 4; ++m) { const int row = u.pm * BM + ai * HALF + wr * 64 + m * 16 + fr;
                float* p = S + ((size_t)(u.z * SSM_M2 + row) * 128 + col0);
                *(f32x4*)p = acc[ai][0][m][0]; *(f32x4*)(p + 4) = acc[ai][0][m][1]; }
    }
};
struct EpiGelu {
    static constexpr bool PERM = true, NEEDS_R = false;
    bf16_t* Y;
    DI void operator()(const AccT& acc, const Unit& u, int wr, int wc, int fr, int fq, const LAS float* rt) const {
        const int col0 = u.pn * BM + wc * 32 + 8 * fq;
#pragma unroll
        for (int ai = 0; ai < 2; ++ai)
#pragma unroll
            for (int m = 0; m < 4; ++m) { const int row = u.pm * BM + ai * HALF + wr * 64 + m * 16 + fr; const int b = row >> 7, c = row & 127;
#pragma unroll
                for (int bj = 0; bj < 2; ++bj) { const int n = col0 + bj * HALF, t = n >> 4, co = n & 15;
                    f32x4 v0 = acc[ai][bj][m][0], v1 = acc[ai][bj][m][1];
#pragma unroll
                    for (int k = 0; k < 4; ++k) { float x = v0[k]; v0[k] = x * __builtin_amdgcn_rcpf(1.f + __builtin_amdgcn_exp2f(x * (-2.3022082f - 0.10294324f * (x * x))));
                        x = v1[k]; v1[k] = x * __builtin_amdgcn_rcpf(1.f + __builtin_amdgcn_exp2f(x * (-2.3022082f - 0.10294324f * (x * x)))); }
                    st8(Y + ((size_t)(b * SEQ + c * SSM_T + t) * 512 + u.z * 16 + co), v0, v1); } }
    }
};
struct EpiMerge {
    static constexpr bool PERM = true, NEEDS_R = false;
    const bf16_t* gates; bf16_t* O;
    DI void operator()(const AccT& acc, const Unit& u, int wr, int wc, int fr, int fq, const LAS float* rt) const {
        const int col0 = u.pn * BM + wc * 32 + 8 * fq;
#pragma unroll
        for (int ai = 0; ai < 2; ++ai) {
            u32x4 gw[4][2], pw[4][2];
#pragma unroll
            for (int m = 0; m < 4; ++m) { const int row = u.pm * BM + ai * HALF + wr * 64 + m * 16 + fr;
#pragma unroll
                for (int bj = 0; bj < 2; ++bj) { const int col = col0 + bj * HALF;
                    gw[m][bj] = *(const u32x4*)(gates + (size_t)row * 3072 + u.z * 1024 + col);
                    if (u.z > 0) pw[m][bj] = *(const u32x4*)(O + (size_t)row * 1024 + col); else pw[m][bj] = (u32x4){0u, 0u, 0u, 0u}; } }
            __builtin_amdgcn_sched_barrier(0);
#pragma unroll
            for (int m = 0; m < 4; ++m) { const int row = u.pm * BM + ai * HALF + wr * 64 + m * 16 + fr;
#pragma unroll
                for (int bj = 0; bj < 2; ++bj) { const int col = col0 + bj * HALF; const u32x4 g4 = gw[m][bj], p4 = pw[m][bj];
                    f32x4 v0 = acc[ai][bj][m][0], v1 = acc[ai][bj][m][1];
                    v0[0] = v0[0] * bf2f(g4.x & 0xffffu) + bf2f(p4.x & 0xffffu); v0[1] = v0[1] * bf2f(g4.x >> 16) + bf2f(p4.x >> 16);
                    v0[2] = v0[2] * bf2f(g4.y & 0xffffu) + bf2f(p4.y & 0xffffu); v0[3] = v0[3] * bf2f(g4.y >> 16) + bf2f(p4.y >> 16);
                    v1[0] = v1[0] * bf2f(g4.z & 0xffffu) + bf2f(p4.z & 0xffffu); v1[1] = v1[1] * bf2f(g4.z >> 16) + bf2f(p4.z >> 16);
                    v1[2] = v1[2] * bf2f(g4.w & 0xffffu) + bf2f(p4.w & 0xffffu); v1[3] = v1[3] * bf2f(g4.w >> 16) + bf2f(p4.w >> 16);
                    st8(O + (size_t)row * 1024 + col, v0, v1); } }
        }
    }
};
struct EpiResid {
    static constexpr bool PERM = true, NEEDS_R = false;
    const float* base; float* out; bf16_t* hb; const float* gain; float* part;
    DI void operator()(const AccT& acc, const Unit& u, int wr, int wc, int fr, int fq, const LAS float* rt) const {
        const int col0 = u.pn * BM + wc * 32 + 8 * fq;
        f32x4 gv[2][2];
#pragma unroll
        for (int bj = 0; bj < 2; ++bj) { gv[bj][0] = *(const f32x4*)(gain + col0 + bj * HALF); gv[bj][1] = *(const f32x4*)(gain + col0 + bj * HALF + 4); }
#pragma unroll
        for (int ai = 0; ai < 2; ++ai)
#pragma unroll
            for (int mh = 0; mh < 2; ++mh) {
                f32x4 bx[2][2][2];
#pragma unroll
                for (int mm = 0; mm < 2; ++mm) { const int row = u.pm * BM + ai * HALF + wr * 64 + (mh * 2 + mm) * 16 + fr;
#pragma unroll
                    for (int bj = 0; bj < 2; ++bj) { const size_t o = (size_t)row * DM + col0 + bj * HALF; bx[mm][bj][0] = *(const f32x4*)(base + o); bx[mm][bj][1] = *(const f32x4*)(base + o + 4); } }
                __builtin_amdgcn_sched_barrier(0);
#pragma unroll
                for (int mm = 0; mm < 2; ++mm) { const int m = mh * 2 + mm; const int row = u.pm * BM + ai * HALF + wr * 64 + m * 16 + fr; float ss = 0.f;
#pragma unroll
                    for (int bj = 0; bj < 2; ++bj) { const size_t o = (size_t)row * DM + col0 + bj * HALF;
                        const f32x4 x0 = bx[mm][bj][0] + acc[ai][bj][m][0], x1 = bx[mm][bj][1] + acc[ai][bj][m][1];
                        *(f32x4*)(out + o) = x0; *(f32x4*)(out + o + 4) = x1;
                        ss += (x0[0] * x0[0] + x0[1] * x0[1]) + (x0[2] * x0[2] + x0[3] * x0[3]) + (x1[0] * x1[0] + x1[1] * x1[1]) + (x1[2] * x1[2] + x1[3] * x1[3]);
                        st8(hb + o, x0 * gv[bj][0], x1 * gv[bj][1]); }
                    ss += __shfl_xor(ss, 16); ss += __shfl_xor(ss, 32);
                    if (fq == 0) part[(size_t)row * 16 + u.pn * 4 + wc] = ss; }
            }
    }
};

struct GmArgs { const bf16_t* Ah; const bf16_t* Wg; const bf16_t* Y; long zY; const bf16_t* Wb; bf16_t* gs; bf16_t* O; const float* part; };
DI void gm_unit_info(const GmArgs& a, const Unit& u, const char*& cA, const char*& cB, int& ld, int& nt) {
    const int z = u.z >> 1;
    if (u.z & 1) { ld = 512; nt = 8; cA = (const char*)(a.Y + (size_t)z * a.zY) + (size_t)u.pm * 256 * 512 * 2; cB = (const char*)a.Wb + ((size_t)z * 1024 + u.pn * 256) * 512 * 2; }
    else { ld = 1024; nt = 16; cA = (const char*)a.Ah + (size_t)u.pm * 256 * 1024 * 2; cB = (const char*)a.Wg + ((size_t)z * 1024 + u.pn * 256) * 1024 * 2; }
}
DI void gm_epilogue(const GmArgs& a, const AccT& acc, const Unit& u, int wr, int wc, int fr, int fq, const LAS float* rt) {
    const int z = u.z >> 1; const int colL = wc * 32 + 8 * fq;
    bf16_t* gsb = a.gs + (size_t)blockIdx.x * 65536;
    if (!(u.z & 1)) {
#pragma unroll
        for (int ai = 0; ai < 2; ++ai)
#pragma unroll
            for (int m = 0; m < 4; ++m) { const int rl = ai * HALF + wr * 64 + m * 16 + fr; const float rrn = rt[rl] * -1.4426950408889634f;
#pragma unroll
                for (int bj = 0; bj < 2; ++bj) { f32x4 v0 = acc[ai][bj][m][0] * rrn, v1 = acc[ai][bj][m][1] * rrn;
#pragma unroll
                    for (int k = 0; k < 4; ++k) { v0[k] = __builtin_amdgcn_rcpf(1.f + __builtin_amdgcn_exp2f(v0[k])); v1[k] = __builtin_amdgcn_rcpf(1.f + __builtin_amdgcn_exp2f(v1[k])); }
                    st8(gsb + rl * 256 + colL + bj * HALF, v0, v1); } }
    } else {
#pragma unroll
        for (int ai = 0; ai < 2; ++ai) {
            u32x4 gw[4][2], pw[4][2];
#pragma unroll
            for (int m = 0; m < 4; ++m) { const int rl = ai * HALF + wr * 64 + m * 16 + fr; const int row = u.pm * BM + rl;
#pragma unroll
                for (int bj = 0; bj < 2; ++bj) { const int col = u.pn * BM + colL + bj * HALF;
                    gw[m][bj] = *(const u32x4*)(gsb + rl * 256 + colL + bj * HALF);
                    if (z > 0) pw[m][bj] = *(const u32x4*)(a.O + (size_t)row * 1024 + col); else pw[m][bj] = (u32x4){0u, 0u, 0u, 0u}; } }
            __builtin_amdgcn_sched_barrier(0);
#pragma unroll
            for (int m = 0; m < 4; ++m) { const int rl = ai * HALF + wr * 64 + m * 16 + fr; const int row = u.pm * BM + rl;
#pragma unroll
                for (int bj = 0; bj < 2; ++bj) { const int col = u.pn * BM + colL + bj * HALF; const u32x4 g4 = gw[m][bj], p4 = pw[m][bj];
                    f32x4 v0 = acc[ai][bj][m][0], v1 = acc[ai][bj][m][1];
                    v0[0] = v0[0] * bf2f(g4.x & 0xffffu) + bf2f(p4.x & 0xffffu); v0[1] = v0[1] * bf2f(g4.x >> 16) + bf2f(p4.x >> 16);
                    v0[2] = v0[2] * bf2f(g4.y & 0xffffu) + bf2f(p4.y & 0xffffu); v0[3] = v0[3] * bf2f(g4.y >> 16) + bf2f(p4.y >> 16);
                    v1[0] = v1[0] * bf2f(g4.z & 0xffffu) + bf2f(p4.z & 0xffffu); v1[1] = v1[1] * bf2f(g4.z >> 16) + bf2f(p4.z >> 16);
                    v1[2] = v1[2] * bf2f(g4.w & 0xffffu) + bf2f(p4.w & 0xffffu); v1[3] = v1[3] * bf2f(g4.w >> 16) + bf2f(p4.w >> 16);
                    st8(a.O + (size_t)row * 1024 + col, v0, v1); } }
        }
    }
}
struct SchedGM {
    int nM, nN, G, c;
    DI bool next(int i, Unit& u) const { const long L = (long)(i / 6) * G + c; if (L >= (long)nM * nN) return false; tile_decode((int)L, nM, nN, u.pm, u.pn); u.z = i % 6; return true; }
};
DI void gemm_phase_gm(LAS unsigned char* lds, const GmArgs ga, const SchedGM& S) {
    const int tid = opaque(threadIdx.x), wid = __builtin_amdgcn_readfirstlane(tid >> 6), lane = tid & 63, wr = wid >> 2, wc = wid & 3, fr = lane & 15, fq = lane >> 4;
    unsigned RA2, RB2, C2;
    { int R, C; stage_rc(tid * 16, R, C); const int Rb = (R & ~31) + perm32(R & 31); RA2 = (unsigned)R * 2u; RB2 = (unsigned)Rb * 2u; C2 = (unsigned)C * 2u; }
    const size_t kstep = (size_t)(BK * 2);
    const unsigned ldsw = (unsigned)wid * 1024u;
    const int aoff = lds_byte(wr * 64 + fr, fq * 8), boff = lds_byte(wc * 32 + fr, fq * 8);
#define PG8_SA(b, h) (((b) * 2 + (h)) * HTB)
#define PG8_SB(b, h) ((4 + (b) * 2 + (h)) * HTB)
#define GM_STAGE(bufoff, gbase, R2, ld_) do { _Pragma("unroll") for (int _i = 0; _i < 2; ++_i) \
        __builtin_amdgcn_global_load_lds((const unsigned*)((const char*)(gbase) + (size_t)_i * 128 * (size_t)(ld_) + ((R2) * (unsigned)(ld_) + C2)), (LAS unsigned*)(lds + (bufoff) + ldsw + _i * 8192), 16, 0, 0); } while (0)
#define PG8_LDA(dst, b, h) do { _Pragma("unroll") for (int m = 0; m < 4; ++m) _Pragma("unroll") for (int k = 0; k < 2; ++k) dst[m][k] = *(const LAS bf16x8*)(lds + PG8_SA(b, h) + aoff + m * 2048 + k * 1024); } while (0)
#define PG8_LDB(dst, b, h) do { _Pragma("unroll") for (int n = 0; n < 2; ++n) _Pragma("unroll") for (int k = 0; k < 2; ++k) dst[n][k] = *(const LAS bf16x8*)(lds + PG8_SB(b, h) + boff + n * 2048 + k * 1024); } while (0)
#define PG8_MMA(ai, bj, At, Bt) do { __builtin_amdgcn_s_setprio(1); _Pragma("unroll") for (int m = 0; m < 4; ++m) _Pragma("unroll") for (int n = 0; n < 2; ++n) _Pragma("unroll") for (int k = 0; k < 2; ++k) \
        acc[ai][bj][m][n] = __builtin_amdgcn_mfma_f32_16x16x32_bf16(Bt[n][k], At[m][k], acc[ai][bj][m][n], 0, 0, 0); __builtin_amdgcn_s_setprio(0); } while (0)
#define PG8_WAIT_V(n) asm volatile("s_waitcnt vmcnt(" #n ")" ::: "memory")
#define PG8_WAIT_L(n) asm volatile("s_waitcnt lgkmcnt(" #n ")" ::: "memory")
#define PG8_BAR __builtin_amdgcn_s_barrier()
#define PG8_SCHED __builtin_amdgcn_sched_barrier(0)
#define GM_RFILL(u_, ui_) do { if (tid < 256) { const f32x4* pp_ = (const f32x4*)(ga.part + (size_t)((u_).pm * BM + tid) * 16); \
        const f32x4 a_ = pp_[0], b_ = pp_[1], c_ = pp_[2], d_ = pp_[3]; const f32x4 s_ = (a_ + b_) + (c_ + d_); \
        ((LAS float*)(lds + STAGE_BYTES))[(ui_) * 256 + tid] = rsqrtf(((s_[0] + s_[1]) + (s_[2] + s_[3])) * (1.f / DM) + RMS_EPS); } } while (0)
    Unit cur, nxt; int ui = 0;
    if (!S.next(0, cur)) return;
    { Unit uu; for (int i = 0; i < 8 && S.next(6 * i, uu); ++i) GM_RFILL(uu, i); }
    f32x4 acc[2][2][4][2];
#pragma unroll
    for (int a = 0; a < 2; ++a)
#pragma unroll
        for (int b = 0; b < 2; ++b)
#pragma unroll
            for (int m = 0; m < 4; ++m)
#pragma unroll
                for (int n = 0; n < 2; ++n) acc[a][b][m][n] = (f32x4){0.f, 0.f, 0.f, 0.f};
    bf16x8 At[4][2], B0[2][2], B1[2][2];
    const char* cA; const char* cB; int ldc_, nt;
    gm_unit_info(ga, cur, cA, cB, ldc_, nt);
    size_t hsc = (size_t)HALF * ldc_ * 2;
    GM_STAGE(PG8_SB(0, 0), cB, RB2, ldc_); GM_STAGE(PG8_SB(0, 1), cB + hsc, RB2, ldc_); GM_STAGE(PG8_SA(0, 0), cA, RA2, ldc_); GM_STAGE(PG8_SA(0, 1), cA + hsc, RA2, ldc_);
    if (wr == 1) PG8_BAR;
    PG8_WAIT_V(2); PG8_BAR;
    GM_STAGE(PG8_SB(1, 0), cB + kstep, RB2, ldc_); GM_STAGE(PG8_SA(1, 0), cA + kstep, RA2, ldc_); GM_STAGE(PG8_SB(1, 1), cB + hsc + kstep, RB2, ldc_);
    PG8_WAIT_V(6); PG8_BAR;
    for (;;) {
        const bool has_next = S.next(ui + 1, nxt);
        const char* nA = cA; const char* nB = cB; int ldn = ldc_, ntn = nt;
        if (has_next) gm_unit_info(ga, nxt, nA, nB, ldn, ntn);
        const size_t hsn = (size_t)HALF * ldn * 2;
        for (int t = 0; t < nt; t += 2) {
            const bool last = (t == nt - 2);
            const char* a1 = cA + (size_t)(t + 1) * kstep;
            const char* a2 = last ? nA : cA + (size_t)(t + 2) * kstep; const char* b2 = last ? nB : cB + (size_t)(t + 2) * kstep;
            const char* a3 = a2 + kstep; const char* b3 = b2 + kstep;
            const int ld2 = last ? ldn : ldc_; const size_t hs2 = last ? hsn : hsc;
            PG8_LDB(B0, 0, 0); PG8_LDB(B1, 0, 1); PG8_SCHED; PG8_LDA(At, 0, 0); GM_STAGE(PG8_SA(1, 1), a1 + hsc, RA2, ldc_);
            PG8_WAIT_V(8); PG8_WAIT_L(0); PG8_BAR; PG8_MMA(0, 0, At, B0); PG8_MMA(0, 1, At, B1); PG8_BAR; PG8_SCHED;
            PG8_LDA(At, 0, 1); GM_STAGE(PG8_SB(0, 0), b2, RB2, ld2); GM_STAGE(PG8_SB(0, 1), b2 + hs2, RB2, ld2); GM_STAGE(PG8_SA(0, 0), a2, RA2, ld2);
            PG8_WAIT_V(8); PG8_WAIT_L(0); PG8_BAR; PG8_MMA(1, 0, At, B0); PG8_MMA(1, 1, At, B1); PG8_BAR; PG8_SCHED;
            PG8_LDB(B0, 1, 0); PG8_LDB(B1, 1, 1); PG8_SCHED; PG8_LDA(At, 1, 0); GM_STAGE(PG8_SA(0, 1), a2 + hs2, RA2, ld2);
            PG8_WAIT_V(8); PG8_WAIT_L(0); PG8_BAR; PG8_MMA(0, 0, At, B0); PG8_MMA(0, 1, At, B1); PG8_BAR; PG8_SCHED;
            PG8_LDA(At, 1, 1); GM_STAGE(PG8_SB(1, 0), b3, RB2, ld2); GM_STAGE(PG8_SB(1, 1), b3 + hs2, RB2, ld2); GM_STAGE(PG8_SA(1, 0), a3, RA2, ld2);
            PG8_WAIT_V(8); PG8_WAIT_L(0); PG8_BAR; PG8_MMA(1, 0, At, B0); PG8_MMA(1, 1, At, B1); PG8_BAR; PG8_SCHED;
        }
        if (wr == 0) PG8_BAR;
        gm_epilogue(ga, acc, cur, wr, wc, fr, fq, (const LAS float*)(lds + STAGE_BYTES) + ((ui / 6) & 7) * 256);
        if (!has_next) break;
#pragma unroll
        for (int a = 0; a < 2; ++a)
#pragma unroll
            for (int b = 0; b < 2; ++b)
#pragma unroll
                for (int m = 0; m < 4; ++m)
#pragma unroll
                    for (int n = 0; n < 2; ++n) acc[a][b][m][n] = (f32x4){0.f, 0.f, 0.f, 0.f};
        cur = nxt; cA = nA; cB = nB; ldc_ = ldn; nt = ntn; hsc = hsn; ++ui;
        if (wr == 1) PG8_BAR;
    }
    PG8_WAIT_V(0);
    PG8_BAR;
#undef GM_RFILL
#undef GM_STAGE
#undef PG8_SA
#undef PG8_SB
#undef PG8_LDA
#undef PG8_LDB
#undef PG8_MMA
#undef PG8_WAIT_V
#undef PG8_WAIT_L
#undef PG8_BAR
#undef PG8_SCHED
}
}

DI f32x16 mfma32(bf16x8 a, bf16x8 b, f32x16 c) { return __builtin_amdgcn_mfma_f32_32x32x16_bf16(a, b, c, 0, 0, 0); }
DI s16x4 vtr(const LAS unsigned char* p) { return __builtin_bit_cast(s16x4, __builtin_amdgcn_ds_read_tr16_b64_v4i16((LAS v4i16_t*)p)); }
DI int crow(int r, int hi) { return (r & 3) + 8 * (r >> 2) + 4 * hi; }
DI bf16x8 pack8(const float* w) { u32x4 p; p.x = pk2(w[0], w[1]); p.y = pk2(w[2], w[3]); p.z = pk2(w[4], w[5]); p.w = pk2(w[6], w[7]); return __builtin_bit_cast(bf16x8, p); }

template <bool MASK>
DI void sb_block(const f32x16& p, int kvbase, int qrow, int hi, float& carry, bf16x8& f0, bf16x8& f1) {
    float bt[16], om[16];
#pragma unroll
    for (int i = 0; i < 16; ++i) { const float e = __builtin_amdgcn_exp2f(-p[i]); float b = __builtin_amdgcn_rcpf(1.f + e); float o = 1.f - b;
        if (MASK) { const bool valid = (kvbase + crow(i, hi) < qrow); b = valid ? b : 0.f; o = valid ? o : 1.f; }
        bt[i] = b; om[i] = o; }
    float plo[4], phi[4];
#pragma unroll
    for (int g = 0; g < 4; ++g) { const float gp = (om[4 * g] * om[4 * g + 1]) * (om[4 * g + 2] * om[4 * g + 3]);
        auto rr = __builtin_amdgcn_permlane32_swap(__float_as_uint(gp), __float_as_uint(gp), false, false);
        plo[g] = __uint_as_float(rr[0]); phi[g] = __uint_as_float(rr[1]); }
    float T[4]; T[3] = 1.f; T[2] = plo[3] * phi[3]; T[1] = T[2] * (plo[2] * phi[2]); T[0] = T[1] * (plo[1] * phi[1]);
    const float tot = T[0] * (plo[0] * phi[0]);
    float w[16];
#pragma unroll
    for (int g = 0; g < 4; ++g) { const float w3 = carry * T[g] * (hi ? 1.f : phi[g]);
        const float w2 = w3 * om[4 * g + 3], w1 = w2 * om[4 * g + 2], w0 = w1 * om[4 * g + 1];
        w[4 * g + 3] = bt[4 * g + 3] * w3; w[4 * g + 2] = bt[4 * g + 2] * w2; w[4 * g + 1] = bt[4 * g + 1] * w1; w[4 * g] = bt[4 * g] * w0; }
    carry *= tot;
    f0 = pack8(w); f1 = pack8(w + 8);
}

constexpr int SB_KP = 144, SB_VP = 192, SB_FLAGS = 2 * 64 * SB_KP + 2 * 64 * SB_VP;
DI void sb_unit(int b, int h, int qb, const bf16_t* QO, bf16_t* Ob, const bf16_t* K, const bf16_t* V, LAS unsigned char* lds) {
    const int tid = opaque(threadIdx.x), lane = tid & 63, wid = __builtin_amdgcn_readfirstlane(tid >> 6), r32 = lane & 31, hi = lane >> 5;
    const size_t rowbase = (size_t)b * SEQ;
    const int q0w = qb * 256 + wid * 32, qrow = q0w + r32;
    const bf16_t* qp = QO + (rowbase + qrow) * 512 + h * 64;
    bf16x8 qf[4];
#pragma unroll
    for (int ks = 0; ks < 4; ++ks) qf[ks] = *(const bf16x8*)(qp + ks * 16 + hi * 8);
    const int nt = 4 * qb + 4;
    const int lrow = tid >> 3, lch = tid & 7;
    const bf16_t* kg = K + (rowbase + lrow) * 512 + h * 64 + lch * 8;
    const bf16_t* vg = V + (rowbase + lrow) * 512 + h * 64 + lch * 8;
    LAS unsigned char* Kb = lds; LAS unsigned char* Vb = lds + 2 * 64 * SB_KP;
    LAS unsigned char* flags = lds + SB_FLAGS;
    const int kst = lrow * SB_KP + lch * 16, vst = lrow * SB_VP + lch * 16;
    u32x4 kr = *(const u32x4*)(kg + (size_t)(nt - 1) * 64 * 512), vr = *(const u32x4*)(vg + (size_t)(nt - 1) * 64 * 512);
    *(LAS u32x4*)(Kb + kst) = kr; *(LAS u32x4*)(Vb + vst) = vr;
    __syncthreads();
    f32x16 o0, o1;
#pragma unroll
    for (int i = 0; i < 16; ++i) { o0[i] = 0.f; o1[i] = 0.f; }
    float carry = 1.f; int cur = 0;
    const int vlane = (4 * hi + ((lane & 15) >> 2)) * SB_VP + (16 * ((lane >> 4) & 1) + 4 * (lane & 3)) * 2;
    for (int t = nt - 1; t >= 0; --t) {
        if (t > 0) { kr = *(const u32x4*)(kg + (size_t)(t - 1) * 64 * 512); vr = *(const u32x4*)(vg + (size_t)(t - 1) * 64 * 512); }
        const LAS unsigned char* Kc = Kb + cur * 64 * SB_KP; const LAS unsigned char* Vc = Vb + cur * 64 * SB_VP;
        const bool wdone = !__any(carry >= 1e-30f);
        if (64 * t < q0w + 31 && !wdone) {
            f32x16 p0, p1;
#pragma unroll
            for (int i = 0; i < 16; ++i) { p0[i] = 0.f; p1[i] = 0.f; }
            { bf16x8 a0[4], a1[4];
#pragma unroll
              for (int ks = 0; ks < 4; ++ks) { a0[ks] = *(const LAS bf16x8*)(Kc + r32 * SB_KP + (ks * 16 + hi * 8) * 2); a1[ks] = *(const LAS bf16x8*)(Kc + (32 + r32) * SB_KP + (ks * 16 + hi * 8) * 2); }
              __builtin_amdgcn_sched_barrier(0);
#pragma unroll
              for (int ks = 0; ks < 4; ++ks) { p0 = mfma32(a0[ks], qf[ks], p0); p1 = mfma32(a1[ks], qf[ks], p1); } }
            s16x4 vlo[8], vhh[8];
#pragma unroll
            for (int kk = 0; kk < 4; ++kk) { const LAS unsigned char* vp = Vc + vlane + 16 * kk * SB_VP;
                vlo[2 * kk] = vtr(vp); vhh[2 * kk] = vtr(vp + 8 * SB_VP); vlo[2 * kk + 1] = vtr(vp + 64); vhh[2 * kk + 1] = vtr(vp + 64 + 8 * SB_VP); }
            __builtin_amdgcn_sched_barrier(0);
            bf16x8 fr[4];
            if (64 * t + 63 >= q0w) { sb_block<true>(p1, 64 * t + 32, qrow, hi, carry, fr[2], fr[3]); sb_block<true>(p0, 64 * t, qrow, hi, carry, fr[0], fr[1]); }
            else { sb_block<false>(p1, 64 * t + 32, qrow, hi, carry, fr[2], fr[3]); sb_block<false>(p0, 64 * t, qrow, hi, carry, fr[0], fr[1]); }
            __builtin_amdgcn_sched_barrier(0);
#pragma unroll
            for (int kk = 0; kk < 4; ++kk) {
                { const bf16x8 vb = __builtin_shufflevector(vlo[2 * kk], vhh[2 * kk], 0, 1, 2, 3, 4, 5, 6, 7); o0 = mfma32(fr[kk], vb, o0); }
                { const bf16x8 vb = __builtin_shufflevector(vlo[2 * kk + 1], vhh[2 * kk + 1], 0, 1, 2, 3, 4, 5, 6, 7); o1 = mfma32(fr[kk], vb, o1); }
            }
        }
        if (lane == 0) flags[(t & 1) * 8 + wid] = __any(carry >= 1e-30f) ? 0 : 1;
        if (t > 0) { *(LAS u32x4*)(Kb + (cur ^ 1) * 64 * SB_KP + kst) = kr; *(LAS u32x4*)(Vb + (cur ^ 1) * 64 * SB_VP + vst) = vr; }
        __syncthreads(); cur ^= 1;
        const unsigned long long fl = *(const LAS unsigned long long*)(flags + (t & 1) * 8);
        if (fl == 0x0101010101010101ull) break;
    }
    bf16_t* ob = Ob + (rowbase + q0w) * 512 + h * 64 + r32;
#pragma unroll
    for (int i = 0; i < 16; ++i) { const int r = crow(i, hi); ob[(size_t)r * 512] = f2bf(o0[i]); ob[(size_t)r * 512 + 32] = f2bf(o1[i]); }
}

constexpr int A2_KP = 272, A2_VP = 320, A2_WS = 2 * 64 * A2_KP + 2 * 64 * A2_VP;
DI void bcast_rows(LAS float* wsf, float v, int r32, int hi, float (&out)[16]) {
    if (hi == 0) wsf[r32] = v;
    asm volatile("s_waitcnt lgkmcnt(0)" ::: "memory");
#pragma unroll
    for (int i = 0; i < 16; ++i) out[i] = wsf[crow(i, hi)];
    asm volatile("s_waitcnt lgkmcnt(0)" ::: "memory");
}
DI float half_swap_max(float m) { auto rr = __builtin_amdgcn_permlane32_swap(__float_as_uint(m), __float_as_uint(m), false, false); return fmaxf(__uint_as_float(rr[0]), __uint_as_float(rr[1])); }
DI float half_swap_sum(float m) { auto rr = __builtin_amdgcn_permlane32_swap(__float_as_uint(m), __float_as_uint(m), false, false); return __uint_as_float(rr[0]) + __uint_as_float(rr[1]); }

template <bool DIFF>
DI void attn2_unit(int qb, const bf16_t* QO  , bf16_t* Ob, const bf16_t* K, const bf16_t* V  ,
                   int ntile, float lam, const float* gain, float post, LAS unsigned char* lds) {
    const int tid = opaque(threadIdx.x), lane = tid & 63, wid = __builtin_amdgcn_readfirstlane(tid >> 6), r32 = lane & 31, hi = lane >> 5;
    const int q0w = qb * 256 + wid * 32, qrow = q0w + r32;
    const bf16_t* qp = QO + (size_t)qrow * 512;
    LAS unsigned char* qst = lds + A2_WS + 2048 + wid * 8192 + lane * 16;
#pragma unroll
    for (int ks = 0; ks < 8; ++ks) *(LAS bf16x8*)(qst + ks * 1024) = *(const bf16x8*)(qp + ks * 16 + hi * 8);
    const int lrow = tid >> 3, lch = tid & 7;
    const bf16_t* kg = K + (size_t)lrow * 512 + lch * 16;
    const bf16_t* vg = V + (size_t)lrow * 512 + lch * 16;
    LAS unsigned char* Kb = lds; LAS unsigned char* Vb = lds + 2 * 64 * A2_KP;
    LAS float* wsf = (LAS float*)(lds + A2_WS) + wid * 64;
    const int kst = lrow * A2_KP + lch * 32, vst = lrow * A2_VP + lch * 32;
    const int vlane = (4 * hi + ((lane & 15) >> 2)) * A2_VP + (16 * ((lane >> 4) & 1) + 4 * (lane & 3)) * 2;
    constexpr int NC = DIFF ? 2 : 1;
    float mref[2] = {-1e30f, -1e30f}, ls[2] = {0.f, 0.f};
    bool ref0[2] = {false, false}, inited[2] = {false, false};
    f32x16 o1[4], o2[4];
#pragma unroll
    for (int d = 0; d < 4; ++d)
#pragma unroll
        for (int i = 0; i < 16; ++i) { o1[d][i] = 0.f; o2[d][i] = 0.f; }
    u32x4 kr0 = *(const u32x4*)(kg), kr1 = *(const u32x4*)(kg + 8), vr0 = *(const u32x4*)(vg), vr1 = *(const u32x4*)(vg + 8);
    *(LAS u32x4*)(Kb + kst) = kr0; *(LAS u32x4*)(Kb + kst + 16) = kr1; *(LAS u32x4*)(Vb + vst) = vr0; *(LAS u32x4*)(Vb + vst + 16) = vr1;
    __syncthreads();
    int cur = 0;
    for (int t = 0; t < ntile; ++t) {
        const bool more = (t + 1 < ntile);
        if (more) { const size_t go = (size_t)(t + 1) * 64 * 512; kr0 = *(const u32x4*)(kg + go); kr1 = *(const u32x4*)(kg + go + 8); vr0 = *(const u32x4*)(vg + go); vr1 = *(const u32x4*)(vg + go + 8); }
        const LAS unsigned char* Kc = Kb + cur * 64 * A2_KP; const LAS unsigned char* Vc = Vb + cur * 64 * A2_VP;
#pragma unroll
        for (int blk = 0; blk < 2; ++blk) {
            const int kv0 = 64 * t + 32 * blk;
            if (DIFF && kv0 > q0w + 31) continue;
            const bool diag = DIFF && (kv0 + 31 > q0w);
#pragma unroll
            for (int c = 0; c < NC; ++c) {
                f32x16 p;
#pragma unroll
                for (int i = 0; i < 16; ++i) p[i] = 0.f;
                constexpr int KS = DIFF ? 4 : 8;
                {
                    bf16x8 ka[KS], qa[KS];
#pragma unroll
                    for (int ks = 0; ks < KS; ++ks) { const int kk = c * 4 + ks;
                        ka[ks] = *(const LAS bf16x8*)(Kc + (32 * blk + r32) * A2_KP + (kk * 16 + hi * 8) * 2);
                        qa[ks] = *(const LAS bf16x8*)(qst + kk * 1024); }
                    __builtin_amdgcn_sched_barrier(0);
#pragma unroll
                    for (int ks = 0; ks < KS; ++ks) p = mfma32(ka[ks], qa[ks], p);
                }
                s16x4 vlo[8], vhh[8];
                { const LAS unsigned char* vp = Vc + vlane + 16 * (2 * blk) * A2_VP;
#pragma unroll
                    for (int d0 = 0; d0 < 4; ++d0) { vlo[d0] = vtr(vp + d0 * 64); vhh[d0] = vtr(vp + d0 * 64 + 8 * A2_VP); } }
                __builtin_amdgcn_sched_barrier(0);
                if (diag) {
#pragma unroll
                    for (int i = 0; i < 16; ++i) { if (kv0 + crow(i, hi) > qrow) p[i] = -1e30f; }
                }
                float mm = mref[c]; float w[16]; float sm = 0.f;
                if (ref0[c]) {
#pragma unroll
                    for (int i = 0; i < 16; ++i) { w[i] = __builtin_amdgcn_exp2f(p[i]); sm += w[i]; }
                } else {
#pragma unroll
                    for (int i = 0; i < 16; ++i) { w[i] = __builtin_amdgcn_exp2f(p[i] - mm); sm += w[i]; }
                }
                if (__any(!(sm <= (ref0[c] ? 1.0e30f : 256.f)))) {
                    float tm = fmaxf(p[0], p[1]);
#pragma unroll
                    for (int i = 2; i < 16; i += 2) tm = fmaxf(fmaxf(tm, p[i]), p[i + 1]);
                    tm = half_swap_max(tm);
                    if (!inited[c] && !__any(!(fabsf(tm) <= 40.f))) {
                        mref[c] = 0.f; mm = 0.f; ref0[c] = true;
                    } else {
                        const float mn = fmaxf(mref[c], tm); const float f = __builtin_amdgcn_exp2f(mref[c] - mn); ls[c] *= f; mref[c] = mn; mm = mn; ref0[c] = false;
                        float f16[16]; bcast_rows(wsf, f, r32, hi, f16);
                        if (c == 0) {
#pragma unroll
                            for (int d = 0; d < 4; ++d)
#pragma unroll
                                for (int i = 0; i < 16; ++i) o1[d][i] *= f16[i];
                        } else {
#pragma unroll
                            for (int d = 0; d < 4; ++d)
#pragma unroll
                                for (int i = 0; i < 16; ++i) o2[d][i] *= f16[i];
                        }
                    }
                    inited[c] = true;
                    sm = 0.f;
#pragma unroll
                    for (int i = 0; i < 16; ++i) { w[i] = __builtin_amdgcn_exp2f(p[i] - mm); sm += w[i]; }
                }
                ls[c] += sm;
                const bf16x8 fr0 = pack8(w), fr1 = pack8(w + 8);
                __builtin_amdgcn_sched_barrier(0);
                { const LAS unsigned char* vp = Vc + vlane + 16 * (2 * blk + 1) * A2_VP;
#pragma unroll
                    for (int d0 = 0; d0 < 4; ++d0) { vlo[4 + d0] = vtr(vp + d0 * 64); vhh[4 + d0] = vtr(vp + d0 * 64 + 8 * A2_VP); } }
                __builtin_amdgcn_sched_barrier(0);
#pragma unroll
                for (int s2 = 0; s2 < 2; ++s2) {
#pragma unroll
                    for (int d0 = 0; d0 < 4; ++d0) { const bf16x8 vb = __builtin_shufflevector(vlo[s2 * 4 + d0], vhh[s2 * 4 + d0], 0, 1, 2, 3, 4, 5, 6, 7);
                        if (c == 0) o1[d0] = mfma32(s2 ? fr1 : fr0, vb, o1[d0]); else o2[d0] = mfma32(s2 ? fr1 : fr0, vb, o2[d0]); }
                }
            }
        }
        if (more) { LAS unsigned char* kd = Kb + (cur ^ 1) * 64 * A2_KP + kst; *(LAS u32x4*)kd = kr0; *(LAS u32x4*)(kd + 16) = kr1;
            LAS unsigned char* vd = Vb + (cur ^ 1) * 64 * A2_VP + vst; *(LAS u32x4*)vd = vr0; *(LAS u32x4*)(vd + 16) = vr1; }
        __syncthreads(); cur ^= 1;
    }
    float a1[16], a2[16];
    { const float l1 = half_swap_sum(ls[0]); bcast_rows(wsf, 1.f / l1, r32, hi, a1); }
    if (DIFF) { const float l2 = half_swap_sum(ls[1]); bcast_rows(wsf, -lam / l2, r32, hi, a2); }
#pragma unroll
    for (int d = 0; d < 4; ++d)
#pragma unroll
        for (int i = 0; i < 16; ++i) { o1[d][i] *= a1[i]; if (DIFF) o1[d][i] += o2[d][i] * a2[i]; }
    bf16_t* ob = Ob + (size_t)q0w * 512 + r32;
    if (DIFF) {
        const float g0 = gain[r32] * post, g1 = gain[32 + r32] * post, g2 = gain[64 + r32] * post, g3 = gain[96 + r32] * post;
#pragma unroll
        for (int i = 0; i < 16; ++i) {
            float ss = o1[0][i] * o1[0][i] + o1[1][i] * o1[1][i] + o1[2][i] * o1[2][i] + o1[3][i] * o1[3][i];
            ss += __shfl_xor(ss, 1); ss += __shfl_xor(ss, 2); ss += __shfl_xor(ss, 4); ss += __shfl_xor(ss, 8); ss += __shfl_xor(ss, 16);
            const float rs = rsqrtf(ss * (1.f / 128.f) + RMS_EPS);
            bf16_t* rp = ob + (size_t)crow(i, hi) * 512;
            rp[0] = f2bf(o1[0][i] * rs * g0); rp[32] = f2bf(o1[1][i] * rs * g1); rp[64] = f2bf(o1[2][i] * rs * g2); rp[96] = f2bf(o1[3][i] * rs * g3);
        }
    } else {
#pragma unroll
        for (int i = 0; i < 16; ++i) { bf16_t* rp = ob + (size_t)crow(i, hi) * 512;
            rp[0] = f2bf(o1[0][i]); rp[32] = f2bf(o1[1][i]); rp[64] = f2bf(o1[2][i]); rp[96] = f2bf(o1[3][i]); }
    }
}

DI void transpose_item(const float* W, int K, int N, bf16_t* WT, int drow0, LAS float* scr, int k0, int n0, int lane, bool ropeperm) {
#pragma unroll
    for (int i = 0; i < 32; ++i) { const int kk = 2 * i + (lane >> 5); scr[kk * 33 + (lane & 31)] = W[(size_t)(k0 + kk) * N + n0 + (lane & 31)]; }
    asm volatile("s_waitcnt lgkmcnt(0)" ::: "memory");
    const int c = lane & 7;
#pragma unroll
    for (int j = 0; j < 4; ++j) { const int n = (lane >> 3) + 8 * j;
        int ns = n; if (ropeperm && n < 16) { const int gq = (n >> 2) & 3; ns = (n & 3) | ((gq == 1 ? 2 : gq == 2 ? 1 : gq) << 2); }
        const LAS float* s = scr + (8 * c) * 33 + ns;
        u32x4 o; o.x = pk2(s[0 * 33], s[1 * 33]); o.y = pk2(s[2 * 33], s[3 * 33]); o.z = pk2(s[4 * 33], s[5 * 33]); o.w = pk2(s[6 * 33], s[7 * 33]);
        *(u32x4*)(WT + (size_t)(drow0 + n) * K + k0 + 8 * c) = o; }
    asm volatile("s_waitcnt lgkmcnt(0)" ::: "memory");
}
DI void transpose_mat(const float* W, int K, int N, bf16_t* WT, bool glu, LAS float* scr, int gw, int ngw, int lane, int& goff, int rope_lo = -1, int rope_hi = -1) {
    lane = opaque(lane); gw = opaque_s(gw);
    const int nblk = N / 32, items = (K / 64) * nblk;
    int first = gw - (goff % ngw); if (first < 0) first += ngw;
    goff += items;
    for (int it = first; it < items; it += ngw) { const int kb = it / nblk, nb = it % nblk, n0 = nb * 32;
        int d0 = n0; if (glu) d0 = (n0 < 512) ? (n0 / 128) * 256 + (n0 % 128) : ((n0 - 512) / 128) * 256 + 128 + ((n0 - 512) % 128);
        transpose_item(W, K, N, WT, d0, scr, kb * 64, n0, lane, (n0 >= rope_lo) && (n0 < rope_hi) && ((n0 & 63) == 0)); }
}
DI void rms_row_bf16(const float* xrow, const float* gain, bf16_t* orow, int lane) {
    lane = opaque(lane);
    const f32x4* xr = (const f32x4*)xrow + lane; const f32x4* gr = (const f32x4*)gain + lane;
    f32x4 v[4]; float s = 0.f;
#pragma unroll
    for (int j = 0; j < 4; ++j) { v[j] = xr[64 * j]; s += (v[j].x * v[j].x + v[j].y * v[j].y) + (v[j].z * v[j].z + v[j].w * v[j].w); }
    const float r = rsqrtf(wave_sum(s) * (1.f / DM) + RMS_EPS);
    unsigned long long* o8 = (unsigned long long*)orow + lane;
#pragma unroll
    for (int j = 0; j < 4; ++j) { const f32x4 gq = gr[64 * j];
        o8[64 * j] = (unsigned long long)pk2(v[j].x * r * gq.x, v[j].y * r * gq.y) | ((unsigned long long)pk2(v[j].z * r * gq.z, v[j].w * r * gq.w) << 32); }
}
DI void prep_row_bf16(const float* xrow, const float* gain, bf16_t* orow, float* prow, int lane) {
    lane = opaque(lane);
    const f32x4* xr = (const f32x4*)xrow + lane; const f32x4* gr = (const f32x4*)gain + lane;
    f32x4 v[4]; float s = 0.f;
#pragma unroll
    for (int j = 0; j < 4; ++j) { v[j] = xr[64 * j]; s += (v[j].x * v[j].x + v[j].y * v[j].y) + (v[j].z * v[j].z + v[j].w * v[j].w); }
    s = wave_sum(s);
    if (lane < 16) prow[lane] = (lane == 0) ? s : 0.f;
    unsigned long long* o8 = (unsigned long long*)orow + lane;
#pragma unroll
    for (int j = 0; j < 4; ++j) { const f32x4 gq = gr[64 * j];
        o8[64 * j] = (unsigned long long)pk2(v[j].x * gq.x, v[j].y * gq.y) | ((unsigned long long)pk2(v[j].z * gq.z, v[j].w * gq.w) << 32); }
}
DI void rms_row_f32(float* xrow, const float* gain, int lane) {
    lane = opaque(lane);
    f32x4* xr = (f32x4*)xrow + lane; const f32x4* gr = (const f32x4*)gain + lane;
    f32x4 v[4]; float s = 0.f;
#pragma unroll
    for (int j = 0; j < 4; ++j) { v[j] = xr[64 * j]; s += (v[j].x * v[j].x + v[j].y * v[j].y) + (v[j].z * v[j].z + v[j].w * v[j].w); }
    const float r = rsqrtf(wave_sum(s) * (1.f / DM) + RMS_EPS);
#pragma unroll
    for (int j = 0; j < 4; ++j) xr[64 * j] = v[j] * r * gr[64 * j];
}

struct Params {
    const float* x; const float* mem; const int* pos;
    const float *norm_mix, *w_in, *lam_re, *lam_im, *log_dt, *b_re, *b_im, *c_re, *c_im, *ssm_d, *w_glu, *diff_lambda, *diff_subln, *w_branch, *w_out,
                *norm_cross, *norm_mem, *w_xq, *w_xkv, *w_xo, *norm_mlp, *w_up, *w_down, *norm_final;
    float* out; unsigned char* ws;
};

typedef const __attribute__((address_space(4))) Params* KPtr;
DI KPtr kp_get() { unsigned long long v = (unsigned long long)__builtin_amdgcn_kernarg_segment_ptr(); asm volatile("" : "+s"(v)); return (KPtr)v; }
#define PP (kp_get())

DI void ssm_prep(int l, LAS unsigned char* lds) {
    const int tid = opaque(threadIdx.x);
    LAS f32x2_t* E = (LAS f32x2_t*)lds;
    LAS f32x2_t* Bb = (LAS f32x2_t*)(lds + 33 * 64 * 8);
    LAS f32x2_t* Cc = (LAS f32x2_t*)(lds + 33 * 64 * 8 + 1024 * 8);
    LAS float* Kk = (LAS float*)(lds + 33 * 64 * 8 + 1024 * 8 + 64 * 8);
    bf16_t* toep = (bf16_t*)(PP->ws + WS_TOEP); bf16_t* wst = (bf16_t*)(PP->ws + WS_WST); f32x2_t* lamT = (f32x2_t*)(PP->ws + WS_LAMT);
    const float* lre = PP->lam_re + l * 2048; const float* lim = PP->lam_im + l * 2048; const float* ldt = PP->log_dt + l * 32;
    const float* bre = PP->b_re + (size_t)l * 32768; const float* bim = PP->b_im + (size_t)l * 32768;
    const float* cre = PP->c_re + (size_t)l * 32768; const float* cim = PP->c_im + (size_t)l * 32768; const float* dsk = PP->ssm_d + l * 512;
    for (int un = blockIdx.x; un < 512; un += gridDim.x) {
        const int g = un >> 4, co = un & 15; const float dt = __expf(ldt[g]);
        for (int idx = tid; idx < 33 * 64; idx += 512) { const int tau = idx >> 6, p = idx & 63; const float lr = lre[g * 64 + p] * dt; const double li = (double)(lim[g * 64 + p] * dt);
            const float mag = __expf(tau * lr); float s, c; sincos_red(tau * li, s, c); E[idx] = (f32x2_t){mag * c, mag * s}; }
        for (int idx = tid; idx < 1024; idx += 512) { const int p = idx >> 4, ci = idx & 15; const float ar = lre[g * 64 + p], ai = lim[g * 64 + p];
            const float mag = __expf(ar * dt); float s, c; sincos_red((double)(ai * dt), s, c);
            const float nr = mag * c - 1.f, ni = mag * s; const float den = 1.f / (ar * ar + ai * ai);
            const float qr = (nr * ar + ni * ai) * den, qi = (ni * ar - nr * ai) * den;
            const float br = bre[(size_t)(g * 64 + p) * 16 + ci], bi = bim[(size_t)(g * 64 + p) * 16 + ci];
            Bb[idx] = (f32x2_t){qr * br - qi * bi, qr * bi + qi * br}; }
        if (tid < 64) Cc[tid] = (f32x2_t){cre[(size_t)(g * 16 + co) * 64 + tid], cim[(size_t)(g * 16 + co) * 64 + tid]};
        __syncthreads();
        { const int tau = tid >> 4, ci = tid & 15; float a = 0.f;
            for (int p = 0; p < 64; ++p) { const f32x2_t e = E[tau * 64 + p], cc = Cc[p], bb = Bb[p * 16 + ci];
                const float cr = cc.x * e.x - cc.y * e.y, cim2 = cc.x * e.y + cc.y * e.x; a += cr * bb.x - cim2 * bb.y; }
            Kk[tid] = a; }
        __syncthreads();
        {
            const int s_ = tid >> 4, ci = tid & 15;
#pragma unroll
            for (int pp = 0; pp < 4; ++pp) { const int p = 4 * co + pp; const f32x2_t e = E[(31 - s_) * 64 + p], bb = Bb[p * 16 + ci];
                const size_t o = (size_t)(g * 256 + p) * 512 + s_ * 16 + ci;
                wst[o] = f2bf(e.x * bb.x - e.y * bb.y); wst[o + 64 * 512] = f2bf(e.x * bb.y + e.y * bb.x); wst[o + 128 * 512] = 0; wst[o + 192 * 512] = 0; }
            if (tid < 4) lamT[g * 64 + 4 * co + tid] = E[32 * 64 + 4 * co + tid];
        }
        const float dval = dsk[g * 16 + co];
        for (int idx = tid; idx < 32 * SSM_K2; idx += 512) { const int t = idx / SSM_K2, k = idx % SSM_K2; float val;
            if (k < 512) { const int s = k >> 4, ci = k & 15; val = (t >= s) ? Kk[(t - s) * 16 + ci] : 0.f; if (s == t && ci == co) val += dval; }
            else { const int p = (k - 512) & 63; const f32x2_t e = E[(t + 1) * 64 + p], cc = Cc[p];
                val = (k < 576) ? (cc.x * e.x - cc.y * e.y) : -(cc.x * e.y + cc.y * e.x); }
            toep[(size_t)(g * 512 + t * 16 + co) * SSM_K2 + k] = f2bf(val); }
        __syncthreads();
    }
}

DI void ssm_scan(LAS unsigned char* lds) {
    const int tid = opaque(threadIdx.x);
    const float* sloc = (const float*)(PP->ws + WS_SLOC); bf16_t* a2 = (bf16_t*)(PP->ws + WS_A2); const f32x2_t* lamT = (const f32x2_t*)(PP->ws + WS_LAMT);
    for (int un = blockIdx.x; un < NB * 32; un += gridDim.x) {
        const int g = un & 31, b = un >> 5; const size_t r0 = (size_t)g * SSM_M2 + b * SSM_NC;
        const f32x4* src = (const f32x4*)(sloc + r0 * 128) + tid;
#pragma unroll
        for (int j = 0; j < 8; ++j) ((LAS f32x4*)lds)[tid + j * 512] = src[j * 512];
        __syncthreads();
        if (tid < 64) { const int p = tid; const f32x2_t lt = lamT[g * 64 + p]; float sr = 0.f, si = 0.f; const LAS float* L = (const LAS float*)lds;
            bf16_t* dst = a2 + r0 * SSM_K2 + 512 + p;
#pragma unroll 8
            for (int c = 0; c < SSM_NC; ++c) { dst[(size_t)c * SSM_K2] = f2bf(sr); dst[(size_t)c * SSM_K2 + 64] = f2bf(si);
                const float lr = L[c * 128 + p], li = L[c * 128 + 64 + p];
                const float nr = lt.x * sr - lt.y * si + lr, ni = lt.x * si + lt.y * sr + li; sr = nr; si = ni; } }
        __syncthreads();
    }
}

#define XB_TMO      128
#define XB_XCNT(j)  (256  + 64 * (j))
#define XB_XSUB(j)  (1280 + 64 * (j))
#define XB_XGEN(j)  (2304 + 64 * (j))
#define XB_TOP      3328
#define XB_TOPGEN   3392
#define XCD_BAR_WORDS 3456
#define XB_SPIN_CAP (1u << 18)
DI unsigned xb_ld(unsigned* p)              { return __hip_atomic_load(p, __ATOMIC_RELAXED, __HIP_MEMORY_SCOPE_AGENT); }
DI unsigned xb_add(unsigned* p, unsigned v) { return __hip_atomic_fetch_add(p, v, __ATOMIC_RELAXED, __HIP_MEMORY_SCOPE_AGENT); }
DI unsigned xb_xcc_id() { return (unsigned)__builtin_amdgcn_s_getreg((3 << 11) | 20) & 0xFu; }
#define XB_SPIN(cond, bar) do { unsigned _sp = 0; while (cond) { __builtin_amdgcn_s_sleep(1); \
    if ((++_sp & 255u) == 0u) { if (xb_ld(&(bar)[XB_TMO])) break; if (_sp > XB_SPIN_CAP) { atomicAdd(&(bar)[XB_TMO], 1u); break; } } } } while (0)
struct XcdBarrier { unsigned* bar; unsigned x; volatile LAS unsigned* st; };
DI XcdBarrier xcd_barrier_post(unsigned* bar, volatile LAS unsigned* st) {
    XcdBarrier b; b.bar = bar; b.x = xb_xcc_id(); b.st = st;
    if (threadIdx.x == 0) (void)xb_add(&bar[XB_XCNT(b.x)], 1u);
    return b;
}
DI void xcd_barrier_complete(unsigned* bar, unsigned x, unsigned& nloc, unsigned& nx) {
    const unsigned G = gridDim.x * gridDim.y * gridDim.z;
    unsigned sum, cnt, mine, sp = 0u;
    for (;;) {
        sum = 0u; cnt = 0u; mine = 0u;
#pragma unroll
        for (unsigned j = 0; j < 16; ++j) { const unsigned c = xb_ld(&bar[XB_XCNT(j)]); sum += c; cnt += (c > 0u) ? 1u : 0u; mine = (j == x) ? c : mine; }
        if (sum == G) break;
        __builtin_amdgcn_s_sleep(1);
        if ((++sp & 255u) == 0u) { if (xb_ld(&bar[XB_TMO])) break; if (sp > XB_SPIN_CAP) { atomicAdd(&bar[XB_TMO], 1u); break; } }
    }
    nloc = mine > 0u ? mine : 1u; nx = cnt > 0u ? cnt : 1u;
}
DI void xcd_barrier(const XcdBarrier& b) {
    asm volatile("s_waitcnt vmcnt(0)" ::: "memory");
    __syncthreads();
    if (opaque((int)threadIdx.x) == 0) {
        unsigned* bar = b.bar;
        __builtin_amdgcn_s_waitcnt(0);
        unsigned nloc = b.st[0], nx = b.st[1];
        if (nloc == 0u) { xcd_barrier_complete(bar, b.x, nloc, nx); b.st[0] = nloc; b.st[1] = nx; }
        const unsigned old = xb_add(&bar[XB_XSUB(b.x)], 1u);
        const unsigned gen = old / nloc;
        if (old + 1u == (gen + 1u) * nloc) {
            __builtin_amdgcn_fence(__ATOMIC_RELEASE, "agent");
            asm volatile("s_waitcnt vmcnt(0)" ::: "memory");
            const unsigned og = xb_add(&bar[XB_TOP], 1u);
            const unsigned tg = og / nx;
            if (og + 1u == (tg + 1u) * nx) xb_add(&bar[XB_TOPGEN], 1u);
            else XB_SPIN(xb_ld(&bar[XB_TOPGEN]) == tg, bar);
            __builtin_amdgcn_fence(__ATOMIC_ACQUIRE, "agent");
            xb_add(&bar[XB_XGEN(b.x)], 1u);
            asm volatile("s_waitcnt vmcnt(0)" ::: "memory");
        } else {
            XB_SPIN(xb_ld(&bar[XB_XGEN(b.x)]) == gen, bar);
            __builtin_amdgcn_fence(__ATOMIC_ACQUIRE, "agent");
            asm volatile("s_waitcnt vmcnt(0)" ::: "memory");
        }
    }
    __syncthreads();
}

#define HBUF ((bf16_t*)(PP->ws + WS_H))
#define LAMS ((float*)(PP->ws + WS_LAMT + 65536))
__global__ void __launch_bounds__(512, 2) fwd_megakernel(Params P) {
    extern __shared__ __attribute__((aligned(16))) unsigned char lds_raw[];
    LAS unsigned char* lds = (LAS unsigned char*)lds_raw;
    cg::grid_group grid = cg::this_grid();
    const int tid = threadIdx.x, lane = tid & 63, wave = __builtin_amdgcn_readfirstlane(tid >> 6);
    const int G = gridDim.x, c = blockIdx.x;
    const int gw = c * 8 + wave, ngw = G * 8;
    LAS float* scr = (LAS float*)(lds + wave * 16384);
    if (tid < 4) ((LAS unsigned*)(lds + LDS_CTL + 64))[tid] = 0u;
    __syncthreads();
    if (c == 0) { unsigned* bw = (unsigned*)PP->ws + 4096; for (int i = tid; i < XCD_BAR_WORDS; i += 512) bw[i] = 0u; }
    XcdBarrier xbar; xbar.bar = (unsigned*)PP->ws + 4096; xbar.x = xb_xcc_id(); xbar.st = (volatile LAS unsigned*)(lds + LDS_CTL + 64);
    grid.sync();
    if (opaque((int)threadIdx.x) == 0) (void)xb_add(&xbar.bar[XB_XCNT(xbar.x)], 1u);

    int goff = 0;
    for (int i = c * 512 + tid; i < MTOK * 8; i += G * 512) { const int row = i >> 3, j = i & 7;
        const float invf = __builtin_amdgcn_exp2f(-(float)j * 2.3664460712f);   const float ang = (float)PP->pos[row] * invf; float s, cs; sincos_red((double)ang, s, cs);
        ((f32x2_t*)(PP->ws + WS_ROPE))[i] = (f32x2_t){cs, s}; }
    if (c == 0 && tid < DEPTH) { const float* lv = PP->diff_lambda + tid * 256; float a = 0.f, b = 0.f;
        for (int k = 0; k < 64; ++k) { a += lv[k] * lv[64 + k]; b += lv[128 + k] * lv[192 + k]; }
        LAMS[tid] = expf(a) - expf(b) + (0.8f - 0.6f * expf(-0.3f * (float)tid)); }
    for (int r = gw; r < DEPTH * NB * MEML; r += ngw) { const int l = r / (NB * MEML), m = r % (NB * MEML);
        rms_row_bf16(PP->mem + (size_t)m * DM, PP->norm_mem + l * DM, (bf16_t*)(PP->ws + WS_MEMN) + (size_t)r * DM, lane); }
    for (int l = 0; l < DEPTH; ++l) transpose_mat(PP->w_xkv + (size_t)l * DM * 1024, DM, 1024, (bf16_t*)(PP->ws + WS_WXKV) + (size_t)l * 1024 * DM, false, scr, gw, ngw, lane, goff);

    for (int l = 0; l < DEPTH; ++l) {
        const float* xin = (l == 0) ? PP->x : PP->out;
        transpose_mat(PP->w_in + (size_t)l * DM * NIN, DM, NIN, (bf16_t*)(PP->ws + WS_WIN), false, scr, gw, ngw, lane, goff, 2048, 3072);
        transpose_mat(PP->w_glu + (size_t)l * 512 * 1024, 512, 1024, (bf16_t*)(PP->ws + WS_WGLU), true, scr, gw, ngw, lane, goff);
        for (int z = 0; z < 3; ++z) transpose_mat(PP->w_branch + ((size_t)l * 3 + z) * 512 * DM, 512, DM, (bf16_t*)(PP->ws + WS_WB) + (size_t)z * DM * 512, false, scr, gw, ngw, lane, goff);
        transpose_mat(PP->w_out + (size_t)l * DM * DM, DM, DM, (bf16_t*)(PP->ws + WS_WOUT), false, scr, gw, ngw, lane, goff);
        transpose_mat(PP->w_xq + (size_t)l * DM * 512, DM, 512, (bf16_t*)(PP->ws + WS_WXQ), false, scr, gw, ngw, lane, goff);
        transpose_mat(PP->w_xo + (size_t)l * 512 * DM, 512, DM, (bf16_t*)(PP->ws + WS_WXO), false, scr, gw, ngw, lane, goff);
        transpose_mat(PP->w_up + (size_t)l * DM * 4096, DM, 4096, (bf16_t*)(PP->ws + WS_WUP), false, scr, gw, ngw, lane, goff);
        transpose_mat(PP->w_down + (size_t)l * 4096 * DM, 4096, DM, (bf16_t*)(PP->ws + WS_WDN), false, scr, gw, ngw, lane, goff);
        __syncthreads();
        ssm_prep(l, lds);
        if (l == 0) for (int r = gw; r < MTOK; r += ngw) prep_row_bf16(xin + (size_t)r * DM, PP->norm_mix, HBUF + (size_t)r * DM, (float*)(PP->ws + WS_PART) + (size_t)r * 16, lane);
        xcd_barrier(xbar);

        { pg8::Gemm g{HBUF, (const bf16_t*)(PP->ws + WS_WIN), DM, DM, DM, 0, 0}; pg8::SchedMN S{MTOK / 256, NINA / 256, G, c};
          pg8::EpiInProj E{PP->ws, (const f32x2_t*)(PP->ws + WS_ROPE), (const float*)(PP->ws + WS_PART)}; pg8::gemm_phase(lds, g, S, E); }
        if (l == 0) { pg8::Gemm g{(const bf16_t*)(PP->ws + WS_MEMN), (const bf16_t*)(PP->ws + WS_WXKV), DM, DM, DM, (long)NB * MEML * DM, (long)1024 * DM};
          pg8::SchedZ S{DEPTH, NB * MEML / 256, 1024 / 256, G, c}; pg8::EpiMemKV E{(bf16_t*)(PP->ws + WS_MEMKV)}; pg8::gemm_phase(lds, g, S, E); }
        xcd_barrier(xbar);

        { pg8::Gemm g{(const bf16_t*)(PP->ws + WS_A2), (const bf16_t*)(PP->ws + WS_WST), SSM_K2, 512, 512, (long)SSM_M2 * SSM_K2, (long)256 * 512};
          pg8::SchedZ S{32, SSM_M2 / 256, 1, G, c}; pg8::EpiSloc E{(float*)(PP->ws + WS_SLOC)}; pg8::gemm_phase(lds, g, S, E); }
        xcd_barrier(xbar);
        ssm_scan(lds);
        xcd_barrier(xbar);
        { pg8::Gemm g{(const bf16_t*)(PP->ws + WS_A2), (const bf16_t*)(PP->ws + WS_TOEP), SSM_K2, SSM_K2, SSM_K2, (long)SSM_M2 * SSM_K2, (long)512 * SSM_K2};
          pg8::SchedZ S{32, SSM_M2 / 256, 2, G, c}; pg8::EpiGelu E{(bf16_t*)(PP->ws + WS_YACT)}; pg8::gemm_phase(lds, g, S, E); }
        xcd_barrier(xbar);
        { pg8::Gemm g{(const bf16_t*)(PP->ws + WS_YACT), (const bf16_t*)(PP->ws + WS_WGLU), 512, 512, 512, 0, 0}; pg8::SchedMN S{MTOK / 256, 4, G, c};
          pg8::EpiGlu E{(bf16_t*)(PP->ws + WS_YSSM)}; pg8::gemm_phase(lds, g, S, E); }
        for (int r = 0;; ++r) { const int pos = (r & 1) ? G - 1 - c : c; const int idx = r * G + pos; if (idx >= 1024) break;
            const int qb = 15 - idx / 64, bh = idx % 64;
            sb_unit(bh >> 3, bh & 7, qb, (const bf16_t*)(PP->ws + WS_SQ), (bf16_t*)(PP->ws + WS_SQ), (const bf16_t*)(PP->ws + WS_SK), (const bf16_t*)(PP->ws + WS_SV), lds); }
        { const float lam = LAMS[l]; const float post = 1.f - (0.8f - 0.6f * expf(-0.3f * (float)l));
          for (int r = 0;; ++r) { const int pos = (r & 1) ? G - 1 - c : c; const int idx = r * G + pos; if (idx >= 512) break;
            const int qb = 15 - idx / 32, bh = idx % 32, b = bh >> 2, hh = bh & 3; const size_t off = (size_t)b * SEQ * 512 + hh * 128;
            attn2_unit<true>(qb, (const bf16_t*)(PP->ws + WS_DQ) + off, (bf16_t*)(PP->ws + WS_DQ) + off, (const bf16_t*)(PP->ws + WS_DK) + off, (const bf16_t*)(PP->ws + WS_DV) + off, 4 * qb + 4, lam, PP->diff_subln + l * 128, post, lds); } }
        xcd_barrier(xbar);
        { pg8::GmArgs ga{HBUF, (const bf16_t*)(PP->ws + WS_WIN) + (size_t)NINA * DM, (const bf16_t*)(PP->ws + WS_YSSM), (long)(WS_SQ - WS_YSSM) / 2, (const bf16_t*)(PP->ws + WS_WB),
                         (bf16_t*)(PP->ws + WS_GS), (bf16_t*)(PP->ws + WS_H2), (const float*)(PP->ws + WS_PART)};
          pg8::SchedGM S{MTOK / 256, 4, G, c}; pg8::gemm_phase_gm(lds, ga, S); }
        xcd_barrier(xbar);
        { pg8::Gemm g{(const bf16_t*)(PP->ws + WS_H2), (const bf16_t*)(PP->ws + WS_WOUT), DM, DM, DM, 0, 0}; pg8::SchedMN S{MTOK / 256, 4, G, c}; pg8::EpiResid E{xin, PP->out, HBUF, PP->norm_cross + l * DM, (float*)(PP->ws + WS_PART)}; pg8::gemm_phase(lds, g, S, E); }
        xcd_barrier(xbar);
        { pg8::Gemm g{HBUF, (const bf16_t*)(PP->ws + WS_WXQ), DM, DM, DM, 0, 0}; pg8::SchedMN S{MTOK / 256, 2, G, c};
          pg8::EpiBf16<0, true> E{(bf16_t*)(PP->ws + WS_XQ), 512, 0.12751743074602334f, (const float*)(PP->ws + WS_PART)}; pg8::gemm_phase(lds, g, S, E); }
        xcd_barrier(xbar);
        for (int idx = c; idx < 512; idx += G) { const int qb = idx & 15, bh = idx >> 4, b = bh >> 2, hh = bh & 3;
            const bf16_t* kb = (const bf16_t*)(PP->ws + WS_MEMKV) + (size_t)(l * 2) * 2048 * 512 + (size_t)b * MEML * 512 + hh * 128;
            attn2_unit<false>(qb, (const bf16_t*)(PP->ws + WS_XQ) + (size_t)b * SEQ * 512 + hh * 128, (bf16_t*)(PP->ws + WS_XQ) + (size_t)b * SEQ * 512 + hh * 128, kb, kb + (size_t)2048 * 512, 4, 0.f, nullptr, 1.f, lds); }
        xcd_barrier(xbar);
        { pg8::Gemm g{(const bf16_t*)(PP->ws + WS_XQ), (const bf16_t*)(PP->ws + WS_WXO), 512, 512, 512, 0, 0}; pg8::SchedMN S{MTOK / 256, 4, G, c}; pg8::EpiResid E{PP->out, PP->out, HBUF, PP->norm_mlp + l * DM, (float*)(PP->ws + WS_PART)}; pg8::gemm_phase(lds, g, S, E); }
        xcd_barrier(xbar);
        { pg8::Gemm g{HBUF, (const bf16_t*)(PP->ws + WS_WUP), DM, DM, DM, 0, 0}; pg8::SchedMN S{MTOK / 256, 16, G, c};
          pg8::EpiBf16<2, true> E{(bf16_t*)(PP->ws + WS_HID), 4096, 1.f, (const float*)(PP->ws + WS_PART)}; pg8::gemm_phase(lds, g, S, E); }
        xcd_barrier(xbar);
        { pg8::Gemm g{(const bf16_t*)(PP->ws + WS_HID), (const bf16_t*)(PP->ws + WS_WDN), 4096, 4096, 4096, 0, 0}; pg8::SchedMN S{MTOK / 256, 4, G, c}; pg8::EpiResid E{PP->out, PP->out, HBUF, PP->norm_mix + (l + 1 < DEPTH ? l + 1 : l) * DM, (float*)(PP->ws + WS_PART)}; pg8::gemm_phase(lds, g, S, E); }
        xcd_barrier(xbar);
    }
    for (int r = gw; r < MTOK; r += ngw) rms_row_f32(PP->out + (size_t)r * DM, PP->norm_final, lane);
}

extern "C" void kernel_launch(void* const* d_in, const int* in_sizes, int n_in, void* d_out, int out_size, void* d_ws, size_t ws_size, hipStream_t stream) {
    static int grid = 0;
    if (grid == 0) {
        if (n_in != 27 || ws_size < WS_END) { fprintf(stderr, "kernel_launch: unexpected n_in %d / ws %zu\n", n_in, ws_size); grid = -1; return; }
        int dev = 0, cus = 0, per_cu = 0;
        hipGetDevice(&dev); hipDeviceGetAttribute(&cus, hipDeviceAttributeMultiprocessorCount, dev);
        hipFuncSetAttribute((const void*)fwd_megakernel, hipFuncAttributeMaxDynamicSharedMemorySize, LDS_BYTES);
        hipOccupancyMaxActiveBlocksPerMultiprocessor(&per_cu, (const void*)fwd_megakernel, 512, LDS_BYTES);
        if (per_cu < 1) per_cu = 1;
        grid = cus * 1; (void)per_cu;
        (void)hipGetLastError();
    }
    if (grid < 0) return;
    Params p{};
    p.x = (const float*)d_in[0]; p.mem = (const float*)d_in[1]; p.pos = (const int*)d_in[2];
    p.norm_mix = (const float*)d_in[3]; p.w_in = (const float*)d_in[4]; p.lam_re = (const float*)d_in[5]; p.lam_im = (const float*)d_in[6]; p.log_dt = (const float*)d_in[7];
    p.b_re = (const float*)d_in[8]; p.b_im = (const float*)d_in[9]; p.c_re = (const float*)d_in[10]; p.c_im = (const float*)d_in[11]; p.ssm_d = (const float*)d_in[12];
    p.w_glu = (const float*)d_in[13]; p.diff_lambda = (const float*)d_in[14]; p.diff_subln = (const float*)d_in[15]; p.w_branch = (const float*)d_in[16]; p.w_out = (const float*)d_in[17];
    p.norm_cross = (const float*)d_in[18]; p.norm_mem = (const float*)d_in[19]; p.w_xq = (const float*)d_in[20]; p.w_xkv = (const float*)d_in[21]; p.w_xo = (const float*)d_in[22];
    p.norm_mlp = (const float*)d_in[23]; p.w_up = (const float*)d_in[24]; p.w_down = (const float*)d_in[25]; p.norm_final = (const float*)d_in[26];
    p.out = (float*)d_out; p.ws = (unsigned char*)d_ws;
    void* args[] = {&p};
    hipError_t e = hipLaunchCooperativeKernel((const void*)fwd_megakernel, dim3(grid), dim3(512), args, LDS_BYTES, stream);
    if (e != hipSuccess) fprintf(stderr, "cooperative launch failed: %s (grid %d)\n", hipGetErrorString(e), grid);
}
```

```cpp
#include <hip/hip_runtime.h>
#include <hip/hip_cooperative_groups.h>
#include <cstdint>
#include <cstdio>
namespace cg = cooperative_groups;

#define LAS __attribute__((address_space(3)))
#define DI __device__ __forceinline__
typedef unsigned short bf16_t;
typedef short bf16x8 __attribute__((ext_vector_type(8)));
typedef short s16x4 __attribute__((ext_vector_type(4)));
typedef short v4i16_t __attribute__((ext_vector_type(4)));
typedef float f32x4 __attribute__((ext_vector_type(4)));
typedef float f32x16 __attribute__((ext_vector_type(16)));
typedef unsigned u32x4 __attribute__((ext_vector_type(4)));
typedef float f32x2_t __attribute__((ext_vector_type(2)));
typedef __bf16 bf16x2_t __attribute__((ext_vector_type(2)));

constexpr int DM = 1024, NB = 8, SEQ = 4096, MTOK = NB * SEQ, DEPTH = 2, MEML = 256;
constexpr int NIN = 6656, NINA = 3584;
constexpr float RMS_EPS = 1e-6f;
constexpr int SSM_T = 32, SSM_NC = SEQ / SSM_T  , SSM_M2 = NB * SSM_NC  , SSM_K2 = 640;

constexpr size_t MiB = 1u << 20;
constexpr size_t WS_ROPE = 1 * MiB;
constexpr size_t WS_LAMT = 3 * MiB;
constexpr size_t WS_MEMN = 4 * MiB;
constexpr size_t WS_WXKV = 12 * MiB;
constexpr size_t WS_MEMKV = 16 * MiB;
constexpr size_t WS_WIN = 24 * MiB;
constexpr size_t WS_WGLU = 37 * MiB;
constexpr size_t WS_WB = 38 * MiB;
constexpr size_t WS_WOUT = 41 * MiB;
constexpr size_t WS_WXQ = 43 * MiB;
constexpr size_t WS_WXO = 44 * MiB;
constexpr size_t WS_WUP = 45 * MiB;
constexpr size_t WS_WDN = 53 * MiB;
constexpr size_t WS_WST = 61 * MiB;
constexpr size_t WS_TOEP = 69 * MiB;
constexpr size_t WS_H = 90 * MiB;
constexpr size_t WS_YSSM = 154 * MiB;
constexpr size_t WS_SQ = 186 * MiB;
constexpr size_t WS_DQ = 218 * MiB;
constexpr size_t WS_SK = 250 * MiB;
constexpr size_t WS_SV = 282 * MiB;
constexpr size_t WS_DK = 314 * MiB;
constexpr size_t WS_DV = 346 * MiB;
constexpr size_t WS_A2 = 378 * MiB;
constexpr size_t WS_SLOC = 418 * MiB;
constexpr size_t WS_YACT = 434 * MiB;
constexpr size_t WS_GATES = 250 * MiB;
constexpr size_t WS_HID = 154 * MiB;
constexpr size_t WS_XQ = 154 * MiB;
constexpr size_t WS_H2 = 250 * MiB;
constexpr size_t WS_GS = 314 * MiB;
constexpr size_t WS_PART = 466 * MiB;
constexpr size_t WS_END = 468 * MiB;

constexpr int LDS_CTL = 143360;
constexpr int LDS_BYTES = LDS_CTL + 1024;

DI unsigned pk2(float lo, float hi) { f32x2_t v = {lo, hi}; bf16x2_t b = __builtin_convertvector(v, bf16x2_t); return __builtin_bit_cast(unsigned, b); }
DI bf16_t f2bf(float f) { return (bf16_t)(pk2(f, 0.f) & 0xffffu); }
DI float bf2f(unsigned u) { return __uint_as_float(u << 16); }
DI void st8(bf16_t* p, f32x4 a, f32x4 b) { u32x4 w; w.x = pk2(a[0], a[1]); w.y = pk2(a[2], a[3]); w.z = pk2(b[0], b[1]); w.w = pk2(b[2], b[3]); *(u32x4*)p = w; }
DI int opaque(int v) { asm volatile("" : "+v"(v)); return v; }
DI int opaque_s(int v) { asm volatile("" : "+s"(v)); return v; }
DI float sigmoidf_(float x) { return __builtin_amdgcn_rcpf(1.f + __builtin_amdgcn_exp2f(x * -1.4426950408889634f)); }
DI float wave_sum(float v) {
#pragma unroll
    for (int o = 1; o < 64; o <<= 1) v += __shfl_xor(v, o);
    return v;
}
DI void sincos_red(double a, float& s, float& c) {
    const double k = rint(a * 0.15915494309189535);
    const float r = (float)(a - k * 6.283185307179586);
    s = __sinf(r); c = __cosf(r);
}

namespace pg8 {
constexpr int BM = 256, BK = 64, HALF = 128, HTB = HALF * BK * 2, STAGE_BYTES = 8 * HTB, NXCD = 8, WGM = 8;
DI int lds_byte(int r, int c) { const int st = (r >> 4) * 2 + (c >> 5), rr = r & 15, cc = c & 31, ob = rr * 64 + cc * 2; return st * 1024 + (ob ^ (((ob >> 9) & 1) << 5)); }
DI void stage_rc(int b, int& R, int& C) { const int st = b / 1024, sb = b % 1024, swz = sb ^ (((sb >> 9) & 1) << 5); R = (st >> 1) * 16 + swz / 64; C = (st & 1) * 32 + (swz % 64) / 2; }
DI int perm32(int rho) { const int n = rho >> 4, i = rho & 15; return 8 * (i >> 2) + 4 * n + (i & 3); }

struct Unit { int pm, pn, z; };
struct Gemm { const bf16_t* A; const bf16_t* Bt; int lda, ldb, K; long zA, zB; };

DI void tile_decode(int wgid, int nM, int nN, int& pm, int& pn) {
    const int nwg = nM * nN;
    { const int q = nwg / NXCD, r = nwg % NXCD, xcd = wgid % NXCD, off = wgid / NXCD; wgid = (xcd < r ? xcd * (q + 1) : r * (q + 1) + (xcd - r) * q) + off; }
    const int nig = WGM * nN, gid = wgid / nig, fm = gid * WGM, gsz = (nM - fm) < WGM ? (nM - fm) : WGM;
    pm = fm + ((wgid % nig) % gsz); pn = (wgid % nig) / gsz;
}
struct SchedMN {
    int nM, nN, G, c;
    DI bool next(int i, Unit& u) const { const long L = (long)i * G + c; if (L >= (long)nM * nN) return false; tile_decode((int)L, nM, nN, u.pm, u.pn); u.z = 0; return true; }
};
struct SchedZ {
    int nZ, nM, nN, G, c;
    DI bool next(int i, Unit& u) const { const long L = (long)i * G + c; if (L >= (long)nZ * nM * nN) return false; const int l = (int)L; u.z = l / (nM * nN); const int r = l % (nM * nN); u.pm = r / nN; u.pn = r % nN; return true; }
};
struct SchedMerge {
    int nM, nN, G, c;
    DI bool next(int i, Unit& u) const { const long L = (long)(i / 3) * G + c; if (L >= (long)nM * nN) return false; tile_decode((int)L, nM, nN, u.pm, u.pn); u.z = i % 3; return true; }
};

template <class Epi, class Sched>
DI void gemm_phase(LAS unsigned char* lds, const Gemm g, const Sched& S, const Epi& E) {
    const int tid = opaque(threadIdx.x), wid = __builtin_amdgcn_readfirstlane(tid >> 6), lane = tid & 63, wr = wid >> 2, wc = wid & 3, fr = lane & 15, fq = lane >> 4;
    const int nt = g.K / BK;
    unsigned voffA[2], voffB[2];
#pragma unroll
    for (int i = 0; i < 2; ++i) { int R, C; stage_rc(tid * 16 + i * 8192, R, C); const int Rb = (R & ~31) + perm32(R & 31);
        voffA[i] = (unsigned)(R * g.lda + C) * 2u; voffB[i] = (unsigned)(Rb * g.ldb + C) * 2u; }
    const size_t kstep = (size_t)(BK * 2);
    const size_t hstepA = (size_t)HALF * g.lda * 2, hstepB = (size_t)HALF * g.ldb * 2;
    const unsigned ldsw = (unsigned)wid * 1024u;
    const int aoff = lds_byte(wr * 64 + fr, fq * 8), boff = lds_byte(wc * 32 + fr, fq * 8);
#define PG8_SA(b, h) (((b) * 2 + (h)) * HTB)
#define PG8_SB(b, h) ((4 + (b) * 2 + (h)) * HTB)
#define PG8_STAGE(bufoff, gbase, voff) do { _Pragma("unroll") for (int _i = 0; _i < 2; ++_i) \
        __builtin_amdgcn_global_load_lds((const unsigned*)((const char*)(gbase) + (voff)[_i]), (LAS unsigned*)(lds + (bufoff) + ldsw + _i * 8192), 16, 0, 0); } while (0)
#define PG8_LDA(dst, b, h) do { _Pragma("unroll") for (int m = 0; m < 4; ++m) _Pragma("unroll") for (int k = 0; k < 2; ++k) dst[m][k] = *(const LAS bf16x8*)(lds + PG8_SA(b, h) + aoff + m * 2048 + k * 1024); } while (0)
#define PG8_LDB(dst, b, h) do { _Pragma("unroll") for (int n = 0; n < 2; ++n) _Pragma("unroll") for (int k = 0; k < 2; ++k) dst[n][k] = *(const LAS bf16x8*)(lds + PG8_SB(b, h) + boff + n * 2048 + k * 1024); } while (0)
#define PG8_MMA(ai, bj, At, Bt) do { __builtin_amdgcn_s_setprio(1); _Pragma("unroll") for (int m = 0; m < 4; ++m) _Pragma("unroll") for (int n = 0; n < 2; ++n) _Pragma("unroll") for (int k = 0; k < 2; ++k) \
        acc[ai][bj][m][n] = __builtin_amdgcn_mfma_f32_16x16x32_bf16(Bt[n][k], At[m][k], acc[ai][bj][m][n], 0, 0, 0); __builtin_amdgcn_s_setprio(0); } while (0)
#define PG8_WAIT_V(n) asm volatile("s_waitcnt vmcnt(" #n ")" ::: "memory")
#define PG8_WAIT_L(n) asm volatile("s_waitcnt lgkmcnt(" #n ")" ::: "memory")
#define PG8_BAR __builtin_amdgcn_s_barrier()
#define PG8_SCHED __builtin_amdgcn_sched_barrier(0)
    Unit cur, nxt; int ui = 0;
    if (!S.next(0, cur)) return;
#define PG8_RFILL(u_, ui_) do { if (tid < 256) { const f32x4* pp_ = (const f32x4*)(E.part + (size_t)((u_).pm * BM + tid) * 16); \
        const f32x4 a_ = pp_[0], b_ = pp_[1], c_ = pp_[2], d_ = pp_[3]; const f32x4 s_ = (a_ + b_) + (c_ + d_); \
        ((LAS float*)(lds + STAGE_BYTES))[(ui_) * 256 + tid] = rsqrtf(((s_[0] + s_[1]) + (s_[2] + s_[3])) * (1.f / DM) + RMS_EPS); } } while (0)
    if constexpr (Epi::NEEDS_R) {
        Unit uu; for (int i = 0; i < 8 && S.next(i, uu); ++i) PG8_RFILL(uu, i);
    }
    f32x4 acc[2][2][4][2];
#pragma unroll
    for (int a = 0; a < 2; ++a)
#pragma unroll
        for (int b = 0; b < 2; ++b)
#pragma unroll
            for (int m = 0; m < 4; ++m)
#pragma unroll
                for (int n = 0; n < 2; ++n) acc[a][b][m][n] = (f32x4){0.f, 0.f, 0.f, 0.f};
    bf16x8 At[4][2], B0[2][2], B1[2][2];
    const char* cA = (const char*)g.A + (size_t)cur.z * g.zA * 2 + (size_t)cur.pm * 2 * hstepA;
    const char* cB = (const char*)g.Bt + (size_t)cur.z * g.zB * 2 + (size_t)cur.pn * 2 * hstepB;
    PG8_STAGE(PG8_SB(0, 0), cB, voffB); PG8_STAGE(PG8_SB(0, 1), cB + hstepB, voffB); PG8_STAGE(PG8_SA(0, 0), cA, voffA); PG8_STAGE(PG8_SA(0, 1), cA + hstepA, voffA);
    if (wr == 1) PG8_BAR;
    PG8_WAIT_V(2); PG8_BAR;
    PG8_STAGE(PG8_SB(1, 0), cB + kstep, voffB); PG8_STAGE(PG8_SA(1, 0), cA + kstep, voffA); PG8_STAGE(PG8_SB(1, 1), cB + hstepB + kstep, voffB);
    PG8_WAIT_V(6); PG8_BAR;
    for (;;) {
        const bool has_next = S.next(ui + 1, nxt);
        const char* nA = has_next ? (const char*)g.A + (size_t)nxt.z * g.zA * 2 + (size_t)nxt.pm * 2 * hstepA : cA;
        const char* nB = has_next ? (const char*)g.Bt + (size_t)nxt.z * g.zB * 2 + (size_t)nxt.pn * 2 * hstepB : cB;
        for (int t = 0; t < nt; t += 2) {
            const bool last = (t == nt - 2);
            const char* a1 = cA + (size_t)(t + 1) * kstep;
            const char* a2 = last ? nA : cA + (size_t)(t + 2) * kstep; const char* b2 = last ? nB : cB + (size_t)(t + 2) * kstep;
            const char* a3 = a2 + kstep; const char* b3 = b2 + kstep;
            PG8_LDB(B0, 0, 0); PG8_LDB(B1, 0, 1); PG8_SCHED; PG8_LDA(At, 0, 0); PG8_STAGE(PG8_SA(1, 1), a1 + hstepA, voffA);
            PG8_WAIT_V(8); PG8_WAIT_L(0); PG8_BAR; PG8_MMA(0, 0, At, B0); PG8_MMA(0, 1, At, B1); PG8_BAR; PG8_SCHED;
            PG8_LDA(At, 0, 1); PG8_STAGE(PG8_SB(0, 0), b2, voffB); PG8_STAGE(PG8_SB(0, 1), b2 + hstepB, voffB); PG8_STAGE(PG8_SA(0, 0), a2, voffA);
            PG8_WAIT_V(8); PG8_WAIT_L(0); PG8_BAR; PG8_MMA(1, 0, At, B0); PG8_MMA(1, 1, At, B1); PG8_BAR; PG8_SCHED;
            PG8_LDB(B0, 1, 0); PG8_LDB(B1, 1, 1); PG8_SCHED; PG8_LDA(At, 1, 0); PG8_STAGE(PG8_SA(0, 1), a2 + hstepA, voffA);
            PG8_WAIT_V(8); PG8_WAIT_L(0); PG8_BAR; PG8_MMA(0, 0, At, B0); PG8_MMA(0, 1, At, B1); PG8_BAR; PG8_SCHED;
            PG8_LDA(At, 1, 1); PG8_STAGE(PG8_SB(1, 0), b3, voffB); PG8_STAGE(PG8_SB(1, 1), b3 + hstepB, voffB); PG8_STAGE(PG8_SA(1, 0), a3, voffA);
            PG8_WAIT_V(8); PG8_WAIT_L(0); PG8_BAR; PG8_MMA(1, 0, At, B0); PG8_MMA(1, 1, At, B1); PG8_BAR; PG8_SCHED;
        }
        if (wr == 0) PG8_BAR;
        E(acc, cur, wr, wc, fr, fq, (const LAS float*)(lds + STAGE_BYTES) + (ui & 7) * 256);
        if (!has_next) break;
#pragma unroll
        for (int a = 0; a < 2; ++a)
#pragma unroll
            for (int b = 0; b < 2; ++b)
#pragma unroll
                for (int m = 0; m < 4; ++m)
#pragma unroll
                    for (int n = 0; n < 2; ++n) acc[a][b][m][n] = (f32x4){0.f, 0.f, 0.f, 0.f};
        cur = nxt; cA = nA; cB = nB; ++ui;
        if (wr == 1) PG8_BAR;
    }
    PG8_WAIT_V(0);
    PG8_BAR;
#undef PG8_RFILL
#undef PG8_SA
#undef PG8_SB
#undef PG8_STAGE
#undef PG8_LDA
#undef PG8_LDB
#undef PG8_MMA
#undef PG8_WAIT_V
#undef PG8_WAIT_L
#undef PG8_BAR
#undef PG8_SCHED
}

typedef f32x4 AccT[2][2][4][2];

struct EpiInProj {
    static constexpr bool PERM = true, NEEDS_R = true;
    unsigned char* ws; const f32x2_t* rope; const float* part;
    DI void operator()(const AccT& acc, const Unit& u, int wr, int wc, int fr, int fq, const LAS float* rt) const {
        const int colt = u.pn * BM; const int seg = colt >> 9; const int cbase = (colt & 511) + wc * 32 + 8 * fq;
        const size_t off = seg == 1 ? WS_SQ : seg == 2 ? WS_SK : seg == 3 ? WS_SV : seg == 4 ? WS_DQ : seg == 5 ? WS_DK : WS_DV;
        bf16_t* base = (bf16_t*)(ws + off); bf16_t* a2 = (bf16_t*)(ws + WS_A2);
        const bool rot = (seg == 4 || seg == 5) && ((wc & 1) == 0) && (fq < 2);
        const float sc = (seg == 1 || seg == 4) ? 0.18033688011112042f : 1.f;
#pragma unroll
        for (int ai = 0; ai < 2; ++ai) {
            f32x2_t rc[4][4];
            if (rot) {
#pragma unroll
                for (int m = 0; m < 4; ++m) { const f32x2_t* cs = rope + (size_t)(u.pm * BM + ai * HALF + wr * 64 + m * 16 + fr) * 8 + 4 * fq;
#pragma unroll
                    for (int k = 0; k < 4; ++k) rc[m][k] = cs[k]; }
            }
            __builtin_amdgcn_sched_barrier(0);
#pragma unroll
            for (int m = 0; m < 4; ++m) {
                const int row = u.pm * BM + ai * HALF + wr * 64 + m * 16 + fr; const float rr = rt[ai * HALF + wr * 64 + m * 16 + fr] * sc;
#pragma unroll
                for (int bj = 0; bj < 2; ++bj) {
                    const int cs = cbase + bj * HALF; f32x4 v0 = acc[ai][bj][m][0] * rr, v1 = acc[ai][bj][m][1] * rr;
                    if (seg == 0) {
                        const int g = cs >> 4, ci = cs & 15, b = row >> 12, t = row & 4095, c = t >> 5, s = t & 31;
                        st8(a2 + ((size_t)(g * SSM_M2 + b * SSM_NC + c) * SSM_K2 + s * 16 + ci), v0, v1);
                    } else if (rot) {
#pragma unroll
                        for (int k = 0; k < 4; ++k) { const float t1 = v0[k], t2 = v1[k]; v0[k] = t1 * rc[m][k].x - t2 * rc[m][k].y; v1[k] = t2 * rc[m][k].x + t1 * rc[m][k].y; }
                        bf16_t* dp = base + (size_t)row * 512 + (cs - 8 * fq) + 4 * fq;
                        *(unsigned long long*)dp = (unsigned long long)pk2(v0[0], v0[1]) | ((unsigned long long)pk2(v0[2], v0[3]) << 32);
                        *(unsigned long long*)(dp + 8) = (unsigned long long)pk2(v1[0], v1[1]) | ((unsigned long long)pk2(v1[2], v1[3]) << 32);
                    } else {
                        st8(base + (size_t)row * 512 + cs, v0, v1);
                    }
                }
            }
        }
    }
};
struct EpiMemKV {
    static constexpr bool PERM = true, NEEDS_R = false;
    bf16_t* kv;
    DI void operator()(const AccT& acc, const Unit& u, int wr, int wc, int fr, int fq, const LAS float* rt) const {
        const int colt = u.pn * BM; bf16_t* base = kv + (size_t)(u.z * 2 + (colt >> 9)) * 2048 * 512; const int cbase = (colt & 511) + wc * 32 + 8 * fq;
#pragma unroll
        for (int ai = 0; ai < 2; ++ai)
#pragma unroll
            for (int m = 0; m < 4; ++m) { const int row = u.pm * BM + ai * HALF + wr * 64 + m * 16 + fr;
#pragma unroll
                for (int bj = 0; bj < 2; ++bj) st8(base + (size_t)row * 512 + cbase + bj * HALF, acc[ai][bj][m][0], acc[ai][bj][m][1]); }
    }
};
template <int ACT, bool RS> struct EpiBf16 {
    static constexpr bool PERM = true, NEEDS_R = RS;
    bf16_t* O; int ldc; float scale; const float* part;
    DI void operator()(const AccT& acc, const Unit& u, int wr, int wc, int fr, int fq, const LAS float* rt) const {
        const int col0 = u.pn * BM + wc * 32 + 8 * fq;
#pragma unroll
        for (int ai = 0; ai < 2; ++ai)
#pragma unroll
            for (int m = 0; m < 4; ++m) { const int row = u.pm * BM + ai * HALF + wr * 64 + m * 16 + fr; const float rr = RS ? rt[ai * HALF + wr * 64 + m * 16 + fr] * scale : scale;
#pragma unroll
                for (int bj = 0; bj < 2; ++bj) { f32x4 v0 = acc[ai][bj][m][0] * rr, v1 = acc[ai][bj][m][1] * rr;
                    if (ACT == 1) {
#pragma unroll
                        for (int k = 0; k < 4; ++k) { v0[k] = sigmoidf_(v0[k]); v1[k] = sigmoidf_(v1[k]); } }
                    if (ACT == 2) {
#pragma unroll
                        for (int k = 0; k < 4; ++k) { const float a = fmaxf(v0[k], 0.f), b = fmaxf(v1[k], 0.f); v0[k] = a * a; v1[k] = b * b; } }
                    st8(O + (size_t)row * ldc + col0 + bj * HALF, v0, v1); } }
    }
};
struct EpiGlu {
    static constexpr bool PERM = true, NEEDS_R = false;
    bf16_t* O;
    DI void operator()(const AccT& acc, const Unit& u, int wr, int wc, int fr, int fq, const LAS float* rt) const {
        const int col0 = u.pn * HALF + wc * 32 + 8 * fq;
#pragma unroll
        for (int ai = 0; ai < 2; ++ai)
#pragma unroll
            for (int m = 0; m < 4; ++m) { const int row = u.pm * BM + ai * HALF + wr * 64 + m * 16 + fr;
                f32x4 v0, v1;
#pragma unroll
                for (int k = 0; k < 4; ++k) { v0[k] = acc[ai][0][m][0][k] * sigmoidf_(acc[ai][1][m][0][k]); v1[k] = acc[ai][0][m][1][k] * sigmoidf_(acc[ai][1][m][1][k]); }
                st8(O + (size_t)row * 512 + col0, v0, v1); }
    }
};
struct EpiSloc {
    static constexpr bool PERM = true, NEEDS_R = false;
    float* S;
    DI void operator()(const AccT& acc, const Unit& u, int wr, int wc, int fr, int fq, const LAS float* rt) const {
        const int col0 = wc * 32 + 8 * fq;
#pragma unroll
        for (int ai = 0; ai < 2; ++ai)
#pragma unroll
            for (int m = 0; m < 4; ++m) { const int row = u.pm * BM + ai * HALF + wr * 64 + m * 16 + fr;
                float* p = S + ((size_t)(u.z * SSM_M2 + row) * 128 + col0);
                *(f32x4*)p = acc[ai][0][m][0]; *(f32x4*)(p + 4) = acc[ai][0][m][1]; }
    }
};
struct EpiGelu {
    static constexpr bool PERM = true, NEEDS_R = false;
    bf16_t* Y;
    DI void operator()(const AccT& acc, const Unit& u, int wr, int wc, int fr, int fq, const LAS float* rt) const {
        const int col0 = u.pn * BM + wc * 32 + 8 * fq;
#pragma unroll
        for (int ai = 0; ai < 2; ++ai)
#pragma unroll
            for (int m = 0; m < 4; ++m) { const int row = u.pm * BM + ai * HALF + wr * 64 + m * 16 + fr; const int b = row >> 7, c = row & 127;
#pragma unroll
                for (int bj = 0; bj < 2; ++bj) { const int n = col0 + bj * HALF, t = n >> 4, co = n & 15;
                    f32x4 v0 = acc[ai][bj][m][0], v1 = acc[ai][bj][m][1];
#pragma unroll
                    for (int k = 0; k < 4; ++k) { float x = v0[k]; v0[k] = x * __builtin_amdgcn_rcpf(1.f + __builtin_amdgcn_exp2f(x * (-2.3022082f - 0.10294324f * (x * x))));
                        x = v1[k]; v1[k] = x * __builtin_amdgcn_rcpf(1.f + __builtin_amdgcn_exp2f(x * (-2.3022082f - 0.10294324f * (x * x)))); }
                    st8(Y + ((size_t)(b * SEQ + c * SSM_T + t) * 512 + u.z * 16 + co), v0, v1); } }
    }
};
struct EpiMerge {
    static constexpr bool PERM = true, NEEDS_R = false;
    const bf16_t* gates; bf16_t* O;
    DI void operator()(const AccT& acc, const Unit& u, int wr, int wc, int fr, int fq, const LAS float* rt) const {
        const int col0 = u.pn * BM + wc * 32 + 8 * fq;
#pragma unroll
        for (int ai = 0; ai < 2; ++ai) {
            u32x4 gw[4][2], pw[4][2];
#pragma unroll
            for (int m = 0; m < 4; ++m) { const int row = u.pm * BM + ai * HALF + wr * 64 + m * 16 + fr;
#pragma unroll
                for (int bj = 0; bj < 2; ++bj) { const int col = col0 + bj * HALF;
                    gw[m][bj] = *(const u32x4*)(gates + (size_t)row * 3072 + u.z * 1024 + col);
                    if (u.z > 0) pw[m][bj] = *(const u32x4*)(O + (size_t)row * 1024 + col); else pw[m][bj] = (u32x4){0u, 0u, 0u, 0u}; } }
            __builtin_amdgcn_sched_barrier(0);
#pragma unroll
            for (int m = 0; m < 4; ++m) { const int row = u.pm * BM + ai * HALF + wr * 64 + m * 16 + fr;
#pragma unroll
                for (int bj = 0; bj < 2; ++bj) { const int col = col0 + bj * HALF; const u32x4 g4 = gw[m][bj], p4 = pw[m][bj];
                    f32x4 v0 = acc[ai][bj][m][0], v1 = acc[ai][bj][m][1];
                    v0[0] = v0[0] * bf2f(g4.x & 0xffffu) + bf2f(p4.x & 0xffffu); v0[1] = v0[1] * bf2f(g4.x >> 16) + bf2f(p4.x >> 16);
                    v0[2] = v0[2] * bf2f(g4.y & 0xffffu) + bf2f(p4.y & 0xffffu); v0[3] = v0[3] * bf2f(g4.y >> 16) + bf2f(p4.y >> 16);
                    v1[0] = v1[0] * bf2f(g4.z & 0xffffu) + bf2f(p4.z & 0xffffu); v1[1] = v1[1] * bf2f(g4.z >> 16) + bf2f(p4.z >> 16);
                    v1[2] = v1[2] * bf2f(g4.w & 0xffffu) + bf2f(p4.w & 0xffffu); v1[3] = v1[3] * bf2f(g4.w >> 16) + bf2f(p4.w >> 16);
                    st8(O + (size_t)row * 1024 + col, v0, v1); } }
        }
    }
};
struct EpiResid {
    static constexpr bool PERM = true, NEEDS_R = false;
    const float* base; float* out; bf16_t* hb; const float* gain; float* part;
    DI void operator()(const AccT& acc, const Unit& u, int wr, int wc, int fr, int fq, const LAS float* rt) const {
        const int col0 = u.pn * BM + wc * 32 + 8 * fq;
        f32x4 gv[2][2];
#pragma unroll
        for (int bj = 0; bj < 2; ++bj) { gv[bj][0] = *(const f32x4*)(gain + col0 + bj * HALF); gv[bj][1] = *(const f32x4*)(gain + col0 + bj * HALF + 4); }
#pragma unroll
        for (int ai = 0; ai < 2; ++ai)
#pragma unroll
            for (int mh = 0; mh < 2; ++mh) {
                f32x4 bx[2][2][2];
#pragma unroll
                for (int mm = 0; mm < 2; ++mm) { const int row = u.pm * BM + ai * HALF + wr * 64 + (mh * 2 + mm) * 16 + fr;
#pragma unroll
                    for (int bj = 0; bj < 2; ++bj) { const size_t o = (size_t)row * DM + col0 + bj * HALF; bx[mm][bj][0] = *(const f32x4*)(base + o); bx[mm][bj][1] = *(const f32x4*)(base + o + 4); } }
                __builtin_amdgcn_sched_barrier(0);
#pragma unroll
                for (int mm = 0; mm < 2; ++mm) { const int m = mh * 2 + mm; const int row = u.pm * BM + ai * HALF + wr * 64 + m * 16 + fr; float ss = 0.f;
#pragma unroll
                    for (int bj = 0; bj < 2; ++bj) { const size_t o = (size_t)row * DM + col0 + bj * HALF;
                        const f32x4 x0 = bx[mm][bj][0] + acc[ai][bj][m][0], x1 = bx[mm][bj][1] + acc[ai][bj][m][1];
                        *(f32x4*)(out + o) = x0; *(f32x4*)(out + o + 4) = x1;
                        ss += (x0[0] * x0[0] + x0[1] * x0[1]) + (x0[2] * x0[2] + x0[3] * x0[3]) + (x1[0] * x1[0] + x1[1] * x1[1]) + (x1[2] * x1[2] + x1[3] * x1[3]);
                        st8(hb + o, x0 * gv[bj][0], x1 * gv[bj][1]); }
                    ss += __shfl_xor(ss, 16); ss += __shfl_xor(ss, 32);
                    if (fq == 0) part[(size_t)row * 16 + u.pn * 4 + wc] = ss; }
            }
    }
};

struct GmArgs { const bf16_t* Ah; const bf16_t* Wg; const bf16_t* Y; long zY; const bf16_t* Wb; bf16_t* gs; bf16_t* O; const float* part; };
DI void gm_unit_info(const GmArgs& a, const Unit& u, const char*& cA, const char*& cB, int& ld, int& nt) {
    const int z = u.z >> 1;
    if (u.z & 1) { ld = 512; nt = 8; cA = (const char*)(a.Y + (size_t)z * a.zY) + (size_t)u.pm * 256 * 512 * 2; cB = (const char*)a.Wb + ((size_t)z * 1024 + u.pn * 256) * 512 * 2; }
    else { ld = 1024; nt = 16; cA = (const char*)a.Ah + (size_t)u.pm * 256 * 1024 * 2; cB = (const char*)a.Wg + ((size_t)z * 1024 + u.pn * 256) * 1024 * 2; }
}
DI void gm_epilogue(const GmArgs& a, const AccT& acc, const Unit& u, int wr, int wc, int fr, int fq, const LAS float* rt) {
    const int z = u.z >> 1; const int colL = wc * 32 + 8 * fq;
    bf16_t* gsb = a.gs + (size_t)blockIdx.x * 65536;
    if (!(u.z & 1)) {
#pragma unroll
        for (int ai = 0; ai < 2; ++ai)
#pragma unroll
            for (int m = 0; m < 4; ++m) { const int rl = ai * HALF + wr * 64 + m * 16 + fr; const float rrn = rt[rl] * -1.4426950408889634f;
#pragma unroll
                for (int bj = 0; bj < 2; ++bj) { f32x4 v0 = acc[ai][bj][m][0] * rrn, v1 = acc[ai][bj][m][1] * rrn;
#pragma unroll
                    for (int k = 0; k < 4; ++k) { v0[k] = __builtin_amdgcn_rcpf(1.f + __builtin_amdgcn_exp2f(v0[k])); v1[k] = __builtin_amdgcn_rcpf(1.f + __builtin_amdgcn_exp2f(v1[k])); }
                    st8(gsb + rl * 256 + colL + bj * HALF, v0, v1); } }
    } else {
#pragma unroll
        for (int ai = 0; ai < 2; ++ai) {
            u32x4 gw[4][2], pw[4][2];
#pragma unroll
            for (int m = 0; m < 4; ++m) { const int rl = ai * HALF + wr * 64 + m * 16 + fr; const int row = u.pm * BM + rl;
#pragma unroll
                for (int bj = 0; bj < 2; ++bj) { const int col = u.pn * BM + colL + bj * HALF;
                    gw[m][bj] = *(const u32x4*)(gsb + rl * 256 + colL + bj * HALF);
                    if (z > 0) pw[m][bj] = *(const u32x4*)(a.O + (size_t)row * 1024 + col); else pw[m][bj] = (u32x4){0u, 0u, 0u, 0u}; } }
            __builtin_amdgcn_sched_barrier(0);
#pragma unroll
            for (int m = 0; m < 4; ++m) { const int rl = ai * HALF + wr * 64 + m * 16 + fr; const int row = u.pm * BM + rl;
#pragma unroll
                for (int bj = 0; bj < 2; ++bj) { const int col = u.pn * BM + colL + bj * HALF; const u32x4 g4 = gw[m][bj], p4 = pw[m][bj];
                    f32x4 v0 = acc[ai][bj][m][0], v1 = acc[ai][bj][m][1];
                    v0[0] = v0[0] * bf2f(g4.x & 0xffffu) + bf2f(p4.x & 0xffffu); v0[1] = v0[1] * bf2f(g4.x >> 16) + bf2f(p4.x >> 16);
                    v0[2] = v0[2] * bf2f(g4.y & 0xffffu) + bf2f(p4.y & 0xffffu); v0[3] = v0[3] * bf2f(g4.y >> 16) + bf2f(p4.y >> 16);
                    v1[0] = v1[0] * bf2f(g4.z & 0xffffu) + bf2f(p4.z & 0xffffu); v1[1] = v1[1] * bf2f(g4.z >> 16) + bf2f(p4.z >> 16);
                    v1[2] = v1[2] * bf2f(g4.w & 0xffffu) + bf2f(p4.w & 0xffffu); v1[3] = v1[3] * bf2f(g4.w >> 16) + bf2f(p4.w >> 16);
                    st8(a.O + (size_t)row * 1024 + col, v0, v1); } }
        }
    }
}
struct SchedGM {
    int nM, nN, G, c;
    DI bool next(int i, Unit& u) const { const long L = (long)(i / 6) * G + c; if (L >= (long)nM * nN) return false; tile_decode((int)L, nM, nN, u.pm, u.pn); u.z = i % 6; return true; }
};
DI void gemm_phase_gm(LAS unsigned char* lds, const GmArgs ga, const SchedGM& S) {
    const int tid = opaque(threadIdx.x), wid = __builtin_amdgcn_readfirstlane(tid >> 6), lane = tid & 63, wr = wid >> 2, wc = wid & 3, fr = lane & 15, fq = lane >> 4;
    unsigned RA2, RB2, C2;
    { int R, C; stage_rc(tid * 16, R, C); const int Rb = (R & ~31) + perm32(R & 31); RA2 = (unsigned)R * 2u; RB2 = (unsigned)Rb * 2u; C2 = (unsigned)C * 2u; }
    const size_t kstep = (size_t)(BK * 2);
    const unsigned ldsw = (unsigned)wid * 1024u;
    const int aoff = lds_byte(wr * 64 + fr, fq * 8), boff = lds_byte(wc * 32 + fr, fq * 8);
#define PG8_SA(b, h) (((b) * 2 + (h)) * HTB)
#define PG8_SB(b, h) ((4 + (b) * 2 + (h)) * HTB)
#define GM_STAGE(bufoff, gbase, R2, ld_) do { _Pragma("unroll") for (int _i = 0; _i < 2; ++_i) \
        __builtin_amdgcn_global_load_lds((const unsigned*)((const char*)(gbase) + (size_t)_i * 128 * (size_t)(ld_) + ((R2) * (unsigned)(ld_) + C2)), (LAS unsigned*)(lds + (bufoff) + ldsw + _i * 8192), 16, 0, 0); } while (0)
#define PG8_LDA(dst, b, h) do { _Pragma("unroll") for (int m = 0; m < 4; ++m) _Pragma("unroll") for (int k = 0; k < 2; ++k) dst[m][k] = *(const LAS bf16x8*)(lds + PG8_SA(b, h) + aoff + m * 2048 + k * 1024); } while (0)
#define PG8_LDB(dst, b, h) do { _Pragma("unroll") for (int n = 0; n < 2; ++n) _Pragma("unroll") for (int k = 0; k < 2; ++k) dst[n][k] = *(const LAS bf16x8*)(lds + PG8_SB(b, h) + boff + n * 2048 + k * 1024); } while (0)
#define PG8_MMA(ai, bj, At, Bt) do { __builtin_amdgcn_s_setprio(1); _Pragma("unroll") for (int m = 0; m < 4; ++m) _Pragma("unroll") for (int n = 0; n < 2; ++n) _Pragma("unroll") for (int k = 0; k < 2; ++k) \
        acc[ai][bj][m][n] = __builtin_amdgcn_mfma_f32_16x16x32_bf16(Bt[n][k], At[m][k], acc[ai][bj][m][n], 0, 0, 0); __builtin_amdgcn_s_setprio(0); } while (0)
#define PG8_WAIT_V(n) asm volatile("s_waitcnt vmcnt(" #n ")" ::: "memory")
#define PG8_WAIT_L(n) asm volatile("s_waitcnt lgkmcnt(" #n ")" ::: "memory")
#define PG8_BAR __builtin_amdgcn_s_barrier()
#define PG8_SCHED __builtin_amdgcn_sched_barrier(0)
#define GM_RFILL(u_, ui_) do { if (tid < 256) { const f32x4* pp_ = (const f32x4*)(ga.part + (size_t)((u_).pm * BM + tid) * 16); \
        const f32x4 a_ = pp_[0], b_ = pp_[1], c_ = pp_[2], d_ = pp_[3]; const f32x4 s_ = (a_ + b_) + (c_ + d_); \
        ((LAS float*)(lds + STAGE_BYTES))[(ui_) * 256 + tid] = rsqrtf(((s_[0] + s_[1]) + (s_[2] + s_[3])) * (1.f / DM) + RMS_EPS); } } while (0)
    Unit cur, nxt; int ui = 0;
    if (!S.next(0, cur)) return;
    { Unit uu; for (int i = 0; i < 8 && S.next(6 * i, uu); ++i) GM_RFILL(uu, i); }
    f32x4 acc[2][2][4][2];
#pragma unroll
    for (int a = 0; a < 2; ++a)
#pragma unroll
        for (int b = 0; b < 2; ++b)
#pragma unroll
            for (int m = 0; m < 4; ++m)
#pragma unroll
                for (int n = 0; n < 2; ++n) acc[a][b][m][n] = (f32x4){0.f, 0.f, 0.f, 0.f};
    bf16x8 At[4][2], B0[2][2], B1[2][2];
    const char* cA; const char* cB; int ldc_, nt;
    gm_unit_info(ga, cur, cA, cB, ldc_, nt);
    size_t hsc = (size_t)HALF * ldc_ * 2;
    GM_STAGE(PG8_SB(0, 0), cB, RB2, ldc_); GM_STAGE(PG8_SB(0, 1), cB + hsc, RB2, ldc_); GM_STAGE(PG8_SA(0, 0), cA, RA2, ldc_); GM_STAGE(PG8_SA(0, 1), cA + hsc, RA2, ldc_);
    if (wr == 1) PG8_BAR;
    PG8_WAIT_V(2); PG8_BAR;
    GM_STAGE(PG8_SB(1, 0), cB + kstep, RB2, ldc_); GM_STAGE(PG8_SA(1, 0), cA + kstep, RA2, ldc_); GM_STAGE(PG8_SB(1, 1), cB + hsc + kstep, RB2, ldc_);
    PG8_WAIT_V(6); PG8_BAR;
    for (;;) {
        const bool has_next = S.next(ui + 1, nxt);
        const char* nA = cA; const char* nB = cB; int ldn = ldc_, ntn = nt;
        if (has_next) gm_unit_info(ga, nxt, nA, nB, ldn, ntn);
        const size_t hsn = (size_t)HALF * ldn * 2;
        for (int t = 0; t < nt; t += 2) {
            const bool last = (t == nt - 2);
            const char* a1 = cA + (size_t)(t + 1) * kstep;
            const char* a2 = last ? nA : cA + (size_t)(t + 2) * kstep; const char* b2 = last ? nB : cB + (size_t)(t + 2) * kstep;
            const char* a3 = a2 + kstep; const char* b3 = b2 + kstep;
            const int ld2 = last ? ldn : ldc_; const size_t hs2 = last ? hsn : hsc;
            PG8_LDB(B0, 0, 0); PG8_LDB(B1, 0, 1); PG8_SCHED; PG8_LDA(At, 0, 0); GM_STAGE(PG8_SA(1, 1), a1 + hsc, RA2, ldc_);
            PG8_WAIT_V(8); PG8_WAIT_L(0); PG8_BAR; PG8_MMA(0, 0, At, B0); PG8_MMA(0, 1, At, B1); PG8_BAR; PG8_SCHED;
            PG8_LDA(At, 0, 1); GM_STAGE(PG8_SB(0, 0), b2, RB2, ld2); GM_STAGE(PG8_SB(0, 1), b2 + hs2, RB2, ld2); GM_STAGE(PG8_SA(0, 0), a2, RA2, ld2);
            PG8_WAIT_V(8); PG8_WAIT_L(0); PG8_BAR; PG8_MMA(1, 0, At, B0); PG8_MMA(1, 1, At, B1); PG8_BAR; PG8_SCHED;
            PG8_LDB(B0, 1, 0); PG8_LDB(B1, 1, 1); PG8_SCHED; PG8_LDA(At, 1, 0); GM_STAGE(PG8_SA(0, 1), a2 + hs2, RA2, ld2);
            PG8_WAIT_V(8); PG8_WAIT_L(0); PG8_BAR; PG8_MMA(0, 0, At, B0); PG8_MMA(0, 1, At, B1); PG8_BAR; PG8_SCHED;
            PG8_LDA(At, 1, 1); GM_STAGE(PG8_SB(1, 0), b3, RB2, ld2); GM_STAGE(PG8_SB(1, 1), b3 + hs2, RB2, ld2); GM_STAGE(PG8_SA(1, 0), a3, RA2, ld2);
            PG8_WAIT_V(8); PG8_WAIT_L(0); PG8_BAR; PG8_MMA(1, 0, At, B0); PG8_MMA(1, 1, At, B1); PG8_BAR; PG8_SCHED;
        }
        if (wr == 0) PG8_BAR;
        gm_epilogue(ga, acc, cur, wr, wc, fr, fq, (const LAS float*)(lds + STAGE_BYTES) + ((ui / 6) & 7) * 256);
        if (!has_next) break;
#pragma unroll
        for (int a = 0; a < 2; ++a)
#pragma unroll
            for (int b = 0; b < 2; ++b)
#pragma unroll
                for (int m = 0; m < 4; ++m)
#pragma unroll
                    for (int n = 0; n < 2; ++n) acc[a][b][m][n] = (f32x4){0.f, 0.f, 0.f, 0.f};
        cur = nxt; cA = nA; cB = nB; ldc_ = ldn; nt = ntn; hsc = hsn; ++ui;
        if (wr == 1) PG8_BAR;
    }
    PG8_WAIT_V(0);
    PG8_BAR;
#undef GM_RFILL
#undef GM_STAGE
#undef PG8_SA
#undef PG8_SB
#undef PG8_LDA
#undef PG8_LDB
#undef PG8_MMA
#undef PG8_WAIT_V
#undef PG8_WAIT_L
#undef PG8_BAR
#undef PG8_SCHED
}
}

DI f32x16 mfma32(bf16x8 a, bf16x8 b, f32x16 c) { return __builtin_amdgcn_mfma_f32_32x32x16_bf16(a, b, c, 0, 0, 0); }
DI s16x4 vtr(const LAS unsigned char* p) { return __builtin_bit_cast(s16x4, __builtin_amdgcn_ds_read_tr16_b64_v4i16((LAS v4i16_t*)p)); }
DI int crow(int r, int hi) { return (r & 3) + 8 * (r >> 2) + 4 * hi; }
DI bf16x8 pack8(const float* w) { u32x4 p; p.x = pk2(w[0], w[1]); p.y = pk2(w[2], w[3]); p.z = pk2(w[4], w[5]); p.w = pk2(w[6], w[7]); return __builtin_bit_cast(bf16x8, p); }

template <bool MASK>
DI void sb_block(const f32x16& p, int kvbase, int qrow, int hi, float& carry, bf16x8& f0, bf16x8& f1) {
    float bt[16], om[16];
#pragma unroll
    for (int i = 0; i < 16; ++i) { const float e = __builtin_amdgcn_exp2f(-p[i]); float b = __builtin_amdgcn_rcpf(1.f + e); float o = 1.f - b;
        if (MASK) { const bool valid = (kvbase + crow(i, hi) < qrow); b = valid ? b : 0.f; o = valid ? o : 1.f; }
        bt[i] = b; om[i] = o; }
    float plo[4], phi[4];
#pragma unroll
    for (int g = 0; g < 4; ++g) { const float gp = (om[4 * g] * om[4 * g + 1]) * (om[4 * g + 2] * om[4 * g + 3]);
        auto rr = __builtin_amdgcn_permlane32_swap(__float_as_uint(gp), __float_as_uint(gp), false, false);
        plo[g] = __uint_as_float(rr[0]); phi[g] = __uint_as_float(rr[1]); }
    float T[4]; T[3] = 1.f; T[2] = plo[3] * phi[3]; T[1] = T[2] * (plo[2] * phi[2]); T[0] = T[1] * (plo[1] * phi[1]);
    const float tot = T[0] * (plo[0] * phi[0]);
    float w[16];
#pragma unroll
    for (int g = 0; g < 4; ++g) { const float w3 = carry * T[g] * (hi ? 1.f : phi[g]);
        const float w2 = w3 * om[4 * g + 3], w1 = w2 * om[4 * g + 2], w0 = w1 * om[4 * g + 1];
        w[4 * g + 3] = bt[4 * g + 3] * w3; w[4 * g + 2] = bt[4 * g + 2] * w2; w[4 * g + 1] = bt[4 * g + 1] * w1; w[4 * g] = bt[4 * g] * w0; }
    carry *= tot;
    f0 = pack8(w); f1 = pack8(w + 8);
}

constexpr int SB_KP = 144, SB_VP = 192, SB_FLAGS = 2 * 64 * SB_KP + 2 * 64 * SB_VP;
DI void sb_unit(int b, int h, int qb, const bf16_t* QO, bf16_t* Ob, const bf16_t* K, const bf16_t* V, LAS unsigned char* lds) {
    const int tid = opaque(threadIdx.x), lane = tid & 63, wid = __builtin_amdgcn_readfirstlane(tid >> 6), r32 = lane & 31, hi = lane >> 5;
    const size_t rowbase = (size_t)b * SEQ;
    const int q0w = qb * 256 + wid * 32, qrow = q0w + r32;
    const bf16_t* qp = QO + (rowbase + qrow) * 512 + h * 64;
    bf16x8 qf[4];
#pragma unroll
    for (int ks = 0; ks < 4; ++ks) qf[ks] = *(const bf16x8*)(qp + ks * 16 + hi * 8);
    const int nt = 4 * qb + 4;
    const int lrow = tid >> 3, lch = tid & 7;
    const bf16_t* kg = K + (rowbase + lrow) * 512 + h * 64 + lch * 8;
    const bf16_t* vg = V + (rowbase + lrow) * 512 + h * 64 + lch * 8;
    LAS unsigned char* Kb = lds; LAS unsigned char* Vb = lds + 2 * 64 * SB_KP;
    LAS unsigned char* flags = lds + SB_FLAGS;
    const int kst = lrow * SB_KP + lch * 16, vst = lrow * SB_VP + lch * 16;
    u32x4 kr = *(const u32x4*)(kg + (size_t)(nt - 1) * 64 * 512), vr = *(const u32x4*)(vg + (size_t)(nt - 1) * 64 * 512);
    *(LAS u32x4*)(Kb + kst) = kr; *(LAS u32x4*)(Vb + vst) = vr;
    __syncthreads();
    f32x16 o0, o1;
#pragma unroll
    for (int i = 0; i < 16; ++i) { o0[i] = 0.f; o1[i] = 0.f; }
    float carry = 1.f; int cur = 0;
    const int vlane = (4 * hi + ((lane & 15) >> 2)) * SB_VP + (16 * ((lane >> 4) & 1) + 4 * (lane & 3)) * 2;
    for (int t = nt - 1; t >= 0; --t) {
        if (t > 0) { kr = *(const u32x4*)(kg + (size_t)(t - 1) * 64 * 512); vr = *(const u32x4*)(vg + (size_t)(t - 1) * 64 * 512); }
        const LAS unsigned char* Kc = Kb + cur * 64 * SB_KP; const LAS unsigned char* Vc = Vb + cur * 64 * SB_VP;
        const bool wdone = !__any(carry >= 1e-30f);
        if (64 * t < q0w + 31 && !wdone) {
            f32x16 p0, p1;
#pragma unroll
            for (int i = 0; i < 16; ++i) { p0[i] = 0.f; p1[i] = 0.f; }
            { bf16x8 a0[4], a1[4];
#pragma unroll
              for (int ks = 0; ks < 4; ++ks) { a0[ks] = *(const LAS bf16x8*)(Kc + r32 * SB_KP + (ks * 16 + hi * 8) * 2); a1[ks] = *(const LAS bf16x8*)(Kc + (32 + r32) * SB_KP + (ks * 16 + hi * 8) * 2); }
              __builtin_amdgcn_sched_barrier(0);
#pragma unroll
              for (int ks = 0; ks < 4; ++ks) { p0 = mfma32(a0[ks], qf[ks], p0); p1 = mfma32(a1[ks], qf[ks], p1); } }
            s16x4 vlo[8], vhh[8];
#pragma unroll
            for (int kk = 0; kk < 4; ++kk) { const LAS unsigned char* vp = Vc + vlane + 16 * kk * SB_VP;
                vlo[2 * kk] = vtr(vp); vhh[2 * kk] = vtr(vp + 8 * SB_VP); vlo[2 * kk + 1] = vtr(vp + 64); vhh[2 * kk + 1] = vtr(vp + 64 + 8 * SB_VP); }
            __builtin_amdgcn_sched_barrier(0);
            bf16x8 fr[4];
            if (64 * t + 63 >= q0w) { sb_block<true>(p1, 64 * t + 32, qrow, hi, carry, fr[2], fr[3]); sb_block<true>(p0, 64 * t, qrow, hi, carry, fr[0], fr[1]); }
            else { sb_block<false>(p1, 64 * t + 32, qrow, hi, carry, fr[2], fr[3]); sb_block<false>(p0, 64 * t, qrow, hi, carry, fr[0], fr[1]); }
            __builtin_amdgcn_sched_barrier(0);
#pragma unroll
            for (int kk = 0; kk < 4; ++kk) {
                { const bf16x8 vb = __builtin_shufflevector(vlo[2 * kk], vhh[2 * kk], 0, 1, 2, 3, 4, 5, 6, 7); o0 = mfma32(fr[kk], vb, o0); }
                { const bf16x8 vb = __builtin_shufflevector(vlo[2 * kk + 1], vhh[2 * kk + 1], 0, 1, 2, 3, 4, 5, 6, 7); o1 = mfma32(fr[kk], vb, o1); }
            }
        }
        if (lane == 0) flags[(t & 1) * 8 + wid] = __any(carry >= 1e-30f) ? 0 : 1;
        if (t > 0) { *(LAS u32x4*)(Kb + (cur ^ 1) * 64 * SB_KP + kst) = kr; *(LAS u32x4*)(Vb + (cur ^ 1) * 64 * SB_VP + vst) = vr; }
        __syncthreads(); cur ^= 1;
        const unsigned long long fl = *(const LAS unsigned long long*)(flags + (t & 1) * 8);
        if (fl == 0x0101010101010101ull) break;
    }
    bf16_t* ob = Ob + (rowbase + q0w) * 512 + h * 64 + r32;
#pragma unroll
    for (int i = 0; i < 16; ++i) { const int r = crow(i, hi); ob[(size_t)r * 512] = f2bf(o0[i]); ob[(size_t)r * 512 + 32] = f2bf(o1[i]); }
}

constexpr int A2_KP = 272, A2_VP = 320, A2_WS = 2 * 64 * A2_KP + 2 * 64 * A2_VP;
DI void bcast_rows(LAS float* wsf, float v, int r32, int hi, float (&out)[16]) {
    if (hi == 0) wsf[r32] = v;
    asm volatile("s_waitcnt lgkmcnt(0)" ::: "memory");
#pragma unroll
    for (int i = 0; i < 16; ++i) out[i] = wsf[crow(i, hi)];
    asm volatile("s_waitcnt lgkmcnt(0)" ::: "memory");
}
DI float half_swap_max(float m) { auto rr = __builtin_amdgcn_permlane32_swap(__float_as_uint(m), __float_as_uint(m), false, false); return fmaxf(__uint_as_float(rr[0]), __uint_as_float(rr[1])); }
DI float half_swap_sum(float m) { auto rr = __builtin_amdgcn_permlane32_swap(__float_as_uint(m), __float_as_uint(m), false, false); return __uint_as_float(rr[0]) + __uint_as_float(rr[1]); }

template <bool DIFF>
DI void attn2_unit(int qb, const bf16_t* QO  , bf16_t* Ob, const bf16_t* K, const bf16_t* V  ,
                   int ntile, float lam, const float* gain, float post, LAS unsigned char* lds) {
    const int tid = opaque(threadIdx.x), lane = tid & 63, wid = __builtin_amdgcn_readfirstlane(tid >> 6), r32 = lane & 31, hi = lane >> 5;
    const int q0w = qb * 256 + wid * 32, qrow = q0w + r32;
    const bf16_t* qp = QO + (size_t)qrow * 512;
    LAS unsigned char* qst = lds + A2_WS + 2048 + wid * 8192 + lane * 16;
#pragma unroll
    for (int ks = 0; ks < 8; ++ks) *(LAS bf16x8*)(qst + ks * 1024) = *(const bf16x8*)(qp + ks * 16 + hi * 8);
    const int lrow = tid >> 3, lch = tid & 7;
    const bf16_t* kg = K + (size_t)lrow * 512 + lch * 16;
    const bf16_t* vg = V + (size_t)lrow * 512 + lch * 16;
    LAS unsigned char* Kb = lds; LAS unsigned char* Vb = lds + 2 * 64 * A2_KP;
    LAS float* wsf = (LAS float*)(lds + A2_WS) + wid * 64;
    const int kst = lrow * A2_KP + lch * 32, vst = lrow * A2_VP + lch * 32;
    const int vlane = (4 * hi + ((lane & 15) >> 2)) * A2_VP + (16 * ((lane >> 4) & 1) + 4 * (lane & 3)) * 2;
    constexpr int NC = DIFF ? 2 : 1;
    float mref[2] = {-1e30f, -1e30f}, ls[2] = {0.f, 0.f};
    bool ref0[2] = {false, false}, inited[2] = {false, false};
    f32x16 o1[4], o2[4];
#pragma unroll
    for (int d = 0; d < 4; ++d)
#pragma unroll
        for (int i = 0; i < 16; ++i) { o1[d][i] = 0.f; o2[d][i] = 0.f; }
    u32x4 kr0 = *(const u32x4*)(kg), kr1 = *(const u32x4*)(kg + 8), vr0 = *(const u32x4*)(vg), vr1 = *(const u32x4*)(vg + 8);
    *(LAS u32x4*)(Kb + kst) = kr0; *(LAS u32x4*)(Kb + kst + 16) = kr1; *(LAS u32x4*)(Vb + vst) = vr0; *(LAS u32x4*)(Vb + vst + 16) = vr1;
    __syncthreads();
    int cur = 0;
    for (int t = 0; t < ntile; ++t) {
        const bool more = (t + 1 < ntile);
        if (more) { const size_t go = (size_t)(t + 1) * 64 * 512; kr0 = *(const u32x4*)(kg + go); kr1 = *(const u32x4*)(kg + go + 8); vr0 = *(const u32x4*)(vg + go); vr1 = *(const u32x4*)(vg + go + 8); }
        const LAS unsigned char* Kc = Kb + cur * 64 * A2_KP; const LAS unsigned char* Vc = Vb + cur * 64 * A2_VP;
#pragma unroll
        for (int blk = 0; blk < 2; ++blk) {
            const int kv0 = 64 * t + 32 * blk;
            if (DIFF && kv0 > q0w + 31) continue;
            const bool diag = DIFF && (kv0 + 31 > q0w);
#pragma unroll
            for (int c = 0; c < NC; ++c) {
                f32x16 p;
#pragma unroll
                for (int i = 0; i < 16; ++i) p[i] = 0.f;
                constexpr int KS = DIFF ? 4 : 8;
                {
                    bf16x8 ka[KS], qa[KS];
#pragma unroll
                    for (int ks = 0; ks < KS; ++ks) { const int kk = c * 4 + ks;
                        ka[ks] = *(const LAS bf16x8*)(Kc + (32 * blk + r32) * A2_KP + (kk * 16 + hi * 8) * 2);
                        qa[ks] = *(const LAS bf16x8*)(qst + kk * 1024); }
                    __builtin_amdgcn_sched_barrier(0);
#pragma unroll
                    for (int ks = 0; ks < KS; ++ks) p = mfma32(ka[ks], qa[ks], p);
                }
                s16x4 vlo[8], vhh[8];
                { const LAS unsigned char* vp = Vc + vlane + 16 * (2 * blk) * A2_VP;
#pragma unroll
                    for (int d0 = 0; d0 < 4; ++d0) { vlo[d0] = vtr(vp + d0 * 64); vhh[d0] = vtr(vp + d0 * 64 + 8 * A2_VP); } }
                __builtin_amdgcn_sched_barrier(0);
                if (diag) {
#pragma unroll
                    for (int i = 0; i < 16; ++i) { if (kv0 + crow(i, hi) > qrow) p[i] = -1e30f; }
                }
                float mm = mref[c]; float w[16]; float sm = 0.f;
                if (ref0[c]) {
#pragma unroll
                    for (int i = 0; i < 16; ++i) { w[i] = __builtin_amdgcn_exp2f(p[i]); sm += w[i]; }
                } else {
#pragma unroll
                    for (int i = 0; i < 16; ++i) { w[i] = __builtin_amdgcn_exp2f(p[i] - mm); sm += w[i]; }
                }
                if (__any(!(sm <= (ref0[c] ? 1.0e30f : 256.f)))) {
                    float tm = fmaxf(p[0], p[1]);
#pragma unroll
                    for (int i = 2; i < 16; i += 2) tm = fmaxf(fmaxf(tm, p[i]), p[i + 1]);
                    tm = half_swap_max(tm);
                    if (!inited[c] && !__any(!(fabsf(tm) <= 40.f))) {
                        mref[c] = 0.f; mm = 0.f; ref0[c] = true;
                    } else {
                        const float mn = fmaxf(mref[c], tm); const float f = __builtin_amdgcn_exp2f(mref[c] - mn); ls[c] *= f; mref[c] = mn; mm = mn; ref0[c] = false;
                        float f16[16]; bcast_rows(wsf, f, r32, hi, f16);
                        if (c == 0) {
#pragma unroll
                            for (int d = 0; d < 4; ++d)
#pragma unroll
                                for (int i = 0; i < 16; ++i) o1[d][i] *= f16[i];
                        } else {
#pragma unroll
                            for (int d = 0; d < 4; ++d)
#pragma unroll
                                for (int i = 0; i < 16; ++i) o2[d][i] *= f16[i];
                        }
                    }
                    inited[c] = true;
                    sm = 0.f;
#pragma unroll
                    for (int i = 0; i < 16; ++i) { w[i] = __builtin_amdgcn_exp2f(p[i] - mm); sm += w[i]; }
                }
                ls[c] += sm;
                const bf16x8 fr0 = pack8(w), fr1 = pack8(w + 8);
                __builtin_amdgcn_sched_barrier(0);
                { const LAS unsigned char* vp = Vc + vlane + 16 * (2 * blk + 1) * A2_VP;
#pragma unroll
                    for (int d0 = 0; d0 < 4; ++d0) { vlo[4 + d0] = vtr(vp + d0 * 64); vhh[4 + d0] = vtr(vp + d0 * 64 + 8 * A2_VP); } }
                __builtin_amdgcn_sched_barrier(0);
#pragma unroll
                for (int s2 = 0; s2 < 2; ++s2) {
#pragma unroll
                    for (int d0 = 0; d0 < 4; ++d0) { const bf16x8 vb = __builtin_shufflevector(vlo[s2 * 4 + d0], vhh[s2 * 4 + d0], 0, 1, 2, 3, 4, 5, 6, 7);
                        if (c == 0) o1[d0] = mfma32(s2 ? fr1 : fr0, vb, o1[d0]); else o2[d0] = mfma32(s2 ? fr1 : fr0, vb, o2[d0]); }
                }
            }
        }
        if (more) { LAS unsigned char* kd = Kb + (cur ^ 1) * 64 * A2_KP + kst; *(LAS u32x4*)kd = kr0; *(LAS u32x4*)(kd + 16) = kr1;
            LAS unsigned char* vd = Vb + (cur ^ 1) * 64 * A2_VP + vst; *(LAS u32x4*)vd = vr0; *(LAS u32x4*)(vd + 16) = vr1; }
        __syncthreads(); cur ^= 1;
    }
    float a1[16], a2[16];
    { const float l1 = half_swap_sum(ls[0]); bcast_rows(wsf, 1.f / l1, r32, hi, a1); }
    if (DIFF) { const float l2 = half_swap_sum(ls[1]); bcast_rows(wsf, -lam / l2, r32, hi, a2); }
#pragma unroll
    for (int d = 0; d < 4; ++d)
#pragma unroll
        for (int i = 0; i < 16; ++i) { o1[d][i] *= a1[i]; if (DIFF) o1[d][i] += o2[d][i] * a2[i]; }
    bf16_t* ob = Ob + (size_t)q0w * 512 + r32;
    if (DIFF) {
        const float g0 = gain[r32] * post, g1 = gain[32 + r32] * post, g2 = gain[64 + r32] * post, g3 = gain[96 + r32] * post;
#pragma unroll
        for (int i = 0; i < 16; ++i) {
            float ss = o1[0][i] * o1[0][i] + o1[1][i] * o1[1][i] + o1[2][i] * o1[2][i] + o1[3][i] * o1[3][i];
            ss += __shfl_xor(ss, 1); ss += __shfl_xor(ss, 2); ss += __shfl_xor(ss, 4); ss += __shfl_xor(ss, 8); ss += __shfl_xor(ss, 16);
            const float rs = rsqrtf(ss * (1.f / 128.f) + RMS_EPS);
            bf16_t* rp = ob + (size_t)crow(i, hi) * 512;
            rp[0] = f2bf(o1[0][i] * rs * g0); rp[32] = f2bf(o1[1][i] * rs * g1); rp[64] = f2bf(o1[2][i] * rs * g2); rp[96] = f2bf(o1[3][i] * rs * g3);
        }
    } else {
#pragma unroll
        for (int i = 0; i < 16; ++i) { bf16_t* rp = ob + (size_t)crow(i, hi) * 512;
            rp[0] = f2bf(o1[0][i]); rp[32] = f2bf(o1[1][i]); rp[64] = f2bf(o1[2][i]); rp[96] = f2bf(o1[3][i]); }
    }
}

DI void transpose_item(const float* W, int K, int N, bf16_t* WT, int drow0, LAS float* scr, int k0, int n0, int lane, bool ropeperm) {
#pragma unroll
    for (int i = 0; i < 32; ++i) { const int kk = 2 * i + (lane >> 5); scr[kk * 33 + (lane & 31)] = W[(size_t)(k0 + kk) * N + n0 + (lane & 31)]; }
    asm volatile("s_waitcnt lgkmcnt(0)" ::: "memory");
    const int c = lane & 7;
#pragma unroll
    for (int j = 0; j < 4; ++j) { const int n = (lane >> 3) + 8 * j;
        int ns = n; if (ropeperm && n < 16) { const int gq = (n >> 2) & 3; ns = (n & 3) | ((gq == 1 ? 2 : gq == 2 ? 1 : gq) << 2); }
        const LAS float* s = scr + (8 * c) * 33 + ns;
        u32x4 o; o.x = pk2(s[0 * 33], s[1 * 33]); o.y = pk2(s[2 * 33], s[3 * 33]); o.z = pk2(s[4 * 33], s[5 * 33]); o.w = pk2(s[6 * 33], s[7 * 33]);
        *(u32x4*)(WT + (size_t)(drow0 + n) * K + k0 + 8 * c) = o; }
    asm volatile("s_waitcnt lgkmcnt(0)" ::: "memory");
}
DI void transpose_mat(const float* W, int K, int N, bf16_t* WT, bool glu, LAS float* scr, int gw, int ngw, int lane, int& goff, int rope_lo = -1, int rope_hi = -1) {
    lane = opaque(lane); gw = opaque_s(gw);
    const int nblk = N / 32, items = (K / 64) * nblk;
    int first = gw - (goff % ngw); if (first < 0) first += ngw;
    goff += items;
    for (int it = first; it < items; it += ngw) { const int kb = it / nblk, nb = it % nblk, n0 = nb * 32;
        int d0 = n0; if (glu) d0 = (n0 < 512) ? (n0 / 128) * 256 + (n0 % 128) : ((n0 - 512) / 128) * 256 + 128 + ((n0 - 512) % 128);
        transpose_item(W, K, N, WT, d0, scr, kb * 64, n0, lane, (n0 >= rope_lo) && (n0 < rope_hi) && ((n0 & 63) == 0)); }
}
DI void rms_row_bf16(const float* xrow, const float* gain, bf16_t* orow, int lane) {
    lane = opaque(lane);
    const f32x4* xr = (const f32x4*)xrow + lane; const f32x4* gr = (const f32x4*)gain + lane;
    f32x4 v[4]; float s = 0.f;
#pragma unroll
    for (int j = 0; j < 4; ++j) { v[j] = xr[64 * j]; s += (v[j].x * v[j].x + v[j].y * v[j].y) + (v[j].z * v[j].z + v[j].w * v[j].w); }
    const float r = rsqrtf(wave_sum(s) * (1.f / DM) + RMS_EPS);
    unsigned long long* o8 = (unsigned long long*)orow + lane;
#pragma unroll
    for (int j = 0; j < 4; ++j) { const f32x4 gq = gr[64 * j];
        o8[64 * j] = (unsigned long long)pk2(v[j].x * r * gq.x, v[j].y * r * gq.y) | ((unsigned long long)pk2(v[j].z * r * gq.z, v[j].w * r * gq.w) << 32); }
}
DI void prep_row_bf16(const float* xrow, const float* gain, bf16_t* orow, float* prow, int lane) {
    lane = opaque(lane);
    const f32x4* xr = (const f32x4*)xrow + lane; const f32x4* gr = (const f32x4*)gain + lane;
    f32x4 v[4]; float s = 0.f;
#pragma unroll
    for (int j = 0; j < 4; ++j) { v[j] = xr[64 * j]; s += (v[j].x * v[j].x + v[j].y * v[j].y) + (v[j].z * v[j].z + v[j].w * v[j].w); }
    s = wave_sum(s);
    if (lane < 16) prow[lane] = (lane == 0) ? s : 0.f;
    unsigned long long* o8 = (unsigned long long*)orow + lane;
#pragma unroll
    for (int j = 0; j < 4; ++j) { const f32x4 gq = gr[64 * j];
        o8[64 * j] = (unsigned long long)pk2(v[j].x * gq.x, v[j].y * gq.y) | ((unsigned long long)pk2(v[j].z * gq.z, v[j].w * gq.w) << 32); }
}
DI void rms_row_f32(float* xrow, const float* gain, int lane) {
    lane = opaque(lane);
    f32x4* xr = (f32x4*)xrow + lane; const f32x4* gr = (const f32x4*)gain + lane;
    f32x4 v[4]; float s = 0.f;
#pragma unroll
    for (int j = 0; j < 4; ++j) { v[j] = xr[64 * j]; s += (v[j].x * v[j].x + v[j].y * v[j].y) + (v[j].z * v[j].z + v[j].w * v[j].w); }
    const float r = rsqrtf(wave_sum(s) * (1.f / DM) + RMS_EPS);
#pragma unroll
    for (int j = 0; j < 4; ++j) xr[64 * j] = v[j] * r * gr[64 * j];
}

struct Params {
    const float* x; const float* mem; const int* pos;
    const float *norm_mix, *w_in, *lam_re, *lam_im, *log_dt, *b_re, *b_im, *c_re, *c_im, *ssm_d, *w_glu, *diff_lambda, *diff_subln, *w_branch, *w_out,
                *norm_cross, *norm_mem, *w_xq, *w_xkv, *w_xo, *norm_mlp, *w_up, *w_down, *norm_final;
    float* out; unsigned char* ws;
};

typedef const __attribute__((address_space(4))) Params* KPtr;
DI KPtr kp_get() { unsigned long long v = (unsigned long long)__builtin_amdgcn_kernarg_segment_ptr(); asm volatile("" : "+s"(v)); return (KPtr)v; }
#define PP (kp_get())

DI void ssm_prep(int l, LAS unsigned char* lds) {
    const int tid = opaque(threadIdx.x);
    LAS f32x2_t* E = (LAS f32x2_t*)lds;
    LAS f32x2_t* Bb = (LAS f32x2_t*)(lds + 33 * 64 * 8);
    LAS f32x2_t* Cc = (LAS f32x2_t*)(lds + 33 * 64 * 8 + 1024 * 8);
    LAS float* Kk = (LAS float*)(lds + 33 * 64 * 8 + 1024 * 8 + 64 * 8);
    bf16_t* toep = (bf16_t*)(PP->ws + WS_TOEP); bf16_t* wst = (bf16_t*)(PP->ws + WS_WST); f32x2_t* lamT = (f32x2_t*)(PP->ws + WS_LAMT);
    const float* lre = PP->lam_re + l * 2048; const float* lim = PP->lam_im + l * 2048; const float* ldt = PP->log_dt + l * 32;
    const float* bre = PP->b_re + (size_t)l * 32768; const float* bim = PP->b_im + (size_t)l * 32768;
    const float* cre = PP->c_re + (size_t)l * 32768; const float* cim = PP->c_im + (size_t)l * 32768; const float* dsk = PP->ssm_d + l * 512;
    for (int un = blockIdx.x; un < 512; un += gridDim.x) {
        const int g = un >> 4, co = un & 15; const float dt = __expf(ldt[g]);
        for (int idx = tid; idx < 33 * 64; idx += 512) { const int tau = idx >> 6, p = idx & 63; const float lr = lre[g * 64 + p] * dt; const double li = (double)(lim[g * 64 + p] * dt);
            const float mag = __expf(tau * lr); float s, c; sincos_red(tau * li, s, c); E[idx] = (f32x2_t){mag * c, mag * s}; }
        for (int idx = tid; idx < 1024; idx += 512) { const int p = idx >> 4, ci = idx & 15; const float ar = lre[g * 64 + p], ai = lim[g * 64 + p];
            const float mag = __expf(ar * dt); float s, c; sincos_red((double)(ai * dt), s, c);
            const float nr = mag * c - 1.f, ni = mag * s; const float den = 1.f / (ar * ar + ai * ai);
            const float qr = (nr * ar + ni * ai) * den, qi = (ni * ar - nr * ai) * den;
            const float br = bre[(size_t)(g * 64 + p) * 16 + ci], bi = bim[(size_t)(g * 64 + p) * 16 + ci];
            Bb[idx] = (f32x2_t){qr * br - qi * bi, qr * bi + qi * br}; }
        if (tid < 64) Cc[tid] = (f32x2_t){cre[(size_t)(g * 16 + co) * 64 + tid], cim[(size_t)(g * 16 + co) * 64 + tid]};
        __syncthreads();
        { const int tau = tid >> 4, ci = tid & 15; float a = 0.f;
            for (int p = 0; p < 64; ++p) { const f32x2_t e = E[tau * 64 + p], cc = Cc[p], bb = Bb[p * 16 + ci];
                const float cr = cc.x * e.x - cc.y * e.y, cim2 = cc.x * e.y + cc.y * e.x; a += cr * bb.x - cim2 * bb.y; }
            Kk[tid] = a; }
        __syncthreads();
        {
            const int s_ = tid >> 4, ci = tid & 15;
#pragma unroll
            for (int pp = 0; pp < 4; ++pp) { const int p = 4 * co + pp; const f32x2_t e = E[(31 - s_) * 64 + p], bb = Bb[p * 16 + ci];
                const size_t o = (size_t)(g * 256 + p) * 512 + s_ * 16 + ci;
                wst[o] = f2bf(e.x * bb.x - e.y * bb.y); wst[o + 64 * 512] = f2bf(e.x * bb.y + e.y * bb.x); wst[o + 128 * 512] = 0; wst[o + 192 * 512] = 0; }
            if (tid < 4) lamT[g * 64 + 4 * co + tid] = E[32 * 64 + 4 * co + tid];
        }
        const float dval = dsk[g * 16 + co];
        {
            bf16_t* trow = toep + (size_t)(g * 512 + co) * SSM_K2;
            { const int k = tid, s = k >> 4, ci = k & 15; const float dd = (ci == co) ? dval : 0.f;
#pragma unroll 8
              for (int t = 0; t < 32; ++t) { float val = (t >= s) ? Kk[(t - s) * 16 + ci] : 0.f; if (t == s) val += dd; trow[(size_t)t * 16 * SSM_K2 + k] = f2bf(val); } }
            if (tid < 128) { const int p = tid & 63; const bool im = tid >= 64; const f32x2_t cc = Cc[p];
#pragma unroll 8
              for (int t = 0; t < 32; ++t) { const f32x2_t e = E[(t + 1) * 64 + p]; const float val = im ? -(cc.x * e.y + cc.y * e.x) : (cc.x * e.x - cc.y * e.y);
                  trow[(size_t)t * 16 * SSM_K2 + 512 + tid] = f2bf(val); } }
        }
        __syncthreads();
    }
}

DI void ssm_scan(LAS unsigned char* lds) {
    const int tid = opaque(threadIdx.x);
    const float* sloc = (const float*)(PP->ws + WS_SLOC); bf16_t* a2 = (bf16_t*)(PP->ws + WS_A2); const f32x2_t* lamT = (const f32x2_t*)(PP->ws + WS_LAMT);
    for (int un = blockIdx.x; un < NB * 32; un += gridDim.x) {
        const int g = un & 31, b = un >> 5; const size_t r0 = (size_t)g * SSM_M2 + b * SSM_NC;
        const f32x4* src = (const f32x4*)(sloc + r0 * 128) + tid;
#pragma unroll
        for (int j = 0; j < 8; ++j) ((LAS f32x4*)lds)[tid + j * 512] = src[j * 512];
        __syncthreads();
        if (tid < 64) { const int p = tid; const f32x2_t lt = lamT[g * 64 + p]; float sr = 0.f, si = 0.f; const LAS float* L = (const LAS float*)lds;
            bf16_t* dst = a2 + r0 * SSM_K2 + 512 + p;
#pragma unroll 8
            for (int c = 0; c < SSM_NC; ++c) { dst[(size_t)c * SSM_K2] = f2bf(sr); dst[(size_t)c * SSM_K2 + 64] = f2bf(si);
                const float lr = L[c * 128 + p], li = L[c * 128 + 64 + p];
                const float nr = lt.x * sr - lt.y * si + lr, ni = lt.x * si + lt.y * sr + li; sr = nr; si = ni; } }
        __syncthreads();
    }
}

#define XB_TMO      128
#define XB_XCNT(j)  (256  + 64 * (j))
#define XB_XSUB(j)  (1280 + 64 * (j))
#define XB_XGEN(j)  (2304 + 64 * (j))
#define XB_TOP      3328
#define XB_TOPGEN   3392
#define XCD_BAR_WORDS 3456
#define XB_SPIN_CAP (1u << 18)
DI unsigned xb_ld(unsigned* p)              { return __hip_atomic_load(p, __ATOMIC_RELAXED, __HIP_MEMORY_SCOPE_AGENT); }
DI unsigned xb_add(unsigned* p, unsigned v) { return __hip_atomic_fetch_add(p, v, __ATOMIC_RELAXED, __HIP_MEMORY_SCOPE_AGENT); }
DI unsigned xb_xcc_id() { return (unsigned)__builtin_amdgcn_s_getreg((3 << 11) | 20) & 0xFu; }
#define XB_SPIN(cond, bar) do { unsigned _sp = 0; while (cond) { __builtin_amdgcn_s_sleep(1); \
    if ((++_sp & 255u) == 0u) { if (xb_ld(&(bar)[XB_TMO])) break; if (_sp > XB_SPIN_CAP) { atomicAdd(&(bar)[XB_TMO], 1u); break; } } } } while (0)
struct XcdBarrier { unsigned* bar; unsigned x; volatile LAS unsigned* st; };
DI XcdBarrier xcd_barrier_post(unsigned* bar, volatile LAS unsigned* st) {
    XcdBarrier b; b.bar = bar; b.x = xb_xcc_id(); b.st = st;
    if (threadIdx.x == 0) (void)xb_add(&bar[XB_XCNT(b.x)], 1u);
    return b;
}
DI void xcd_barrier_complete(unsigned* bar, unsigned x, unsigned& nloc, unsigned& nx) {
    const unsigned G = gridDim.x * gridDim.y * gridDim.z;
    unsigned sum, cnt, mine, sp = 0u;
    for (;;) {
        sum = 0u; cnt = 0u; mine = 0u;
#pragma unroll
        for (unsigned j = 0; j < 16; ++j) { const unsigned c = xb_ld(&bar[XB_XCNT(j)]); sum += c; cnt += (c > 0u) ? 1u : 0u; mine = (j == x) ? c : mine; }
        if (sum == G) break;
        __builtin_amdgcn_s_sleep(1);
        if ((++sp & 255u) == 0u) { if (xb_ld(&bar[XB_TMO])) break; if (sp > XB_SPIN_CAP) { atomicAdd(&bar[XB_TMO], 1u); break; } }
    }
    nloc = mine > 0u ? mine : 1u; nx = cnt > 0u ? cnt : 1u;
}
DI void xcd_barrier(const XcdBarrier& b) {
    asm volatile("s_waitcnt vmcnt(0)" ::: "memory");
    __syncthreads();
    if (opaque((int)threadIdx.x) == 0) {
        unsigned* bar = b.bar;
        __builtin_amdgcn_s_waitcnt(0);
        unsigned nloc = b.st[0], nx = b.st[1];
        if (nloc == 0u) { xcd_barrier_complete(bar, b.x, nloc, nx); b.st[0] = nloc; b.st[1] = nx; }
        const unsigned old = xb_add(&bar[XB_XSUB(b.x)], 1u);
        const unsigned gen = old / nloc;
        if (old + 1u == (gen + 1u) * nloc) {
            __builtin_amdgcn_fence(__ATOMIC_RELEASE, "agent");
            asm volatile("s_waitcnt vmcnt(0)" ::: "memory");
            const unsigned og = xb_add(&bar[XB_TOP], 1u);
            const unsigned tg = og / nx;
            if (og + 1u == (tg + 1u) * nx) xb_add(&bar[XB_TOPGEN], 1u);
            else XB_SPIN(xb_ld(&bar[XB_TOPGEN]) == tg, bar);
            __builtin_amdgcn_fence(__ATOMIC_ACQUIRE, "agent");
            xb_add(&bar[XB_XGEN(b.x)], 1u);
            asm volatile("s_waitcnt vmcnt(0)" ::: "memory");
        } else {
            XB_SPIN(xb_ld(&bar[XB_XGEN(b.x)]) == gen, bar);
            __builtin_amdgcn_fence(__ATOMIC_ACQUIRE, "agent");
            asm volatile("s_waitcnt vmcnt(0)" ::: "memory");
        }
    }
    __syncthreads();
}

#define HBUF ((bf16_t*)(PP->ws + WS_H))
#define LAMS ((float*)(PP->ws + WS_LAMT + 65536))
__global__ void __launch_bounds__(512, 2) fwd_megakernel(Params P) {
    extern __shared__ __attribute__((aligned(16))) unsigned char lds_raw[];
    LAS unsigned char* lds = (LAS unsigned char*)lds_raw;
    cg::grid_group grid = cg::this_grid();
    const int tid = threadIdx.x, lane = tid & 63, wave = __builtin_amdgcn_readfirstlane(tid >> 6);
    const int G = gridDim.x, c = blockIdx.x;
    const int gw = c * 8 + wave, ngw = G * 8;
    LAS float* scr = (LAS float*)(lds + wave * 16384);
    if (tid < 4) ((LAS unsigned*)(lds + LDS_CTL + 64))[tid] = 0u;
    __syncthreads();
    if (c == 0) { unsigned* bw = (unsigned*)PP->ws + 4096; for (int i = tid; i < XCD_BAR_WORDS; i += 512) bw[i] = 0u; }
    XcdBarrier xbar; xbar.bar = (unsigned*)PP->ws + 4096; xbar.x = xb_xcc_id(); xbar.st = (volatile LAS unsigned*)(lds + LDS_CTL + 64);
    grid.sync();
    if (opaque((int)threadIdx.x) == 0) (void)xb_add(&xbar.bar[XB_XCNT(xbar.x)], 1u);

    int goff = 0;
    for (int i = c * 512 + tid; i < MTOK * 8; i += G * 512) { const int row = i >> 3, j = i & 7;
        const float invf = __builtin_amdgcn_exp2f(-(float)j * 2.3664460712f);   const float ang = (float)PP->pos[row] * invf; float s, cs; sincos_red((double)ang, s, cs);
        ((f32x2_t*)(PP->ws + WS_ROPE))[i] = (f32x2_t){cs, s}; }
    if (c == 0 && tid < DEPTH) { const float* lv = PP->diff_lambda + tid * 256; float a = 0.f, b = 0.f;
        for (int k = 0; k < 64; ++k) { a += lv[k] * lv[64 + k]; b += lv[128 + k] * lv[192 + k]; }
        LAMS[tid] = expf(a) - expf(b) + (0.8f - 0.6f * expf(-0.3f * (float)tid)); }
    for (int r = gw; r < DEPTH * NB * MEML; r += ngw) { const int l = r / (NB * MEML), m = r % (NB * MEML);
        rms_row_bf16(PP->mem + (size_t)m * DM, PP->norm_mem + l * DM, (bf16_t*)(PP->ws + WS_MEMN) + (size_t)r * DM, lane); }
    for (int l = 0; l < DEPTH; ++l) transpose_mat(PP->w_xkv + (size_t)l * DM * 1024, DM, 1024, (bf16_t*)(PP->ws + WS_WXKV) + (size_t)l * 1024 * DM, false, scr, gw, ngw, lane, goff);

    for (int l = 0; l < DEPTH; ++l) {
        const float* xin = (l == 0) ? PP->x : PP->out;
        transpose_mat(PP->w_in + (size_t)l * DM * NIN, DM, NIN, (bf16_t*)(PP->ws + WS_WIN), false, scr, gw, ngw, lane, goff, 2048, 3072);
        transpose_mat(PP->w_glu + (size_t)l * 512 * 1024, 512, 1024, (bf16_t*)(PP->ws + WS_WGLU), true, scr, gw, ngw, lane, goff);
        for (int z = 0; z < 3; ++z) transpose_mat(PP->w_branch + ((size_t)l * 3 + z) * 512 * DM, 512, DM, (bf16_t*)(PP->ws + WS_WB) + (size_t)z * DM * 512, false, scr, gw, ngw, lane, goff);
        transpose_mat(PP->w_out + (size_t)l * DM * DM, DM, DM, (bf16_t*)(PP->ws + WS_WOUT), false, scr, gw, ngw, lane, goff);
        transpose_mat(PP->w_xq + (size_t)l * DM * 512, DM, 512, (bf16_t*)(PP->ws + WS_WXQ), false, scr, gw, ngw, lane, goff);
        transpose_mat(PP->w_xo + (size_t)l * 512 * DM, 512, DM, (bf16_t*)(PP->ws + WS_WXO), false, scr, gw, ngw, lane, goff);
        transpose_mat(PP->w_up + (size_t)l * DM * 4096, DM, 4096, (bf16_t*)(PP->ws + WS_WUP), false, scr, gw, ngw, lane, goff);
        transpose_mat(PP->w_down + (size_t)l * 4096 * DM, 4096, DM, (bf16_t*)(PP->ws + WS_WDN), false, scr, gw, ngw, lane, goff);
        __syncthreads();
        ssm_prep(l, lds);
        if (l == 0) for (int r = gw; r < MTOK; r += ngw) prep_row_bf16(xin + (size_t)r * DM, PP->norm_mix, HBUF + (size_t)r * DM, (float*)(PP->ws + WS_PART) + (size_t)r * 16, lane);
        xcd_barrier(xbar);

        { pg8::Gemm g{HBUF, (const bf16_t*)(PP->ws + WS_WIN), DM, DM, DM, 0, 0}; pg8::SchedMN S{MTOK / 256, NINA / 256, G, c};
          pg8::EpiInProj E{PP->ws, (const f32x2_t*)(PP->ws + WS_ROPE), (const float*)(PP->ws + WS_PART)}; pg8::gemm_phase(lds, g, S, E); }
        if (l == 0) { pg8::Gemm g{(const bf16_t*)(PP->ws + WS_MEMN), (const bf16_t*)(PP->ws + WS_WXKV), DM, DM, DM, (long)NB * MEML * DM, (long)1024 * DM};
          pg8::SchedZ S{DEPTH, NB * MEML / 256, 1024 / 256, G, c}; pg8::EpiMemKV E{(bf16_t*)(PP->ws + WS_MEMKV)}; pg8::gemm_phase(lds, g, S, E); }
        xcd_barrier(xbar);

        { pg8::Gemm g{(const bf16_t*)(PP->ws + WS_A2), (const bf16_t*)(PP->ws + WS_WST), SSM_K2, 512, 512, (long)SSM_M2 * SSM_K2, (long)256 * 512};
          pg8::SchedZ S{32, SSM_M2 / 256, 1, G, c}; pg8::EpiSloc E{(float*)(PP->ws + WS_SLOC)}; pg8::gemm_phase(lds, g, S, E); }
        xcd_barrier(xbar);
        ssm_scan(lds);
        xcd_barrier(xbar);
        { pg8::Gemm g{(const bf16_t*)(PP->ws + WS_A2), (const bf16_t*)(PP->ws + WS_TOEP), SSM_K2, SSM_K2, SSM_K2, (long)SSM_M2 * SSM_K2, (long)512 * SSM_K2};
          pg8::SchedZ S{32, SSM_M2 / 256, 2, G, c}; pg8::EpiGelu E{(bf16_t*)(PP->ws + WS_YACT)}; pg8::gemm_phase(lds, g, S, E); }
        xcd_barrier(xbar);
        { pg8::Gemm g{(const bf16_t*)(PP->ws + WS_YACT), (const bf16_t*)(PP->ws + WS_WGLU), 512, 512, 512, 0, 0}; pg8::SchedMN S{MTOK / 256, 4, G, c};
          pg8::EpiGlu E{(bf16_t*)(PP->ws + WS_YSSM)}; pg8::gemm_phase(lds, g, S, E); }
        for (int r = 0;; ++r) { const int pos = (r & 1) ? G - 1 - c : c; const int idx = r * G + pos; if (idx >= 1024) break;
            const int qb = 15 - idx / 64, bh = idx % 64;
            sb_unit(bh >> 3, bh & 7, qb, (const bf16_t*)(PP->ws + WS_SQ), (bf16_t*)(PP->ws + WS_SQ), (const bf16_t*)(PP->ws + WS_SK), (const bf16_t*)(PP->ws + WS_SV), lds); }
        { const float lam = LAMS[l]; const float post = 1.f - (0.8f - 0.6f * expf(-0.3f * (float)l));
          for (int r = 0;; ++r) { const int pos = (r & 1) ? G - 1 - c : c; const int idx = r * G + pos; if (idx >= 512) break;
            const int qb = 15 - idx / 32, bh = idx % 32, b = bh >> 2, hh = bh & 3; const size_t off = (size_t)b * SEQ * 512 + hh * 128;
            attn2_unit<true>(qb, (const bf16_t*)(PP->ws + WS_DQ) + off, (bf16_t*)(PP->ws + WS_DQ) + off, (const bf16_t*)(PP->ws + WS_DK) + off, (const bf16_t*)(PP->ws + WS_DV) + off, 4 * qb + 4, lam, PP->diff_subln + l * 128, post, lds); } }
        xcd_barrier(xbar);
        { pg8::GmArgs ga{HBUF, (const bf16_t*)(PP->ws + WS_WIN) + (size_t)NINA * DM, (const bf16_t*)(PP->ws + WS_YSSM), (long)(WS_SQ - WS_YSSM) / 2, (const bf16_t*)(PP->ws + WS_WB),
                         (bf16_t*)(PP->ws + WS_GS), (bf16_t*)(PP->ws + WS_H2), (const float*)(PP->ws + WS_PART)};
          pg8::SchedGM S{MTOK / 256, 4, G, c}; pg8::gemm_phase_gm(lds, ga, S); }
        xcd_barrier(xbar);
        { pg8::Gemm g{(const bf16_t*)(PP->ws + WS_H2), (const bf16_t*)(PP->ws + WS_WOUT), DM, DM, DM, 0, 0}; pg8::SchedMN S{MTOK / 256, 4, G, c}; pg8::EpiResid E{xin, PP->out, HBUF, PP->norm_cross + l * DM, (float*)(PP->ws + WS_PART)}; pg8::gemm_phase(lds, g, S, E); }
        xcd_barrier(xbar);
        { pg8::Gemm g{HBUF, (const bf16_t*)(PP->ws + WS_WXQ), DM, DM, DM, 0, 0}; pg8::SchedMN S{MTOK / 256, 2, G, c};
          pg8::EpiBf16<0, true> E{(bf16_t*)(PP->ws + WS_XQ), 512, 0.12751743074602334f, (const float*)(PP->ws + WS_PART)}; pg8::gemm_phase(lds, g, S, E); }
        xcd_barrier(xbar);
        for (int idx = c; idx < 512; idx += G) { const int qb = idx & 15, bh = idx >> 4, b = bh >> 2, hh = bh & 3;
            const bf16_t* kb = (const bf16_t*)(PP->ws + WS_MEMKV) + (size_t)(l * 2) * 2048 * 512 + (size_t)b * MEML * 512 + hh * 128;
            attn2_unit<false>(qb, (const bf16_t*)(PP->ws + WS_XQ) + (size_t)b * SEQ * 512 + hh * 128, (bf16_t*)(PP->ws + WS_XQ) + (size_t)b * SEQ * 512 + hh * 128, kb, kb + (size_t)2048 * 512, 4, 0.f, nullptr, 1.f, lds); }
        xcd_barrier(xbar);
        { pg8::Gemm g{(const bf16_t*)(PP->ws + WS_XQ), (const bf16_t*)(PP->ws + WS_WXO), 512, 512, 512, 0, 0}; pg8::SchedMN S{MTOK / 256, 4, G, c}; pg8::EpiResid E{PP->out, PP->out, HBUF, PP->norm_mlp + l * DM, (float*)(PP->ws + WS_PART)}; pg8::gemm_phase(lds, g, S, E); }
        xcd_barrier(xbar);
        { pg8::Gemm g{HBUF, (const bf16_t*)(PP->ws + WS_WUP), DM, DM, DM, 0, 0}; pg8::SchedMN S{MTOK / 256, 16, G, c};
          pg8::EpiBf16<2, true> E{(bf16_t*)(PP->ws + WS_HID), 4096, 1.f, (const float*)(PP->ws + WS_PART)}; pg8::gemm_phase(lds, g, S, E); }
        xcd_barrier(xbar);
        { pg8::Gemm g{(const bf16_t*)(PP->ws + WS_HID), (const bf16_t*)(PP->ws + WS_WDN), 4096, 4096, 4096, 0, 0}; pg8::SchedMN S{MTOK / 256, 4, G, c}; pg8::EpiResid E{PP->out, PP->out, HBUF, PP->norm_mix + (l + 1 < DEPTH ? l + 1 : l) * DM, (float*)(PP->ws + WS_PART)}; pg8::gemm_phase(lds, g, S, E); }
        xcd_barrier(xbar);
    }
    for (int r = gw; r < MTOK; r += ngw) rms_row_f32(PP->out + (size_t)r * DM, PP->norm_final, lane);
}

extern "C" void kernel_launch(void* const* d_in, const int* in_sizes, int n_in, void* d_out, int out_size, void* d_ws, size_t ws_size, hipStream_t stream) {
    static int grid = 0;
    if (grid == 0) {
        if (n_in != 27 || ws_size < WS_END) { fprintf(stderr, "kernel_launch: unexpected n_in %d / ws %zu\n", n_in, ws_size); grid = -1; return; }
        int dev = 0, cus = 0, per_cu = 0;
        hipGetDevice(&dev); hipDeviceGetAttribute(&cus, hipDeviceAttributeMultiprocessorCount, dev);
        hipFuncSetAttribute((const void*)fwd_megakernel, hipFuncAttributeMaxDynamicSharedMemorySize, LDS_BYTES);
        hipOccupancyMaxActiveBlocksPerMultiprocessor(&per_cu, (const void*)fwd_megakernel, 512, LDS_BYTES);
        if (per_cu < 1) per_cu = 1;
        grid = cus * 1; (void)per_cu;
        (void)hipGetLastError();
    }
    if (grid < 0) return;
    Params p{};
    p.x = (const float*)d_in[0]; p.mem = (const float*)d_in[1]; p.pos = (const int*)d_in[2];
    p.norm_mix = (const float*)d_in[3]; p.w_in = (const float*)d_in[4]; p.lam_re = (const float*)d_in[5]; p.lam_im = (const float*)d_in[6]; p.log_dt = (const float*)d_in[7];
    p.b_re = (const float*)d_in[8]; p.b_im = (const float*)d_in[9]; p.c_re = (const float*)d_in[10]; p.c_im = (const float*)d_in[11]; p.ssm_d = (const float*)d_in[12];
    p.w_glu = (const float*)d_in[13]; p.diff_lambda = (const float*)d_in[14]; p.diff_subln = (const float*)d_in[15]; p.w_branch = (const float*)d_in[16]; p.w_out = (const float*)d_in[17];
    p.norm_cross = (const float*)d_in[18]; p.norm_mem = (const float*)d_in[19]; p.w_xq = (const float*)d_in[20]; p.w_xkv = (const float*)d_in[21]; p.w_xo = (const float*)d_in[22];
    p.norm_mlp = (const float*)d_in[23]; p.w_up = (const float*)d_in[24]; p.w_down = (const float*)d_in[25]; p.norm_final = (const float*)d_in[26];
    p.out = (float*)d_out; p.ws = (unsigned char*)d_ws;
    void* args[] = {&p};
    hipError_t e = hipLaunchCooperativeKernel((const void*)fwd_megakernel, dim3(grid), dim3(512), args, LDS_BYTES, stream);
    if (e != hipSuccess) fprintf(stderr, "cooperative launch failed: %s (grid %d)\n", hipGetErrorString(e), grid);
}
```
